# Optimizing an MI355X kernel written in HIP

```python
import math
import jax
import jax.numpy as jnp
from jax import lax
import numpy as np

D_MODEL = 1024
BATCH = 16
SEQ = 2048
DEPTH = 4

CTX_LEN = 256
GRID_W = 64

FOURIER_WIDTH = D_MODEL // 4
FOURIER_GROUPS = 4
FOURIER_GROUP_DIM = FOURIER_WIDTH // FOURIER_GROUPS
POOL_WINDOWS = (2, 4, 8, 16)
POOL_WIDTH = D_MODEL // 4
POOL_GROUP_DIM = POOL_WIDTH // len(POOL_WINDOWS)
HEAD_DIM = 64
Q_WIDTH = D_MODEL // 2
N_HEADS = Q_WIDTH // HEAD_DIM
N_KV_HEADS = N_HEADS // 4
GQA_GROUP = N_HEADS // N_KV_HEADS
KV_WIDTH = N_KV_HEADS * HEAD_DIM
ROPE_THETA = 10000.0
ROPE_AX_FREQS = HEAD_DIM // 4
Q_BLOCK = 128
N_BRANCHES = 3
OFF_P = FOURIER_WIDTH
OFF_Q = OFF_P + POOL_WIDTH
OFF_K = OFF_Q + Q_WIDTH
OFF_V = OFF_K + KV_WIDTH
OFF_G = OFF_V + KV_WIDTH
IN_COLS = OFF_G + N_BRANCHES * D_MODEL
PEER_HEADS = 8
PEER_KEYS = 128
PEER_EXPERTS = PEER_KEYS * PEER_KEYS
PEER_TOPK = 16
PEER_KEY_DIM = 128
PEER_QDIM = 2 * PEER_KEY_DIM
PEER_CHUNK = 128
EPS = 1e-6

kernel_name = 'hybrid_fourier_pool_gqa_peer_dit'


def rmsnorm(x, g):
    x32 = x.astype(jnp.float32)
    y = x32 * lax.rsqrt(jnp.mean(x32 * x32, axis=-1, keepdims=True) + EPS)
    return (y * g.astype(jnp.float32)).astype(x.dtype)


def modulate(h, shift, scale):
    return h * (1 + scale) + shift


def axial_rope_angles(L):
    rows = L // GRID_W
    row = jnp.repeat(jnp.arange(rows), GRID_W).astype(jnp.float32)
    col = jnp.tile(jnp.arange(GRID_W), rows).astype(jnp.float32)
    inv = ROPE_THETA ** (-jnp.arange(ROPE_AX_FREQS, dtype=jnp.float32) / ROPE_AX_FREQS)
    return row[:, None] * inv, col[:, None] * inv


def rope_rotate(x, ang):
    F = ang.shape[-1]
    cos = jnp.cos(ang)[None, :, None, :].astype(x.dtype)
    sin = jnp.sin(ang)[None, :, None, :].astype(x.dtype)
    x1, x2 = x[..., :F], x[..., F:]
    return jnp.concatenate([x1 * cos - x2 * sin, x2 * cos + x1 * sin], axis=-1)


def apply_axial_rope(x, ang_row, ang_col):
    half = HEAD_DIM // 2
    return jnp.concatenate([rope_rotate(x[..., :half], ang_row),
                            rope_rotate(x[..., half:], ang_col)], axis=-1)


def split_proj(P):
    B, L, _ = P.shape
    f = P[..., :OFF_P]
    p = P[..., OFF_P:OFF_Q]
    q = P[..., OFF_Q:OFF_K].reshape(B, L, N_HEADS, HEAD_DIM)
    k = P[..., OFF_K:OFF_V].reshape(B, L, N_KV_HEADS, HEAD_DIM)
    v = P[..., OFF_V:OFF_G].reshape(B, L, N_KV_HEADS, HEAD_DIM)
    gates = jax.nn.sigmoid(P[..., OFF_G:]).reshape(B, L, N_BRANCHES, D_MODEL)
    return f, p, q, k, v, gates


def fourier_branch(f, w):
    B, L, _ = f.shape
    fg = f.reshape(B, L, FOURIER_GROUPS, FOURIER_GROUP_DIM).astype(jnp.float32)
    re = jnp.fft.fftn(fg, axes=(1, 3), norm='ortho').real
    return re.reshape(B, L, FOURIER_WIDTH).astype(f.dtype) @ w


def pool_branch(p, w_grp, scale, w_proj):
    B, L, _ = p.shape
    n_g = len(POOL_WINDOWS)
    pg = p.reshape(B, L, n_g, POOL_GROUP_DIM)
    cs = jnp.concatenate([jnp.zeros((B, 1, n_g, POOL_GROUP_DIM), jnp.float32),
                          jnp.cumsum(pg.astype(jnp.float32), axis=1)], axis=1)
    t = jnp.arange(L)
    means = []
    for gi, win in enumerate(POOL_WINDOWS):
        lo = jnp.maximum(t - win // 2, 0)
        hi = jnp.minimum(t + win - win // 2, L)
        s = cs[:, hi, gi] - cs[:, lo, gi]
        means.append(s / (hi - lo).astype(jnp.float32)[None, :, None])
    pooled = jnp.stack(means, axis=2).astype(p.dtype) - pg
    mixed = jnp.einsum('blgc,gce->blge', pooled, w_grp).reshape(B, L, POOL_WIDTH) * scale
    return mixed @ w_proj


def attend(q, k, v):
    s = jnp.einsum('bqhgd,bkhd->bhgqk', q, k).astype(jnp.float32) * (HEAD_DIM ** -0.5)
    p = jax.nn.softmax(s, axis=-1).astype(v.dtype)
    return jnp.einsum('bhgqk,bkhd->bqhgd', p, v)


def latent_attention(q, k_all, v_all):
    B, L = q.shape[0], q.shape[1]
    nb = L // Q_BLOCK
    qb = q.reshape(B, nb, Q_BLOCK, N_KV_HEADS, GQA_GROUP, HEAD_DIM).swapaxes(0, 1)
    ob = lax.map(lambda qq: attend(qq, k_all, v_all), qb)
    return ob.swapaxes(0, 1).reshape(B, L, Q_WIDTH)


def merge(yf, yp, ya, gates, w_out):
    return (gates[:, :, 0] * yf + gates[:, :, 1] * yp + gates[:, :, 2] * ya) @ w_out


def peer(h, wq, sub_keys, u_tab, v_tab):
    B, L, D = h.shape
    xs = h.reshape(-1, PEER_CHUNK, D)

    def block(xc):
        C = xc.shape[0]
        q = (xc @ wq).reshape(C, PEER_HEADS, 2, PEER_KEY_DIM)
        s = jnp.einsum('chpd,hpnd->chpn', q, sub_keys).astype(jnp.float32)
        s1, i1 = lax.top_k(s[:, :, 0], PEER_TOPK)
        s2, i2 = lax.top_k(s[:, :, 1], PEER_TOPK)
        cand = (s1[..., :, None] + s2[..., None, :]).reshape(C, PEER_HEADS, PEER_TOPK * PEER_TOPK)
        cidx = (i1[..., :, None] * PEER_KEYS + i2[..., None, :]).reshape(C, PEER_HEADS, PEER_TOPK * PEER_TOPK)
        top, pos = lax.top_k(cand, PEER_TOPK)
        eidx = jnp.take_along_axis(cidx, pos, axis=-1)
        g = jax.nn.softmax(top, axis=-1).astype(xc.dtype)
        a = jax.nn.gelu(jnp.einsum('chkd,cd->chk', u_tab[eidx], xc))
        return jnp.einsum('chk,chkd->cd', g * a, v_tab[eidx])

    return lax.map(block, xs).reshape(B, L, D)


def setup_inputs(seed: int = 0) -> dict:
    key = jax.random.key(seed)
    ks = jax.random.split(key, 24)
    f32 = jnp.float32

    def nrm(k, shape, scale):
        return jax.random.normal(k, shape, f32) * scale

    def gain(k, shape):
        return 1.0 + 0.02 * jax.random.normal(k, shape, f32)

    return {
        'x': nrm(ks[0], (BATCH, SEQ, D_MODEL), 1.0),
        'c': nrm(ks[1], (BATCH, D_MODEL), 1.0),
        'ctx': nrm(ks[2], (BATCH, CTX_LEN, D_MODEL), 1.0),
        'c_ctx': nrm(ks[3], (D_MODEL,), 1.0),
        'ada_w': nrm(ks[4], (DEPTH, D_MODEL, 6 * D_MODEL), 0.5 * D_MODEL ** -0.5),
        'ada_b': nrm(ks[5], (DEPTH, 6 * D_MODEL), 0.02),
        'norm_mix': gain(ks[6], (DEPTH, D_MODEL)),
        'w_in': nrm(ks[7], (DEPTH, D_MODEL, IN_COLS), D_MODEL ** -0.5),
        'fourier_w': nrm(ks[8], (DEPTH, FOURIER_WIDTH, D_MODEL), FOURIER_WIDTH ** -0.5),
        'pool_w': nrm(ks[9], (DEPTH, len(POOL_WINDOWS), POOL_GROUP_DIM, POOL_GROUP_DIM), POOL_GROUP_DIM ** -0.5),
        'pool_scale': gain(ks[10], (DEPTH, POOL_WIDTH)),
        'pool_proj': nrm(ks[11], (DEPTH, POOL_WIDTH, D_MODEL), POOL_WIDTH ** -0.5),
        'q_norm': gain(ks[12], (DEPTH, HEAD_DIM)),
        'k_norm': gain(ks[13], (DEPTH, HEAD_DIM)),
        'attn_proj': nrm(ks[14], (DEPTH, Q_WIDTH, D_MODEL), Q_WIDTH ** -0.5),
        'w_out': nrm(ks[15], (DEPTH, D_MODEL, D_MODEL), D_MODEL ** -0.5),
        'norm_ffn': gain(ks[16], (DEPTH, D_MODEL)),
        'peer_wq': nrm(ks[17], (DEPTH, D_MODEL, PEER_HEADS * PEER_QDIM), D_MODEL ** -0.5),
        'peer_keys': nrm(ks[18], (DEPTH, PEER_HEADS, 2, PEER_KEYS, PEER_KEY_DIM), PEER_KEY_DIM ** -0.5),
        'peer_u': nrm(ks[19], (DEPTH, PEER_EXPERTS, D_MODEL), D_MODEL ** -0.5),
        'peer_v': nrm(ks[20], (DEPTH, PEER_EXPERTS, D_MODEL), PEER_HEADS ** -0.5),
    }


def reference(x, c, ctx, c_ctx, ada_w, ada_b, norm_mix, w_in, fourier_w, pool_w, pool_scale,
              pool_proj, q_norm, k_norm, attn_proj, w_out, norm_ffn, peer_wq, peer_keys, peer_u, peer_v):
    B, L, _ = x.shape
    ang_row, ang_col = axial_rope_angles(L)
    for l in range(DEPTH):
        last = l == DEPTH - 1
        m_lat = jnp.split((jax.nn.silu(c) @ ada_w[l] + ada_b[l])[:, None, :], 6, axis=-1)
        m_ctx = jnp.split(jax.nn.silu(c_ctx) @ ada_w[l] + ada_b[l], 6, axis=-1)

        h = modulate(rmsnorm(x, norm_mix[l]), m_lat[0], m_lat[1])
        hc = modulate(rmsnorm(ctx, norm_mix[l]), m_ctx[0], m_ctx[1])
        f, p, q, k, v, gates = split_proj(h @ w_in[l])
        fc, pc, qc, kc, vc, gates_c = split_proj(hc @ w_in[l])

        q = apply_axial_rope(rmsnorm(q, q_norm[l]), ang_row, ang_col)
        k = apply_axial_rope(rmsnorm(k, k_norm[l]), ang_row, ang_col)
        kc = rmsnorm(kc, k_norm[l])
        k_all = jnp.concatenate([k, kc], axis=1)
        v_all = jnp.concatenate([v, vc], axis=1)
        q = q.reshape(B, L, N_KV_HEADS, GQA_GROUP, HEAD_DIM)
        ya = latent_attention(q, k_all, v_all) @ attn_proj[l]
        yf = fourier_branch(f, fourier_w[l])
        yp = pool_branch(p, pool_w[l], pool_scale[l], pool_proj[l])
        x = x + m_lat[2] * merge(yf, yp, ya, gates, w_out[l])

        if not last:
            Lc = ctx.shape[1]
            qc = rmsnorm(qc, q_norm[l]).reshape(B, Lc, N_KV_HEADS, GQA_GROUP, HEAD_DIM)
            yac = attend(qc, kc, vc).reshape(B, Lc, Q_WIDTH) @ attn_proj[l]
            yfc = fourier_branch(fc, fourier_w[l])
            ypc = pool_branch(pc, pool_w[l], pool_scale[l], pool_proj[l])
            ctx = ctx + m_ctx[2] * merge(yfc, ypc, yac, gates_c, w_out[l])

        h2 = modulate(rmsnorm(x, norm_ffn[l]), m_lat[3], m_lat[4])
        x = x + m_lat[5] * peer(h2, peer_wq[l], peer_keys[l], peer_u[l], peer_v[l])
        if not last:
            hc2 = modulate(rmsnorm(ctx, norm_ffn[l]), m_ctx[3], m_ctx[4])
            ctx = ctx + m_ctx[5] * peer(hc2, peer_wq[l], peer_keys[l], peer_u[l], peer_v[l])
    return x
```

```cpp
#include <hip/hip_runtime.h>
#include <stdint.h>

typedef unsigned short bf16_t;
typedef short bf16x8 __attribute__((ext_vector_type(8)));
typedef float f32x4 __attribute__((ext_vector_type(4)));
typedef float f32x16 __attribute__((ext_vector_type(16)));
typedef unsigned u32x4 __attribute__((ext_vector_type(4)));
typedef unsigned u32x2 __attribute__((ext_vector_type(2)));
typedef float f32x2_t __attribute__((ext_vector_type(2)));
typedef __bf16 bf16x2_t __attribute__((ext_vector_type(2)));

constexpr int D = 1024, NB = 16, SEQ = 2048, DEPTH = 4, CTX = 256;
constexpr int NL = NB * SEQ, NC = NB * CTX, NT = NL + NC;
constexpr int INC = 4352;
constexpr int KV = SEQ + CTX;
constexpr int NEXP = 16384;
constexpr float C2 = 0.125f * 1.4426950408889634f;
constexpr float EPS = 1e-6f;

constexpr size_t MiB = 1u << 20;
constexpr size_t OFF_CTL = 0;
constexpr size_t OFF_MOD = 1 * MiB;
constexpr size_t OFF_SC = 3 * MiB + 512 * 1024;
constexpr size_t OFF_ROPE = 3 * MiB;
constexpr size_t OFF_XC = 4 * MiB;
constexpr size_t OFF_HB = 20 * MiB;
constexpr size_t OFF_MIX = 92 * MiB;
constexpr size_t OFF_KALL = 164 * MiB;
constexpr size_t OFF_VALL = 173 * MiB;
constexpr size_t OFF_EID = 182 * MiB;
constexpr size_t OFF_GW = 200 * MiB;
constexpr size_t OFF_GT = 218 * MiB;
constexpr size_t OFF_QR = 434 * MiB;
constexpr size_t OFF_ZTL = 470 * MiB;
constexpr size_t OFF_ZTC = 502 * MiB;
constexpr size_t OFF_PP = 506 * MiB;
constexpr size_t OFF_ST = 218 * MiB;
constexpr size_t OFF_W1T = 524 * MiB;
constexpr size_t OFF_WFT = 556 * MiB;
constexpr size_t OFF_WMT = 560 * MiB;
constexpr size_t OFF_WOT = 568 * MiB;
constexpr size_t OFF_WST = 576 * MiB;
constexpr size_t OFF_ADFT = 592 * MiB;
constexpr size_t OFF_ADFTC = 608 * MiB;
constexpr size_t OFF_PU = 609 * MiB;
constexpr size_t OFF_PV = 737 * MiB;
constexpr size_t WS_END = 865 * MiB;

struct Params {
    const float *x, *c, *ctx, *c_ctx, *ada_w, *ada_b, *norm_mix, *w_in, *fourier_w, *pool_w, *pool_scale, *pool_proj, *q_norm, *k_norm,
        *attn_proj, *w_out, *norm_ffn, *peer_wq, *peer_keys, *peer_u, *peer_v;
    float* out;
    unsigned char* ws;
};

__device__ __forceinline__ unsigned pk_bf16(float lo, float hi) { f32x2_t v = {lo, hi}; bf16x2_t b = __builtin_convertvector(v, bf16x2_t); return __builtin_bit_cast(unsigned, b); }
__device__ __forceinline__ float bf_lo(unsigned u) { return __uint_as_float(u << 16); }
__device__ __forceinline__ float bf_hi(unsigned u) { return __uint_as_float(u & 0xffff0000u); }
__device__ __forceinline__ float sigmoidf_(float x) { return 1.0f / (1.0f + __expf(-x)); }
__device__ __forceinline__ float gelu_tanh(float x) { const float y = 0.7978845608028654f * (x + 0.044715f * x * x * x); const float t = 1.0f - 2.0f / (1.0f + __expf(2.0f * y)); return 0.5f * x * (1.0f + t); }
__device__ __forceinline__ float wave_sum(float v) {
#pragma unroll
    for (int o = 32; o >= 1; o >>= 1) v += __shfl_xor(v, o);
    return v;
}
__device__ __forceinline__ float dot2bf(unsigned a, unsigned b, float acc) { return __builtin_amdgcn_fdot2_f32_bf16(__builtin_bit_cast(bf16x2_t, a), __builtin_bit_cast(bf16x2_t, b), acc, false); }
__device__ __forceinline__ float dot8(u32x4 a, u32x4 b, float acc) {
    const unsigned a0 = a.x, a1 = a.y, a2 = a.z, a3 = a.w, b0 = b.x, b1 = b.y, b2 = b.z, b3 = b.w;
    acc = dot2bf(a0, b0, acc); acc = dot2bf(a1, b1, acc); acc = dot2bf(a2, b2, acc); acc = dot2bf(a3, b3, acc);
    return acc;
}
__device__ __forceinline__ float* xrow_ptr(const Params& P, int row) { return row < NL ? P.out + (size_t)row * D : (float*)(P.ws + OFF_XC) + (size_t)(row - NL) * D; }
__device__ __forceinline__ int mod_r(int row) { return row < NL ? (row >> 11) : 16; }
__device__ __forceinline__ const float* mod_ptr(const Params& P, int l, int r, int j) { return (const float*)(P.ws + OFF_MOD) + ((size_t)(l * 17 + r) * 6 + j) * D; }
__device__ __forceinline__ int kv_row(int row) { return row < NL ? (row >> 11) * KV + (row & 2047) : ((row - NL) >> 8) * KV + SEQ + ((row - NL) & 255); }

__device__ __forceinline__ void ph_init_x(const Params& P, int bid, int nblk) {
    const size_t n4 = (size_t)NL * D / 4, c4 = (size_t)NC * D / 4;
    const f32x4* xs = (const f32x4*)P.x; f32x4* xd = (f32x4*)P.out;
    for (size_t i = (size_t)bid * 512 + threadIdx.x; i < n4; i += (size_t)nblk * 512) xd[i] = xs[i];
    const f32x4* cs = (const f32x4*)P.ctx; f32x4* cd = (f32x4*)(P.ws + OFF_XC);
    for (size_t i = (size_t)bid * 512 + threadIdx.x; i < c4; i += (size_t)nblk * 512) cd[i] = cs[i];
}
__device__ __forceinline__ void ph_silu_c(const Params& P, int bid, int nblk) {
    float* sc = (float*)(P.ws + OFF_SC);
    for (int i = bid * 512 + threadIdx.x; i < 17 * D; i += nblk * 512) { const float v = i < 16 * D ? P.c[i] : P.c_ctx[i - 16 * D]; sc[i] = v * sigmoidf_(v); }
}
__device__ __forceinline__ void ph_tables(const Params& P, int bid, int nblk) {
    float* rc = (float*)(P.ws + OFF_ROPE); float* rs = rc + SEQ * 32;
    for (int i = bid * 512 + threadIdx.x; i < SEQ * 32; i += nblk * 512) {
        const int t = i >> 5, f = i & 31; const float pos = (float)(f < 16 ? (t >> 6) : (t & 63));
        const float inv = powf(10000.0f, -(float)(f & 15) / 16.0f); const float ang = pos * inv;
        float s, c; sincosf(ang, &s, &c); rc[i] = c; rs[i] = s;
    }
    bf16_t* A = (bf16_t*)(P.ws + OFF_ADFT); const float sc1 = 0.0027621358640099515f;
    for (size_t i = (size_t)bid * 512 + threadIdx.x; i < (size_t)2048 * 2048; i += (size_t)nblk * 512) {
        const int kp = (int)(i >> 11), t = (int)(i & 2047); const int m = (kp * t) & 2047;
        float s, c; sincospif((float)m * (1.0f / 1024.0f), &s, &c);
        A[(size_t)kp * 4096 + t] = (bf16_t)(pk_bf16(c * sc1, 0.f) & 0xffff); A[(size_t)kp * 4096 + 2048 + t] = (bf16_t)(pk_bf16(-s * sc1, 0.f) & 0xffff);
    }
    bf16_t* Ac = (bf16_t*)(P.ws + OFF_ADFTC); const float sc2 = 1.0f / 128.0f;
    for (int i = bid * 512 + threadIdx.x; i < 256 * 256; i += nblk * 512) {
        const int kp = i >> 8, t = i & 255; const int m = (kp * t) & 255;
        float s, c; sincospif((float)m * (1.0f / 128.0f), &s, &c);
        Ac[kp * 512 + t] = (bf16_t)(pk_bf16(c * sc2, 0.f) & 0xffff); Ac[kp * 512 + 256 + t] = (bf16_t)(pk_bf16(-s * sc2, 0.f) & 0xffff);
    }
}
__device__ __forceinline__ void ph_mod(const Params& P, int bid, int nblk, float* lds) {
    const int tid = threadIdx.x, cl = tid & 63, ks = __builtin_amdgcn_readfirstlane(tid >> 6);
    const float* sc = (const float*)(P.ws + OFF_SC); float* mod = (float*)(P.ws + OFF_MOD);
    for (int u = bid; u < DEPTH * 96; u += nblk) {
        const int l = u / 96, j = (u % 96) * 64 + cl;
        float acc[17];
#pragma unroll
        for (int r = 0; r < 17; ++r) acc[r] = 0.f;
        const float* w = P.ada_w + ((size_t)l * D + ks * 128) * 6144 + j;
        for (int k = 0; k < 128; ++k) { const float wv = w[(size_t)k * 6144];
#pragma unroll
            for (int r = 0; r < 17; ++r) acc[r] += sc[r * D + ks * 128 + k] * wv; }
        __syncthreads();
#pragma unroll
        for (int r = 0; r < 17; ++r) lds[(ks * 17 + r) * 64 + cl] = acc[r];
        __syncthreads();
        for (int i = tid; i < 17 * 64; i += 512) { const int r = i >> 6, c = i & 63; float s = 0.f;
#pragma unroll
            for (int q = 0; q < 8; ++q) s += lds[(q * 17 + r) * 64 + c];
            const int jj = (u % 96) * 64 + c; mod[(size_t)(l * 17 + r) * 6144 + jj] = s + P.ada_b[l * 6144 + jj]; }
    }
}
__device__ __forceinline__ void tr_cvt_tile(const float* src, int ldn, bf16_t* dst, int ldk, int K, int N, int tile, float* lds) {
    const int tn = N / 64; const int k0 = (tile / tn) * 64, n0 = (tile % tn) * 64; const int tid = threadIdx.x;
    __syncthreads();
    for (int i = tid; i < 64 * 64; i += 512) { const int kk = i >> 6, nn = i & 63; lds[kk * 65 + nn] = src[(size_t)(k0 + kk) * ldn + n0 + nn]; }
    __syncthreads();
    for (int i = tid; i < 64 * 32; i += 512) { const int nn = i >> 5, kk = (i & 31) * 2; *(unsigned*)(dst + (size_t)(n0 + nn) * ldk + k0 + kk) = pk_bf16(lds[kk * 65 + nn], lds[(kk + 1) * 65 + nn]); }
}
__device__ __forceinline__ void ph_wtrans(const Params& P, int bid, int nblk, float* lds) {
    for (int u = bid; u < DEPTH * 1472; u += nblk) {
        const int l = u / 1472; int t = u % 1472;
        if (t < 1024) tr_cvt_tile(P.w_in + (size_t)l * D * INC + 256, INC, (bf16_t*)(P.ws + OFF_W1T) + (size_t)l * 4096 * D, D, D, 4096, t, lds);
        else if (t < 1280) tr_cvt_tile(P.w_out + (size_t)l * D * D, D, (bf16_t*)(P.ws + OFF_WOT) + (size_t)l * D * D, D, D, D, t - 1024, lds);
        else if (t < 1344) tr_cvt_tile(P.fourier_w + (size_t)l * 256 * D, D, (bf16_t*)(P.ws + OFF_WMT) + (size_t)l * D * D, D, 256, D, t - 1280, lds);
        else tr_cvt_tile(P.attn_proj + (size_t)l * 512 * D, D, (bf16_t*)(P.ws + OFF_WMT) + (size_t)l * D * D + 512, D, 512, D, t - 1344, lds);
    }
}
__device__ __forceinline__ void ph_wft(const Params& P, int bid, int nblk, float* lds) {
    const int tid = threadIdx.x;
    __syncthreads();
    if (tid < 64) { float s, c; sincospif((float)tid * (1.0f / 32.0f), &s, &c); lds[tid] = c; lds[64 + tid] = s; }
    __syncthreads();
    bf16_t* W = (bf16_t*)(P.ws + OFF_WFT);
    for (int i = bid * 512 + tid; i < DEPTH * 4 * D; i += nblk * 512) {
        const int k = i & 1023, g = (i >> 10) & 3, l = i >> 12;
        float w[64]; const f32x4* src = (const f32x4*)(P.w_in + ((size_t)l * D + k) * INC + g * 64);
#pragma unroll
        for (int q = 0; q < 16; ++q) { const f32x4 v = src[q]; w[4 * q] = v.x; w[4 * q + 1] = v.y; w[4 * q + 2] = v.z; w[4 * q + 3] = v.w; }
#pragma unroll 1
        for (int j = 0; j < 64; ++j) { float ac = 0.f, as = 0.f;
#pragma unroll
            for (int c = 0; c < 64; ++c) { const int m = (c * j) & 63; ac += w[c] * lds[m]; as += w[c] * lds[64 + m]; }
            W[((size_t)l * 512 + g * 64 + j) * D + k] = (bf16_t)(pk_bf16(ac, 0.f) & 0xffff);
            W[((size_t)l * 512 + 256 + g * 64 + j) * D + k] = (bf16_t)(pk_bf16(as, 0.f) & 0xffff); }
    }
}
__device__ __forceinline__ void ph_wpool(const Params& P, int bid, int nblk) {
    bf16_t* W = (bf16_t*)(P.ws + OFF_WMT);
    for (int u = bid; u < DEPTH * 4 * 2; u += nblk) {
        const int n = (u & 1) * 512 + threadIdx.x, g = (u >> 1) & 3, l = u >> 3;
        float pr[64];
#pragma unroll
        for (int e = 0; e < 64; ++e) pr[e] = P.pool_proj[((size_t)l * 256 + g * 64 + e) * D + n] * P.pool_scale[l * 256 + g * 64 + e];
        const float* pw = P.pool_w + (size_t)(l * 4 + g) * 64 * 64;
#pragma unroll 1
        for (int c = 0; c < 64; ++c) { float a0 = 0.f;
#pragma unroll
            for (int e = 0; e < 64; ++e) a0 += pw[c * 64 + e] * pr[e];
            W[((size_t)l * D + n) * D + 256 + g * 64 + c] = (bf16_t)(pk_bf16(a0, 0.f) & 0xffff); }
    }
}
__device__ __forceinline__ void ph_wst(const Params& P, int bid, int nblk) {
    bf16_t* W = (bf16_t*)(P.ws + OFF_WST);
    const int wid = __builtin_amdgcn_readfirstlane(threadIdx.x >> 6), lane = threadIdx.x & 63, r = lane & 31, hi = lane >> 5;
    for (int u = bid * 8 + wid; u < DEPTH * 16 * 4 * 32; u += nblk * 8) {
        const int kt = u & 31, jt = (u >> 5) & 3, hp = (u >> 7) & 15, l = u >> 11;
        const float* ap = P.peer_keys + ((size_t)(l * 16 + hp) * 128 + jt * 32 + r) * 128 + hi;
        const float* bp = P.peer_wq + ((size_t)l * D + kt * 32 + r) * 2048 + hp * 128 + hi;
        f32x16 acc;
#pragma unroll
        for (int q = 0; q < 16; ++q) acc[q] = 0.f;
#pragma unroll 8
        for (int d = 0; d < 128; d += 2) acc = __builtin_amdgcn_mfma_f32_32x32x2f32(ap[d], bp[d], acc, 0, 0, 0);
#pragma unroll
        for (int q = 0; q < 16; ++q) { const int j = jt * 32 + 8 * (q >> 2) + 4 * hi + (q & 3);
            W[((size_t)l * 2048 + hp * 128 + j) * D + kt * 32 + r] = (bf16_t)(pk_bf16(acc[q], 0.f) & 0xffff); }
    }
}
__device__ __forceinline__ void ph_peer_cvt(const Params& P, int bid, int nblk) {
    const size_t n8 = (size_t)DEPTH * NEXP * D / 8;
    for (int w = 0; w < 2; ++w) {
        const f32x4* s = (const f32x4*)(w ? P.peer_v : P.peer_u); u32x4* d = (u32x4*)(P.ws + (w ? OFF_PV : OFF_PU));
        for (size_t i = (size_t)bid * 512 + threadIdx.x; i < n8; i += (size_t)nblk * 512) {
            const f32x4 a = __builtin_nontemporal_load(s + 2 * i), b = __builtin_nontemporal_load(s + 2 * i + 1);
            u32x4 o; o.x = pk_bf16(a.x, a.y); o.y = pk_bf16(a.z, a.w); o.z = pk_bf16(b.x, b.y); o.w = pk_bf16(b.z, b.w); d[i] = o; }
    }
}

__device__ __forceinline__ void ph_norm(const Params& P, int l, int which, int bid, int nblk) {
    const int wid = __builtin_amdgcn_readfirstlane(threadIdx.x >> 6), lane = threadIdx.x & 63;
    const float* gain = (which ? P.norm_ffn : P.norm_mix) + l * D;
    bf16_t* HB = (bf16_t*)(P.ws + OFF_HB);
    for (int row = bid * 8 + wid; row < NT; row += nblk * 8) {
        const float* xr = xrow_ptr(P, row); const int r = mod_r(row);
        const float* sh = mod_ptr(P, l, r, which ? 3 : 0); const float* sc = mod_ptr(P, l, r, which ? 4 : 1);
        f32x4 v[4]; float ss = 0.f;
#pragma unroll
        for (int i = 0; i < 4; ++i) { v[i] = *(const f32x4*)(xr + i * 256 + lane * 4); ss += v[i].x * v[i].x + v[i].y * v[i].y + v[i].z * v[i].z + v[i].w * v[i].w; }
        ss = wave_sum(ss); const float rstd = rsqrtf(ss * (1.0f / D) + EPS);
#pragma unroll
        for (int i = 0; i < 4; ++i) { const int c = i * 256 + lane * 4; const f32x4 g = *(const f32x4*)(gain + c), a = *(const f32x4*)(sc + c), b = *(const f32x4*)(sh + c);
            const float o0 = v[i].x * rstd * g.x * (1.f + a.x) + b.x, o1 = v[i].y * rstd * g.y * (1.f + a.y) + b.y, o2 = v[i].z * rstd * g.z * (1.f + a.z) + b.z, o3 = v[i].w * rstd * g.w * (1.f + a.w) + b.w;
            u32x2 o; o.x = pk_bf16(o0, o1); o.y = pk_bf16(o2, o3); *(u32x2*)(HB + (size_t)row * D + c) = o; }
    }
}

template <class Epi>
__device__ __forceinline__ void sg_tile64(const bf16_t* __restrict__ A, int lda, const bf16_t* __restrict__ Bt, int ldb, int K, int row0, int col0, const Epi& E) {
    const int lane = threadIdx.x & 63, r = lane & 31, hi = lane >> 5;
    f32x16 acc[2][2];
#pragma unroll
    for (int i = 0; i < 2; ++i)
#pragma unroll
        for (int j = 0; j < 2; ++j)
#pragma unroll
            for (int q = 0; q < 16; ++q) acc[i][j][q] = 0.f;
    const bf16_t* a0 = A + (size_t)(row0 + r) * lda + hi * 8; const bf16_t* a1 = a0 + (size_t)32 * lda;
    const bf16_t* b0 = Bt + (size_t)(col0 + r) * ldb + hi * 8; const bf16_t* b1 = b0 + (size_t)32 * ldb;
    for (int k = 0; k < K; k += 16) {
        const bf16x8 fa0 = *(const bf16x8*)(a0 + k), fa1 = *(const bf16x8*)(a1 + k), fb0 = *(const bf16x8*)(b0 + k), fb1 = *(const bf16x8*)(b1 + k);
        acc[0][0] = __builtin_amdgcn_mfma_f32_32x32x16_bf16(fb0, fa0, acc[0][0], 0, 0, 0);
        acc[0][1] = __builtin_amdgcn_mfma_f32_32x32x16_bf16(fb1, fa0, acc[0][1], 0, 0, 0);
        acc[1][0] = __builtin_amdgcn_mfma_f32_32x32x16_bf16(fb0, fa1, acc[1][0], 0, 0, 0);
        acc[1][1] = __builtin_amdgcn_mfma_f32_32x32x16_bf16(fb1, fa1, acc[1][1], 0, 0, 0);
    }
#pragma unroll
    for (int i = 0; i < 2; ++i)
#pragma unroll
        for (int j = 0; j < 2; ++j)
#pragma unroll
            for (int g = 0; g < 4; ++g) E(row0 + i * 32 + r, col0 + j * 32 + 8 * g + 4 * hi, (f32x4){acc[i][j][4 * g], acc[i][j][4 * g + 1], acc[i][j][4 * g + 2], acc[i][j][4 * g + 3]});
}
template <class Epi>
__device__ __forceinline__ void sgemm(const bf16_t* A, int lda, const bf16_t* Bt, int ldb, int M, int N, int K, const Epi& E, int bid, int nblk) {
    const int wid = __builtin_amdgcn_readfirstlane(threadIdx.x >> 6); const int tn = N / 64, nt = (M / 64) * tn;
    for (int t = bid * 8 + wid; t < nt; t += nblk * 8) sg_tile64(A, lda, Bt, ldb, K, (t / tn) * 64, (t % tn) * 64, E);
}

__device__ __forceinline__ void st_bf16x4(bf16_t* p, f32x4 v) { u32x2 o; o.x = pk_bf16(v.x, v.y); o.y = pk_bf16(v.z, v.w); *(u32x2*)p = o; }

struct Epi1 {
    unsigned char* ws;
    __device__ __forceinline__ void operator()(int row, int col, f32x4 v) const {
        if (col < 256) st_bf16x4((bf16_t*)(ws + OFF_PP) + (size_t)row * 256 + col, v);
        else if (col < 768) st_bf16x4((bf16_t*)(ws + OFF_QR) + (size_t)row * 512 + (col - 256), v);
        else if (col < 896) st_bf16x4((bf16_t*)(ws + OFF_KALL) + (size_t)kv_row(row) * 128 + (col - 768), v);
        else if (col < 1024) st_bf16x4((bf16_t*)(ws + OFF_VALL) + (size_t)kv_row(row) * 128 + (col - 896), v);
        else { f32x4 s = {sigmoidf_(v.x), sigmoidf_(v.y), sigmoidf_(v.z), sigmoidf_(v.w)}; st_bf16x4((bf16_t*)(ws + OFF_GT) + (size_t)row * 3072 + (col - 1024), s); }
    }
};
struct EpiZ {
    unsigned char* ws;
    __device__ __forceinline__ void operator()(int row, int col, f32x4 v) const {
        const int half = row >> 8, ch = row & 255;
        if (col < NL) { const int b = col >> 11, t = col & 2047; st_bf16x4((bf16_t*)(ws + OFF_ZTL) + ((size_t)(b * 256 + ch) * 4096 + half * 2048 + t), v); }
        else { const int b = (col - NL) >> 8, t = (col - NL) & 255; st_bf16x4((bf16_t*)(ws + OFF_ZTC) + ((size_t)(b * 256 + ch) * 512 + half * 256 + t), v); }
    }
};
__device__ __forceinline__ void ph_gemm1(const Params& P, int l, int bid, int nblk) {
    const bf16_t* HB = (const bf16_t*)(P.ws + OFF_HB);
    Epi1 e1{P.ws}; sgemm(HB, D, (const bf16_t*)(P.ws + OFF_W1T) + (size_t)l * 4096 * D, D, NT, 4096, D, e1, bid, nblk);
    EpiZ ez{P.ws}; sgemm((const bf16_t*)(P.ws + OFF_WFT) + (size_t)l * 512 * D, D, HB, D, 512, NT, D, ez, bid, nblk);
}

__device__ __forceinline__ void ph_l3(const Params& P, int l, int bid, int nblk) {
    const float* rc = (const float*)(P.ws + OFF_ROPE); const float* rs = rc + SEQ * 32;
    for (int i = bid * 512 + threadIdx.x; i < NT * 10; i += nblk * 512) {
        const int row = i / 10, slot = i % 10; const bool isq = slot < 8;
        bf16_t* p = isq ? (bf16_t*)(P.ws + OFF_QR) + (size_t)row * 512 + slot * 64 : (bf16_t*)(P.ws + OFF_KALL) + (size_t)kv_row(row) * 128 + (slot - 8) * 64;
        const float* gn = (isq ? P.q_norm : P.k_norm) + l * 64;
        float x[64]; float ss = 0.f;
#pragma unroll
        for (int q = 0; q < 8; ++q) { const u32x4 v = *(const u32x4*)(p + q * 8); x[8 * q] = bf_lo(v.x); x[8 * q + 1] = bf_hi(v.x); x[8 * q + 2] = bf_lo(v.y); x[8 * q + 3] = bf_hi(v.y); x[8 * q + 4] = bf_lo(v.z); x[8 * q + 5] = bf_hi(v.z); x[8 * q + 6] = bf_lo(v.w); x[8 * q + 7] = bf_hi(v.w); }
#pragma unroll
        for (int d = 0; d < 64; ++d) ss += x[d] * x[d];
        const float rstd = rsqrtf(ss * (1.0f / 64.0f) + EPS);
#pragma unroll
        for (int d = 0; d < 64; ++d) x[d] = x[d] * rstd * gn[d];
        float y[64];
        if (row < NL) { const int t = row & 2047;
#pragma unroll
            for (int hb = 0; hb < 2; ++hb)
#pragma unroll
                for (int f = 0; f < 16; ++f) { const float c = rc[t * 32 + hb * 16 + f], s = rs[t * 32 + hb * 16 + f]; const float x1 = x[hb * 32 + f], x2 = x[hb * 32 + 16 + f];
                    y[hb * 32 + f] = x1 * c - x2 * s; y[hb * 32 + 16 + f] = x2 * c + x1 * s; }
        } else {
#pragma unroll
            for (int d = 0; d < 64; ++d) y[d] = x[d];
        }
        const float sc = isq ? C2 : 1.0f;
#pragma unroll
        for (int q = 0; q < 8; ++q) { u32x4 o; o.x = pk_bf16(y[8 * q] * sc, y[8 * q + 1] * sc); o.y = pk_bf16(y[8 * q + 2] * sc, y[8 * q + 3] * sc); o.z = pk_bf16(y[8 * q + 4] * sc, y[8 * q + 5] * sc); o.w = pk_bf16(y[8 * q + 6] * sc, y[8 * q + 7] * sc); *(u32x4*)(p + q * 8) = o; }
    }
    const bf16_t* PP = (const bf16_t*)(P.ws + OFF_PP); bf16_t* MIX = (bf16_t*)(P.ws + OFF_MIX);
    for (int i = bid * 512 + threadIdx.x; i < NT * 32; i += nblk * 512) {
        const int row = i >> 5, ch = (i & 31) * 8, g = ch >> 6, win = 2 << g;
        int base, t, L; if (row < NL) { base = row & ~2047; t = row & 2047; L = SEQ; } else { base = NL + ((row - NL) & ~255); t = (row - NL) & 255; L = CTX; }
        const int lo = max(t - win / 2, 0), hi = min(t + win - win / 2, L);
        float s[8];
#pragma unroll
        for (int q = 0; q < 8; ++q) s[q] = 0.f;
        for (int tt = lo; tt < hi; ++tt) { const u32x4 v = *(const u32x4*)(PP + (size_t)(base + tt) * 256 + ch);
            s[0] += bf_lo(v.x); s[1] += bf_hi(v.x); s[2] += bf_lo(v.y); s[3] += bf_hi(v.y); s[4] += bf_lo(v.z); s[5] += bf_hi(v.z); s[6] += bf_lo(v.w); s[7] += bf_hi(v.w); }
        const float inv = 1.0f / (float)(hi - lo); const u32x4 me = *(const u32x4*)(PP + (size_t)row * 256 + ch);
        u32x4 o; o.x = pk_bf16(s[0] * inv - bf_lo(me.x), s[1] * inv - bf_hi(me.x)); o.y = pk_bf16(s[2] * inv - bf_lo(me.y), s[3] * inv - bf_hi(me.y));
        o.z = pk_bf16(s[4] * inv - bf_lo(me.z), s[5] * inv - bf_hi(me.z)); o.w = pk_bf16(s[6] * inv - bf_lo(me.w), s[7] * inv - bf_hi(me.w));
        *(u32x4*)(MIX + (size_t)row * D + 256 + ch) = o;
    }
}

struct EpiRe { bf16_t* dst;
    __device__ __forceinline__ void operator()(int row, int col, f32x4 v) const { st_bf16x4(dst + (size_t)row * D + col, v); } };
__device__ __forceinline__ void ph_dft(const Params& P, int bid, int nblk) {
    bf16_t* MIX = (bf16_t*)(P.ws + OFF_MIX);
    for (int b = 0; b < NB; ++b) {
        EpiRe e{MIX + (size_t)b * SEQ * D}; sgemm((const bf16_t*)(P.ws + OFF_ADFT), 4096, (const bf16_t*)(P.ws + OFF_ZTL) + (size_t)b * 256 * 4096, 4096, SEQ, 256, 4096, e, bid, nblk);
        EpiRe ec{MIX + (size_t)(NL + b * CTX) * D}; sgemm((const bf16_t*)(P.ws + OFF_ADFTC), 512, (const bf16_t*)(P.ws + OFF_ZTC) + (size_t)b * 256 * 512, 512, CTX, 256, 512, ec, bid, nblk);
    }
}

__device__ __forceinline__ void ph_attn_naive(const Params& P, int bid, int nblk) {
    const int wid = __builtin_amdgcn_readfirstlane(threadIdx.x >> 6), lane = threadIdx.x & 63;
    const bf16_t* QR = (const bf16_t*)(P.ws + OFF_QR); const bf16_t* KA = (const bf16_t*)(P.ws + OFF_KALL); const bf16_t* VA = (const bf16_t*)(P.ws + OFF_VALL); bf16_t* MIX = (bf16_t*)(P.ws + OFF_MIX);
    for (int w = bid * 8 + wid; w < 4096 + 512; w += nblk * 8) {
        int b, h, qrow, k0, k1;
        if (w < 4096) { b = w >> 8; h = (w >> 5) & 7; qrow = b * SEQ + (w & 31) * 64 + lane; k0 = 0; k1 = KV; }
        else { const int w2 = w - 4096; b = w2 >> 5; h = (w2 >> 2) & 7; qrow = NL + b * CTX + (w2 & 3) * 64 + lane; k0 = SEQ; k1 = KV; }
        float q[64], o[64];
#pragma unroll
        for (int i = 0; i < 8; ++i) { const u32x4 v = *(const u32x4*)(QR + (size_t)qrow * 512 + h * 64 + i * 8); q[8 * i] = bf_lo(v.x); q[8 * i + 1] = bf_hi(v.x); q[8 * i + 2] = bf_lo(v.y); q[8 * i + 3] = bf_hi(v.y); q[8 * i + 4] = bf_lo(v.z); q[8 * i + 5] = bf_hi(v.z); q[8 * i + 6] = bf_lo(v.w); q[8 * i + 7] = bf_hi(v.w); }
#pragma unroll
        for (int d = 0; d < 64; ++d) o[d] = 0.f;
        float m = -1e30f, lsum = 0.f;
        const bf16_t* kb = KA + ((size_t)b * KV) * 128 + (h >> 2) * 64; const bf16_t* vb = VA + ((size_t)b * KV) * 128 + (h >> 2) * 64;
        for (int j = k0; j < k1; ++j) {
            const u32x4* kr = (const u32x4*)(kb + (size_t)j * 128); float s = 0.f;
#pragma unroll
            for (int i = 0; i < 8; ++i) { const u32x4 v = kr[i]; s += q[8 * i] * bf_lo(v.x) + q[8 * i + 1] * bf_hi(v.x) + q[8 * i + 2] * bf_lo(v.y) + q[8 * i + 3] * bf_hi(v.y) + q[8 * i + 4] * bf_lo(v.z) + q[8 * i + 5] * bf_hi(v.z) + q[8 * i + 6] * bf_lo(v.w) + q[8 * i + 7] * bf_hi(v.w); }
            if (s > m) { const float f = exp2f(m - s); lsum *= f;
#pragma unroll
                for (int d = 0; d < 64; ++d) o[d] *= f;
                m = s; }
            const float p = exp2f(s - m); lsum += p;
            const u32x4* vr = (const u32x4*)(vb + (size_t)j * 128);
#pragma unroll
            for (int i = 0; i < 8; ++i) { const u32x4 v = vr[i]; o[8 * i] += p * bf_lo(v.x); o[8 * i + 1] += p * bf_hi(v.x); o[8 * i + 2] += p * bf_lo(v.y); o[8 * i + 3] += p * bf_hi(v.y); o[8 * i + 4] += p * bf_lo(v.z); o[8 * i + 5] += p * bf_hi(v.z); o[8 * i + 6] += p * bf_lo(v.w); o[8 * i + 7] += p * bf_hi(v.w); }
        }
        const float il = 1.0f / lsum;
#pragma unroll
        for (int i = 0; i < 8; ++i) { u32x4 ov; ov.x = pk_bf16(o[8 * i] * il, o[8 * i + 1] * il); ov.y = pk_bf16(o[8 * i + 2] * il, o[8 * i + 3] * il); ov.z = pk_bf16(o[8 * i + 4] * il, o[8 * i + 5] * il); ov.w = pk_bf16(o[8 * i + 6] * il, o[8 * i + 7] * il);
            *(u32x4*)(MIX + (size_t)qrow * D + 512 + h * 64 + i * 8) = ov; }
    }
}

__device__ __forceinline__ void ph_merge(const Params& P, int l, int bid, int nblk) {
    const int wid = __builtin_amdgcn_readfirstlane(threadIdx.x >> 6), lane = threadIdx.x & 63, r = lane & 31, hi = lane >> 5;
    const bf16_t* MIX = (const bf16_t*)(P.ws + OFF_MIX); const bf16_t* W = (const bf16_t*)(P.ws + OFF_WMT) + (size_t)l * D * D; const bf16_t* GT = (const bf16_t*)(P.ws + OFF_GT); bf16_t* HB = (bf16_t*)(P.ws + OFF_HB);
    const int tn = D / 64, nt = (NT / 64) * tn;
    for (int t = bid * 8 + wid; t < nt; t += nblk * 8) {
        const int row0 = (t / tn) * 64, col0 = (t % tn) * 64;
        f32x16 tot[2][2];
#pragma unroll
        for (int i = 0; i < 2; ++i)
#pragma unroll
            for (int j = 0; j < 2; ++j)
#pragma unroll
                for (int q = 0; q < 16; ++q) tot[i][j][q] = 0.f;
#pragma unroll 1
        for (int br = 0; br < 3; ++br) {
            const int ks = br == 0 ? 0 : br == 1 ? 256 : 512, ke = br == 0 ? 256 : br == 1 ? 512 : 1024;
            f32x16 acc[2][2];
#pragma unroll
            for (int i = 0; i < 2; ++i)
#pragma unroll
                for (int j = 0; j < 2; ++j)
#pragma unroll
                    for (int q = 0; q < 16; ++q) acc[i][j][q] = 0.f;
            const bf16_t* a0 = MIX + (size_t)(row0 + r) * D + hi * 8; const bf16_t* a1 = a0 + (size_t)32 * D;
            const bf16_t* b0 = W + (size_t)(col0 + r) * D + hi * 8; const bf16_t* b1 = b0 + (size_t)32 * D;
#pragma unroll 2
            for (int k = ks; k < ke; k += 16) {
                const bf16x8 fa0 = *(const bf16x8*)(a0 + k), fa1 = *(const bf16x8*)(a1 + k), fb0 = *(const bf16x8*)(b0 + k), fb1 = *(const bf16x8*)(b1 + k);
                acc[0][0] = __builtin_amdgcn_mfma_f32_32x32x16_bf16(fb0, fa0, acc[0][0], 0, 0, 0);
                acc[0][1] = __builtin_amdgcn_mfma_f32_32x32x16_bf16(fb1, fa0, acc[0][1], 0, 0, 0);
                acc[1][0] = __builtin_amdgcn_mfma_f32_32x32x16_bf16(fb0, fa1, acc[1][0], 0, 0, 0);
                acc[1][1] = __builtin_amdgcn_mfma_f32_32x32x16_bf16(fb1, fa1, acc[1][1], 0, 0, 0);
            }
#pragma unroll
            for (int i = 0; i < 2; ++i)
#pragma unroll
                for (int j = 0; j < 2; ++j)
#pragma unroll
                    for (int g = 0; g < 4; ++g) { const int row = row0 + i * 32 + r, col = col0 + j * 32 + 8 * g + 4 * hi;
                        const u32x2 gv = *(const u32x2*)(GT + (size_t)row * 3072 + br * 1024 + col);
                        tot[i][j][4 * g] += bf_lo(gv.x) * acc[i][j][4 * g]; tot[i][j][4 * g + 1] += bf_hi(gv.x) * acc[i][j][4 * g + 1];
                        tot[i][j][4 * g + 2] += bf_lo(gv.y) * acc[i][j][4 * g + 2]; tot[i][j][4 * g + 3] += bf_hi(gv.y) * acc[i][j][4 * g + 3]; }
        }
#pragma unroll
        for (int i = 0; i < 2; ++i)
#pragma unroll
            for (int j = 0; j < 2; ++j)
#pragma unroll
                for (int g = 0; g < 4; ++g) st_bf16x4(HB + (size_t)(row0 + i * 32 + r) * D + col0 + j * 32 + 8 * g + 4 * hi, (f32x4){tot[i][j][4 * g], tot[i][j][4 * g + 1], tot[i][j][4 * g + 2], tot[i][j][4 * g + 3]});
    }
}

struct EpiOut { float* out; unsigned char* ws; int l;
    __device__ __forceinline__ void operator()(int row, int col, f32x4 v) const {
        float* xr = (row < NL ? out + (size_t)row * D : (float*)(ws + OFF_XC) + (size_t)(row - NL) * D) + col;
        const f32x4 g = *(const f32x4*)((const float*)(ws + OFF_MOD) + ((size_t)(l * 17 + mod_r(row)) * 6 + 2) * D + col); f32x4 x = *(const f32x4*)xr;
        x.x += g.x * v.x; x.y += g.y * v.y; x.z += g.z * v.z; x.w += g.w * v.w; *(f32x4*)xr = x; } };
__device__ __forceinline__ void ph_out(const Params& P, int l, int bid, int nblk) {
    EpiOut e{P.out, P.ws, l}; sgemm((const bf16_t*)(P.ws + OFF_HB), D, (const bf16_t*)(P.ws + OFF_WOT) + (size_t)l * D * D, D, NT, D, D, e, bid, nblk);
}

struct EpiST { float* st;
    __device__ __forceinline__ void operator()(int row, int col, f32x4 v) const { *(f32x4*)(st + (size_t)row * NT + col) = v; } };
__device__ __forceinline__ void ph_score(const Params& P, int l, int bid, int nblk) {
    EpiST e{(float*)(P.ws + OFF_ST)}; sgemm((const bf16_t*)(P.ws + OFF_WST) + (size_t)l * 2048 * D, D, (const bf16_t*)(P.ws + OFF_HB), D, 2048, NT, D, e, bid, nblk);
}

__device__ __forceinline__ int fkey(float v) { const int b = __float_as_int(v); return b ^ ((b >> 31) & 0x7fffffff); }
__device__ __forceinline__ float kval(int k) { return __int_as_float(k ^ ((k >> 31) & 0x7fffffff)); }
__device__ __forceinline__ void ins16(int (&l)[16], int key) {
#pragma unroll
    for (int i = 0; i < 16; ++i) { const int hi = max(l[i], key); key = min(l[i], key); l[i] = hi; }
}
__device__ __forceinline__ void ph_topk(const Params& P, int bid, int nblk, unsigned char* lds) {
    const int wid = __builtin_amdgcn_readfirstlane(threadIdx.x >> 6), lane = threadIdx.x & 63;
    const float* ST = (const float*)(P.ws + OFF_ST); int* EID = (int*)(P.ws + OFF_EID); float* GW = (float*)(P.ws + OFF_GW);
    unsigned char* myl = lds + threadIdx.x * 36;
    for (int u = bid * 8 + wid; u < (NT / 64) * 8; u += nblk * 8) {
        const int h = u & 7, tok = (u >> 3) * 64 + lane;
        int l1[16], l2[16];
#pragma unroll
        for (int i = 0; i < 16; ++i) { l1[i] = INT_MIN; l2[i] = INT_MIN; }
        const float* s1 = ST + (size_t)(h * 256) * NT + tok; const float* s2 = s1 + (size_t)128 * NT;
        for (int j0 = 0; j0 < 128; j0 += 8) {
            float a[8], b[8];
#pragma unroll
            for (int q = 0; q < 8; ++q) { a[q] = s1[(size_t)(j0 + q) * NT]; b[q] = s2[(size_t)(j0 + q) * NT]; }
#pragma unroll
            for (int q = 0; q < 8; ++q) { ins16(l1, (fkey(a[q]) & ~127) | (127 - (j0 + q))); ins16(l2, (fkey(b[q]) & ~127) | (127 - (j0 + q))); }
        }
        float v1[16], v2[16];
#pragma unroll
        for (int i = 0; i < 16; ++i) { v1[i] = kval((l1[i] & ~127) | 64); v2[i] = kval((l2[i] & ~127) | 64); myl[i] = (unsigned char)(127 - (l1[i] & 127)); myl[16 + i] = (unsigned char)(127 - (l2[i] & 127)); }
        int l3[16];
#pragma unroll
        for (int i = 0; i < 16; ++i) l3[i] = INT_MIN;
#pragma unroll
        for (int i = 0; i < 16; ++i)
#pragma unroll
            for (int j = 0; j < 16; ++j) if ((i + 1) * (j + 1) <= 16) ins16(l3, (fkey(v1[i] + v2[j]) & ~255) | (255 - (i * 16 + j)));
        float t[16]; float sum = 0.f; const float t0 = kval((l3[0] & ~255) | 128);
#pragma unroll
        for (int k = 0; k < 16; ++k) { t[k] = __expf(kval((l3[k] & ~255) | 128) - t0); sum += t[k]; }
        const float inv = 1.0f / sum;
        int e[16];
#pragma unroll
        for (int k = 0; k < 16; ++k) { const int pos = 255 - (l3[k] & 255); e[k] = (int)myl[pos >> 4] * 128 + (int)myl[16 + (pos & 15)]; t[k] *= inv; }
#pragma unroll
        for (int k = 0; k < 16; k += 4) { *(int4*)(EID + (size_t)tok * 128 + h * 16 + k) = make_int4(e[k], e[k + 1], e[k + 2], e[k + 3]); *(f32x4*)(GW + (size_t)tok * 128 + h * 16 + k) = (f32x4){t[k], t[k + 1], t[k + 2], t[k + 3]}; }
    }
}

__device__ __forceinline__ void ph_gather(const Params& P, int l, int bid, int nblk) {
    const int wid = __builtin_amdgcn_readfirstlane(threadIdx.x >> 6), lane = threadIdx.x & 63;
    const bf16_t* HB = (const bf16_t*)(P.ws + OFF_HB); const int* EID = (const int*)(P.ws + OFF_EID); const float* GW = (const float*)(P.ws + OFF_GW);
    const bf16_t* PU = (const bf16_t*)(P.ws + OFF_PU) + (size_t)l * NEXP * D; const bf16_t* PV = (const bf16_t*)(P.ws + OFF_PV) + (size_t)l * NEXP * D;
    for (int tok = bid * 8 + wid; tok < NT; tok += nblk * 8) {
        const u32x4* xr = (const u32x4*)(HB + (size_t)tok * D); const u32x4 xa = xr[lane], xb = xr[64 + lane];
        float o[16];
#pragma unroll
        for (int i = 0; i < 16; ++i) o[i] = 0.f;
        for (int grp = 0; grp < 16; ++grp) {
            int id[8]; float g[8];
#pragma unroll
            for (int e = 0; e < 8; ++e) { id[e] = __builtin_amdgcn_readfirstlane(EID[(size_t)tok * 128 + grp * 8 + e]); g[e] = GW[(size_t)tok * 128 + grp * 8 + e]; }
            float p[8];
#pragma unroll
            for (int e = 0; e < 8; ++e) { const u32x4* ur = (const u32x4*)(PU + (size_t)id[e] * D); p[e] = dot8(xb, ur[64 + lane], dot8(xa, ur[lane], 0.f)); }
#pragma unroll
            for (int e = 0; e < 8; ++e) { p[e] = wave_sum(p[e]); p[e] = g[e] * gelu_tanh(p[e]); }
#pragma unroll
            for (int e = 0; e < 8; ++e) { const u32x4* vr = (const u32x4*)(PV + (size_t)id[e] * D); const u32x4 va = vr[lane], vb = vr[64 + lane]; const float c = p[e];
                o[0] += c * bf_lo(va.x); o[1] += c * bf_hi(va.x); o[2] += c * bf_lo(va.y); o[3] += c * bf_hi(va.y); o[4] += c * bf_lo(va.z); o[5] += c * bf_hi(va.z); o[6] += c * bf_lo(va.w); o[7] += c * bf_hi(va.w);
                o[8] += c * bf_lo(vb.x); o[9] += c * bf_hi(vb.x); o[10] += c * bf_lo(vb.y); o[11] += c * bf_hi(vb.y); o[12] += c * bf_lo(vb.z); o[13] += c * bf_hi(vb.z); o[14] += c * bf_lo(vb.w); o[15] += c * bf_hi(vb.w); }
        }
        float* xp = xrow_ptr(P, tok); const float* m5 = mod_ptr(P, l, mod_r(tok), 5);
#pragma unroll
        for (int hh = 0; hh < 2; ++hh)
#pragma unroll
            for (int q = 0; q < 2; ++q) { const int c = hh * 512 + lane * 8 + q * 4; const f32x4 g = *(const f32x4*)(m5 + c); f32x4 x = *(const f32x4*)(xp + c);
                x.x += g.x * o[hh * 8 + q * 4]; x.y += g.y * o[hh * 8 + q * 4 + 1]; x.z += g.z * o[hh * 8 + q * 4 + 2]; x.w += g.w * o[hh * 8 + q * 4 + 3]; *(f32x4*)(xp + c) = x; }
    }
}

enum { PH_INITX, PH_SILU, PH_TABLES, PH_MOD, PH_WTRANS, PH_WFT, PH_WPOOL, PH_WST, PH_PEERCVT, PH_NORM1, PH_GEMM1, PH_L3, PH_DFT, PH_ATTN, PH_MERGE, PH_OUT, PH_NORM2, PH_SCORE, PH_TOPK, PH_GATHER };
template <int PH> __global__ void __launch_bounds__(512) k_phase(Params P, int l) {
    __shared__ __attribute__((aligned(16))) float lds[8 * 17 * 64 + 64];
    const int bid = blockIdx.x, nblk = gridDim.x;
    if (PH == PH_INITX) ph_init_x(P, bid, nblk);
    if (PH == PH_SILU) ph_silu_c(P, bid, nblk);
    if (PH == PH_TABLES) ph_tables(P, bid, nblk);
    if (PH == PH_MOD) ph_mod(P, bid, nblk, lds);
    if (PH == PH_WTRANS) ph_wtrans(P, bid, nblk, lds);
    if (PH == PH_WFT) ph_wft(P, bid, nblk, lds);
    if (PH == PH_WPOOL) ph_wpool(P, bid, nblk);
    if (PH == PH_WST) ph_wst(P, bid, nblk);
    if (PH == PH_PEERCVT) ph_peer_cvt(P, bid, nblk);
    if (PH == PH_NORM1) ph_norm(P, l, 0, bid, nblk);
    if (PH == PH_GEMM1) ph_gemm1(P, l, bid, nblk);
    if (PH == PH_L3) ph_l3(P, l, bid, nblk);
    if (PH == PH_DFT) ph_dft(P, bid, nblk);
    if (PH == PH_ATTN) ph_attn_naive(P, bid, nblk);
    if (PH == PH_MERGE) ph_merge(P, l, bid, nblk);
    if (PH == PH_OUT) ph_out(P, l, bid, nblk);
    if (PH == PH_NORM2) ph_norm(P, l, 1, bid, nblk);
    if (PH == PH_SCORE) ph_score(P, l, bid, nblk);
    if (PH == PH_TOPK) ph_topk(P, bid, nblk, (unsigned char*)lds);
    if (PH == PH_GATHER) ph_gather(P, l, bid, nblk);
}

extern "C" void kernel_launch(void* const* d_in, const int* in_sizes, int n_in, void* d_out, int out_size, void* d_ws, size_t ws_size, hipStream_t stream) {
    Params P{};
    const float** f = (const float**)&P;
    for (int i = 0; i < 21; ++i) f[i] = (const float*)d_in[i];
    P.out = (float*)d_out; P.ws = (unsigned char*)d_ws;
    const int G = 1024;
#define LAUNCH(PH, l) hipLaunchKernelGGL(k_phase<PH>, dim3(G), dim3(512), 0, stream, P, l)
    LAUNCH(PH_INITX, 0); LAUNCH(PH_SILU, 0); LAUNCH(PH_TABLES, 0); LAUNCH(PH_MOD, 0); LAUNCH(PH_WTRANS, 0); LAUNCH(PH_WFT, 0); LAUNCH(PH_WPOOL, 0); LAUNCH(PH_WST, 0); LAUNCH(PH_PEERCVT, 0);
    for (int l = 0; l < DEPTH; ++l) {
        LAUNCH(PH_NORM1, l); LAUNCH(PH_GEMM1, l); LAUNCH(PH_L3, l); LAUNCH(PH_DFT, l); LAUNCH(PH_ATTN, l); LAUNCH(PH_MERGE, l); LAUNCH(PH_OUT, l);
        LAUNCH(PH_NORM2, l); LAUNCH(PH_SCORE, l); LAUNCH(PH_TOPK, l); LAUNCH(PH_GATHER, l);
    }
#undef LAUNCH
}
```

```cpp
#include <hip/hip_runtime.h>
#include <stdint.h>
#include <hip/hip_bf16.h>
#include <cmath>

typedef unsigned short bf16_t;
typedef short bf16x8 __attribute__((ext_vector_type(8)));
typedef float f32x4 __attribute__((ext_vector_type(4)));
typedef float f32x16 __attribute__((ext_vector_type(16)));
typedef unsigned u32x4 __attribute__((ext_vector_type(4)));
typedef unsigned u32x2 __attribute__((ext_vector_type(2)));
typedef float f32x2_t __attribute__((ext_vector_type(2)));
typedef __bf16 bf16x2_t __attribute__((ext_vector_type(2)));
typedef int i32x8 __attribute__((ext_vector_type(8)));
typedef int i32x4_ __attribute__((ext_vector_type(4)));
constexpr int SIGLUT_OFF = 131072 + 1024;
constexpr float G8_SCALE = 64.0f;

constexpr int D = 1024, NB = 16, SEQ = 2048, DEPTH = 4, CTX = 256;
constexpr int NL = NB * SEQ, NC = NB * CTX, NT = NL + NC;
constexpr int INC = 4352;
constexpr int KV = SEQ + CTX;
constexpr int NEXP = 16384;
constexpr float C2 = 0.125f * 1.4426950408889634f;
constexpr float EPS = 1e-6f;

constexpr size_t MiB = 1u << 20;
constexpr size_t OFF_CTL = 0;
constexpr size_t OFF_MOD = 1 * MiB;
constexpr size_t OFF_SC = 3 * MiB + 512 * 1024;
constexpr size_t OFF_ROPE = 3 * MiB;
constexpr size_t OFF_XC = 4 * MiB;
constexpr size_t OFF_HB = 20 * MiB;
constexpr size_t OFF_MIX = 92 * MiB;
constexpr size_t OFF_KALL = 164 * MiB;
constexpr size_t OFF_VALL = 173 * MiB;
constexpr size_t OFF_EID = 182 * MiB;
constexpr size_t OFF_GW = 200 * MiB;
constexpr size_t OFF_GT = 218 * MiB;
constexpr size_t OFF_QR = 434 * MiB;
constexpr size_t OFF_ZTL = 470 * MiB;
constexpr size_t OFF_ZTC = 502 * MiB;
constexpr size_t OFF_PP = 506 * MiB;
constexpr size_t OFF_ST = 218 * MiB;
constexpr size_t OFF_W1T = 524 * MiB;
constexpr size_t OFF_WFT = 556 * MiB;
constexpr size_t OFF_WMT = 560 * MiB;
constexpr size_t OFF_WOT = 568 * MiB;
constexpr size_t OFF_WST = 576 * MiB;
constexpr size_t OFF_ADFT = 592 * MiB;
constexpr size_t OFF_ADFTC = 608 * MiB;
constexpr size_t OFF_PU = 609 * MiB;
constexpr size_t OFF_PV = 737 * MiB;
constexpr size_t OFF_WG8 = 866 * MiB;
constexpr size_t OFF_HB8 = 880 * MiB;
constexpr size_t WS_END = 916 * MiB;

struct Params {
    const float *x, *c, *ctx, *c_ctx, *ada_w, *ada_b, *norm_mix, *w_in, *fourier_w, *pool_w, *pool_scale, *pool_proj, *q_norm, *k_norm,
        *attn_proj, *w_out, *norm_ffn, *peer_wq, *peer_keys, *peer_u, *peer_v;
    float* out;
    unsigned char* ws;
};

__device__ __forceinline__ unsigned pk_bf16(float lo, float hi) { f32x2_t v = {lo, hi}; bf16x2_t b = __builtin_convertvector(v, bf16x2_t); return __builtin_bit_cast(unsigned, b); }
__device__ __forceinline__ float bf_lo(unsigned u) { return __uint_as_float(u << 16); }
__device__ __forceinline__ float bf_hi(unsigned u) { return __uint_as_float(u & 0xffff0000u); }
__device__ __forceinline__ float sigmoidf_(float x) { return __builtin_amdgcn_rcpf(1.0f + __expf(-x)); }
__device__ __forceinline__ float gelu_tanh(float x) { const float y = 0.7978845608028654f * (x + 0.044715f * x * x * x); const float t = 1.0f - 2.0f * __builtin_amdgcn_rcpf(1.0f + __expf(2.0f * y)); return 0.5f * x * (1.0f + t); }
template <int CTRL> __device__ __forceinline__ float dpp_f(float v) { return __builtin_bit_cast(float, __builtin_amdgcn_update_dpp(0, __builtin_bit_cast(int, v), CTRL, 0xF, 0xF, true)); }
#define DPP_F(v, ctrl) dpp_f<(ctrl)>(v)
__device__ __forceinline__ float xsum16(float v) { const unsigned u = __builtin_bit_cast(unsigned, v); auto r = __builtin_amdgcn_permlane16_swap(u, u, false, false); return __builtin_bit_cast(float, (unsigned)r[0]) + __builtin_bit_cast(float, (unsigned)r[1]); }
__device__ __forceinline__ float xsum32(float v) { const unsigned u = __builtin_bit_cast(unsigned, v); auto r = __builtin_amdgcn_permlane32_swap(u, u, false, false); return __builtin_bit_cast(float, (unsigned)r[0]) + __builtin_bit_cast(float, (unsigned)r[1]); }
__device__ __forceinline__ float sum8(float v) { v += DPP_F(v, 0xB1); v += DPP_F(v, 0x4E); v += DPP_F(v, 0x141); return v; }
__device__ __forceinline__ float wave_sum(float v) { v = sum8(v); v += DPP_F(v, 0x140); v = xsum16(v); return xsum32(v); }
__device__ __forceinline__ int tidx() { int t = threadIdx.x; asm volatile("" : "+v"(t)); return t; }
__device__ __forceinline__ float dot2bf(unsigned a, unsigned b, float acc) { return __builtin_amdgcn_fdot2_f32_bf16(__builtin_bit_cast(bf16x2_t, a), __builtin_bit_cast(bf16x2_t, b), acc, false); }
__device__ __forceinline__ float dot8(u32x4 a, u32x4 b, float acc) {
    const unsigned a0 = a.x, a1 = a.y, a2 = a.z, a3 = a.w, b0 = b.x, b1 = b.y, b2 = b.z, b3 = b.w;
    acc = dot2bf(a0, b0, acc); acc = dot2bf(a1, b1, acc); acc = dot2bf(a2, b2, acc); acc = dot2bf(a3, b3, acc);
    return acc;
}
__device__ __forceinline__ float* xrow_ptr(const Params& P, int row) { return row < NL ? P.out + (size_t)row * D : (float*)(P.ws + OFF_XC) + (size_t)(row - NL) * D; }
__device__ __forceinline__ int mod_r(int row) { return row < NL ? (row >> 11) : 16; }
__device__ __forceinline__ const float* mod_ptr(const Params& P, int l, int r, int j) { return (const float*)(P.ws + OFF_MOD) + ((size_t)(l * 17 + r) * 6 + j) * D; }
__device__ __forceinline__ int kv_row(int row) { return row < NL ? (row >> 11) * KV + (row & 2047) : ((row - NL) >> 8) * KV + SEQ + ((row - NL) & 255); }

__device__ __forceinline__ void ph_tables(const Params& P, int bid, int nblk) {
    const int TID = tidx();
    float* rc = (float*)(P.ws + OFF_ROPE); float* rs = rc + SEQ * 32;
    for (int i = bid * 512 + TID; i < SEQ * 32; i += nblk * 512) {
        const int t = i >> 5, f = i & 31; const float pos = (float)(f < 16 ? (t >> 6) : (t & 63));
        const float inv = powf(10000.0f, -(float)(f & 15) / 16.0f); const float ang = pos * inv;
        float s, c; sincosf(ang, &s, &c); rc[i] = c; rs[i] = s;
    }
    bf16_t* A = (bf16_t*)(P.ws + OFF_ADFT);
    for (size_t i = (size_t)bid * 512 + TID; i < (size_t)2048 * 2048; i += (size_t)nblk * 512) {
        const int kp = (int)(i >> 11), t = (int)(i & 2047); const int m = (kp * t) & 2047;
        float s, c; sincospif((float)m * (1.0f / 1024.0f), &s, &c);
        A[(size_t)kp * 4096 + t] = (bf16_t)(pk_bf16(c, 0.f) & 0xffff); A[(size_t)kp * 4096 + 2048 + t] = (bf16_t)(pk_bf16(-s, 0.f) & 0xffff);
    }
    bf16_t* Ac = (bf16_t*)(P.ws + OFF_ADFTC);
    for (int i = bid * 512 + TID; i < 256 * 256; i += nblk * 512) {
        const int kp = i >> 8, t = i & 255; const int m = (kp * t) & 255;
        float s, c; sincospif((float)m * (1.0f / 128.0f), &s, &c);
        Ac[kp * 512 + t] = (bf16_t)(pk_bf16(c, 0.f) & 0xffff); Ac[kp * 512 + 256 + t] = (bf16_t)(pk_bf16(-s, 0.f) & 0xffff);
    }
}
__device__ __forceinline__ void ph_mod(const Params& P, int bid, int nblk, float* lds) {
    const int TID = tidx();
    const int tid = TID, c4 = tid & 7, ks = tid >> 3, lane = tid & 63, wid = tid >> 6;
    float* mod = (float*)(P.ws + OFF_MOD);
    float* lsc = lds;
    float* red = lds + 17 * D;
    __syncthreads();
    for (int i = tid; i < 17 * D; i += 512) { const float v = i < 16 * D ? P.c[i] : P.c_ctx[i - 16 * D]; lsc[i] = v * sigmoidf_(v); }
    __syncthreads();
    for (int u = bid; u < DEPTH * 192; u += nblk) {
        const int l = u / 192;
        f32x4 acc[17];
#pragma unroll
        for (int r = 0; r < 17; ++r) acc[r] = (f32x4){0.f, 0.f, 0.f, 0.f};
        const float* w = P.ada_w + ((size_t)l * D + ks * 16) * 6144 + (u % 192) * 32 + c4 * 4;
        f32x4 wv[16];
#pragma unroll
        for (int q = 0; q < 16; ++q) wv[q] = *(const f32x4*)(w + (size_t)q * 6144);
#pragma unroll
        for (int q4 = 0; q4 < 4; ++q4)
#pragma unroll
            for (int r = 0; r < 17; ++r) { const f32x4 cc = *(const f32x4*)(lsc + r * D + ks * 16 + 4 * q4);
                acc[r] += cc.x * wv[4 * q4] + cc.y * wv[4 * q4 + 1] + cc.z * wv[4 * q4 + 2] + cc.w * wv[4 * q4 + 3]; }
#pragma unroll
        for (int r = 0; r < 17; ++r)
#pragma unroll
            for (int e = 0; e < 4; ++e) { float v = acc[r][e]; v += dpp_f<0x128>(v);
                auto sw = __builtin_amdgcn_permlane16_swap(__builtin_bit_cast(unsigned, v), __builtin_bit_cast(unsigned, v), false, false);
                acc[r][e] = __builtin_bit_cast(float, (unsigned)sw[0]) + __builtin_bit_cast(float, (unsigned)sw[1]); }
        __syncthreads();
        if ((lane & 24) == 0) { const int g = wid * 2 + (lane >> 5);
#pragma unroll
            for (int r = 0; r < 17; ++r) *(f32x4*)(red + (g * 17 + r) * 32 + c4 * 4) = acc[r]; }
        __syncthreads();
        for (int i = tid; i < 17 * 32; i += 512) { const int r = i >> 5, c = i & 31; float sum = 0.f;
#pragma unroll
            for (int q = 0; q < 16; ++q) sum += red[(q * 17 + r) * 32 + c];
            const int jj = (u % 192) * 32 + c; mod[(size_t)(l * 17 + r) * 6144 + jj] = sum + P.ada_b[l * 6144 + jj]; }
    }
}
__device__ __forceinline__ void tr_cvt_tile_w(const float* src, int ldn, bf16_t* dst, int ldk, int N, int tile, float* lw, int lane) {
    const int tn = N / 64; const int k0 = (tile / tn) * 32, n0 = (tile % tn) * 64;
    float v[32];
#pragma unroll
    for (int kk = 0; kk < 32; ++kk) v[kk] = src[(size_t)(k0 + kk) * ldn + n0 + lane];
#pragma unroll
    for (int kk = 0; kk < 32; ++kk) lw[kk * 65 + lane] = v[kk];
    asm volatile("s_waitcnt lgkmcnt(0)" ::: "memory");
#pragma unroll
    for (int it = 0; it < 4; ++it) { const int row = it * 16 + (lane >> 2), ch = (lane & 3) * 8; u32x4 o;
        o.x = pk_bf16(lw[(ch + 0) * 65 + row], lw[(ch + 1) * 65 + row]); o.y = pk_bf16(lw[(ch + 2) * 65 + row], lw[(ch + 3) * 65 + row]);
        o.z = pk_bf16(lw[(ch + 4) * 65 + row], lw[(ch + 5) * 65 + row]); o.w = pk_bf16(lw[(ch + 6) * 65 + row], lw[(ch + 7) * 65 + row]);
        *(u32x4*)(dst + (size_t)(n0 + row) * ldk + k0 + ch) = o; }
    asm volatile("s_waitcnt lgkmcnt(0)" ::: "memory");
}
__device__ __forceinline__ void ph_wtrans(const Params& P, int bid, int nblk, float* lds) {
    const int TID = tidx(); const int wid = __builtin_amdgcn_readfirstlane(TID >> 6), lane = TID & 63;
    float* lw = lds + wid * (32 * 65);
    __syncthreads();
    for (int u = bid * 8 + wid; u < DEPTH * 2944; u += nblk * 8) {
        const int l = u / 2944; int t = u % 2944;
        if (t < 2048) tr_cvt_tile_w(P.w_in + (size_t)l * D * INC + 256, INC, (bf16_t*)(P.ws + OFF_W1T) + (size_t)l * 4096 * D, D, 4096, t, lw, lane);
        else if (t < 2560) tr_cvt_tile_w(P.w_out + (size_t)l * D * D, D, (bf16_t*)(P.ws + OFF_WOT) + (size_t)l * D * D, D, D, t - 2048, lw, lane);
        else if (t < 2688) tr_cvt_tile_w(P.fourier_w + (size_t)l * 256 * D, D, (bf16_t*)(P.ws + OFF_WMT) + (size_t)l * D * D, D, D, t - 2560, lw, lane);
        else tr_cvt_tile_w(P.attn_proj + (size_t)l * 512 * D, D, (bf16_t*)(P.ws + OFF_WMT) + (size_t)l * D * D + 512, D, D, t - 2688, lw, lane);
    }
    __syncthreads();
}
__device__ __forceinline__ void ph_wft(const Params& P, int bid, int nblk, float* lds) {
    const int TID = tidx();
    const int tid = TID, lane = TID & 63, r = lane & 31, hi = lane >> 5; const int wid = __builtin_amdgcn_readfirstlane(TID >> 6);
    __syncthreads();
    if (tid < 64) { float s, c; sincospif((float)tid * (1.0f / 32.0f), &s, &c); lds[tid] = c; lds[64 + tid] = s; }
    __syncthreads();
    bf16_t* W = (bf16_t*)(P.ws + OFF_WFT);
    for (int u = bid * 8 + wid; u < DEPTH * 512; u += nblk * 8) {
        const int kt = u & 31, jt = (u >> 5) & 1, part = (u >> 6) & 1, g = (u >> 7) & 3, l = u >> 9;
        const float* tab = lds + part * 64; const int j = jt * 32 + r;
        const float* bp = P.w_in + ((size_t)l * D + kt * 32 + r) * INC + g * 64;
        f32x4 bv[16];
#pragma unroll
        for (int q = 0; q < 16; ++q) bv[q] = *(const f32x4*)(bp + 4 * q);
        f32x16 acc;
#pragma unroll
        for (int q = 0; q < 16; ++q) acc[q] = 0.f;
#pragma unroll
        for (int s2 = 0; s2 < 32; ++s2) { const float a = tab[((2 * s2 + hi) * j) & 63]; const f32x4 b4 = bv[s2 >> 1];
            const float bb = (s2 & 1) ? (hi ? b4.w : b4.z) : (hi ? b4.y : b4.x);
            acc = __builtin_amdgcn_mfma_f32_32x32x2f32(a, bb, acc, 0, 0, 0); }
#pragma unroll
        for (int q = 0; q < 16; ++q) { const int jj = jt * 32 + 8 * (q >> 2) + 4 * hi + (q & 3);
            W[((size_t)l * 512 + part * 256 + g * 64 + jj) * D + kt * 32 + r] = (bf16_t)(pk_bf16(acc[q], 0.f) & 0xffff); }
    }
    __syncthreads();
}
__device__ __forceinline__ unsigned pk_fp8x4(float a, float b, float c, float d) { int w = __builtin_amdgcn_cvt_pk_fp8_f32(a, b, 0, false); w = __builtin_amdgcn_cvt_pk_fp8_f32(c, d, w, true); return (unsigned)w; }
__device__ __forceinline__ void ph_wg8(const Params& P, int bid, int nblk, float* lds) {
    const int TID = tidx(); const int wid = __builtin_amdgcn_readfirstlane(TID >> 6), lane = TID & 63;
    float* lw = lds + wid * (32 * 65);
    __syncthreads();
    for (int u = bid * 8 + wid; u < DEPTH * 1536; u += nblk * 8) {
        const int l = u / 1536, t = u % 1536; const int k0 = (t / 48) * 32, n0 = (t % 48) * 64;
        const float* src = P.w_in + (size_t)l * D * INC + 1280; unsigned char* dst = P.ws + OFF_WG8 + (size_t)l * 3072 * D;
        float v[32];
#pragma unroll
        for (int kk = 0; kk < 32; ++kk) v[kk] = src[(size_t)(k0 + kk) * INC + n0 + lane];
#pragma unroll
        for (int kk = 0; kk < 32; ++kk) lw[kk * 65 + lane] = v[kk] * G8_SCALE;
        asm volatile("s_waitcnt lgkmcnt(0)" ::: "memory");
#pragma unroll
        for (int it = 0; it < 2; ++it) { const int row = it * 32 + (lane >> 1), ch = (lane & 1) * 16; u32x4 o;
            o.x = pk_fp8x4(lw[(ch + 0) * 65 + row], lw[(ch + 1) * 65 + row], lw[(ch + 2) * 65 + row], lw[(ch + 3) * 65 + row]);
            o.y = pk_fp8x4(lw[(ch + 4) * 65 + row], lw[(ch + 5) * 65 + row], lw[(ch + 6) * 65 + row], lw[(ch + 7) * 65 + row]);
            o.z = pk_fp8x4(lw[(ch + 8) * 65 + row], lw[(ch + 9) * 65 + row], lw[(ch + 10) * 65 + row], lw[(ch + 11) * 65 + row]);
            o.w = pk_fp8x4(lw[(ch + 12) * 65 + row], lw[(ch + 13) * 65 + row], lw[(ch + 14) * 65 + row], lw[(ch + 15) * 65 + row]);
            *(u32x4*)(dst + (size_t)(n0 + row) * D + k0 + ch) = o; }
        asm volatile("s_waitcnt lgkmcnt(0)" ::: "memory");
    }
    __syncthreads();
}
__device__ __forceinline__ void ph_wpool(const Params& P, int bid, int nblk, float* lds) {
    const int TID = tidx();
    bf16_t* W = (bf16_t*)(P.ws + OFF_WMT);
    for (int u = bid; u < DEPTH * 4 * 16; u += nblk) {
        const int nc = u & 15, g = (u >> 4) & 3, l = u >> 6; const int n = nc * 64 + (TID & 63), c0 = (TID >> 6) * 8;
        __syncthreads();
        for (int i = TID; i < 64 * 64; i += 512) lds[i] = P.pool_w[(size_t)(l * 4 + g) * 4096 + i];
        __syncthreads();
        float pr[64];
#pragma unroll
        for (int e = 0; e < 64; ++e) pr[e] = P.pool_proj[((size_t)l * 256 + g * 64 + e) * D + n] * P.pool_scale[l * 256 + g * 64 + e];
        float a[8];
#pragma unroll
        for (int c = 0; c < 8; ++c) { a[c] = 0.f;
#pragma unroll
            for (int e = 0; e < 64; ++e) a[c] += lds[(c0 + c) * 64 + e] * pr[e]; }
        u32x4 o; o.x = pk_bf16(a[0], a[1]); o.y = pk_bf16(a[2], a[3]); o.z = pk_bf16(a[4], a[5]); o.w = pk_bf16(a[6], a[7]);
        *(u32x4*)(W + ((size_t)l * D + n) * D + 256 + g * 64 + c0) = o;
    }
}
__device__ __forceinline__ void ph_wst(const Params& P, int bid, int nblk, int l0, int l1) {
    const int TID = tidx();
    bf16_t* W = (bf16_t*)(P.ws + OFF_WST);
    const int wid = __builtin_amdgcn_readfirstlane(TID >> 6), lane = TID & 63, r = lane & 31, hi = lane >> 5;
    for (int u = l0 * 2048 + bid * 8 + wid; u < l1 * 2048; u += nblk * 8) {
        const int kt = u & 31, jt = (u >> 5) & 3, hp = (u >> 7) & 15, l = u >> 11;
        const float* ap = P.peer_keys + ((size_t)(l * 16 + hp) * 128 + jt * 32 + r) * 128;
        const float* bp = P.peer_wq + ((size_t)l * D + kt * 32 + r) * 2048 + hp * 128;
        f32x16 acc;
#pragma unroll
        for (int q = 0; q < 16; ++q) acc[q] = 0.f;
#pragma unroll 1
        for (int q0 = 0; q0 < 32; q0 += 8) { f32x4 av[8], bv[8];
#pragma unroll
            for (int q = 0; q < 8; ++q) { av[q] = *(const f32x4*)(ap + 4 * (q0 + q)); bv[q] = *(const f32x4*)(bp + 4 * (q0 + q)); }
#pragma unroll
            for (int q = 0; q < 8; ++q) {
                acc = __builtin_amdgcn_mfma_f32_32x32x2f32(hi ? av[q].y : av[q].x, hi ? bv[q].y : bv[q].x, acc, 0, 0, 0);
                acc = __builtin_amdgcn_mfma_f32_32x32x2f32(hi ? av[q].w : av[q].z, hi ? bv[q].w : bv[q].z, acc, 0, 0, 0); } }
#pragma unroll
        for (int q = 0; q < 16; ++q) { const int j = jt * 32 + 8 * (q >> 2) + 4 * hi + (q & 3);
            W[((size_t)l * 2048 + hp * 128 + j) * D + kt * 32 + r] = (bf16_t)(pk_bf16(acc[q], 0.f) & 0xffff); }
    }
}
constexpr float U_SCALE = 64.0f, V_SCALE = 8.0f;
__device__ __forceinline__ void ph_peer_cvt(const Params& P, int bid, int nblk, int l0, int l1, int w0 = 0, int w1 = 2) {
    const int TID = tidx();
    const size_t per = (size_t)NEXP * D / 16, nbeg = (size_t)l0 * per, n16 = (size_t)l1 * per;
    for (int w = w0; w < w1; ++w) {
        const f32x4* s = (const f32x4*)(w ? P.peer_v : P.peer_u); unsigned char* d = P.ws + (w ? OFF_PV : OFF_PU); const float sc = w ? V_SCALE : U_SCALE;
        for (size_t i = nbeg + (size_t)bid * 512 + TID; i < n16; i += (size_t)nblk * 512) {
            const f32x4 a = __builtin_nontemporal_load(s + 4 * i), b = __builtin_nontemporal_load(s + 4 * i + 1), c = __builtin_nontemporal_load(s + 4 * i + 2), e4 = __builtin_nontemporal_load(s + 4 * i + 3);
            u32x4 o; o.x = pk_fp8x4(a.x * sc, a.y * sc, a.z * sc, a.w * sc); o.y = pk_fp8x4(b.x * sc, b.y * sc, b.z * sc, b.w * sc); o.z = pk_fp8x4(c.x * sc, c.y * sc, c.z * sc, c.w * sc); o.w = pk_fp8x4(e4.x * sc, e4.y * sc, e4.z * sc, e4.w * sc);
            const size_t row = i >> 6; const int c16 = (int)(i & 63);
            const size_t l = row >> 14, e = row & (NEXP - 1);
            *(u32x4*)(d + (((l * 8 + (c16 >> 3)) * NEXP + e) * 128 + (c16 & 7) * 16)) = o; }
    }
}

__device__ __forceinline__ void ph_norm(const Params& P, int l, int which, int nrows, int bid, int nblk, const bool from_input = false) {
    const int TID = tidx();
    const int wid = __builtin_amdgcn_readfirstlane(TID >> 6), lane = TID & 63;
    const float* gain = (which ? P.norm_ffn : P.norm_mix) + l * D;
    bf16_t* HB = (bf16_t*)(P.ws + OFF_HB);
    f32x4 gg[4];
#pragma unroll
    for (int i = 0; i < 4; ++i) gg[i] = *(const f32x4*)(gain + i * 256 + lane * 4);
    const int stride = nblk * 8;
    for (int row0 = bid * 8 + wid; row0 < nrows; row0 += 2 * stride) {
        f32x4 v[2][4], sa[2][4], sb[2][4];
#pragma unroll
        for (int h = 0; h < 2; ++h) { const int row = min(row0 + h * stride, nrows - 1);
            const float* xr = from_input ? (row < NL ? P.x + (size_t)row * D : P.ctx + (size_t)(row - NL) * D) : xrow_ptr(P, row); const int r = mod_r(row);
            const float* sh = mod_ptr(P, l, r, which ? 3 : 0); const float* sc = mod_ptr(P, l, r, which ? 4 : 1);
#pragma unroll
            for (int i = 0; i < 4; ++i) { v[h][i] = *(const f32x4*)(xr + i * 256 + lane * 4); sa[h][i] = *(const f32x4*)(sc + i * 256 + lane * 4); sb[h][i] = *(const f32x4*)(sh + i * 256 + lane * 4); } }
        asm volatile("" : "+v"(v[0][0]), "+v"(v[0][1]), "+v"(v[0][2]), "+v"(v[0][3]), "+v"(v[1][0]), "+v"(v[1][1]), "+v"(v[1][2]), "+v"(v[1][3]));
#pragma unroll
        for (int h = 0; h < 2; ++h) { const int row = row0 + h * stride;
            float ss = 0.f;
#pragma unroll
            for (int i = 0; i < 4; ++i) ss += v[h][i].x * v[h][i].x + v[h][i].y * v[h][i].y + v[h][i].z * v[h][i].z + v[h][i].w * v[h][i].w;
            ss = wave_sum(ss); const float rstd = rsqrtf(ss * (1.0f / D) + EPS);
            if (row < nrows) {
#pragma unroll
                for (int i = 0; i < 4; ++i) { const int c = i * 256 + lane * 4; const f32x4 g = gg[i], a = sa[h][i], b = sb[h][i];
                    const float o0 = v[h][i].x * rstd * g.x * (1.f + a.x) + b.x, o1 = v[h][i].y * rstd * g.y * (1.f + a.y) + b.y, o2 = v[h][i].z * rstd * g.z * (1.f + a.z) + b.z, o3 = v[h][i].w * rstd * g.w * (1.f + a.w) + b.w;
                    u32x2 o; o.x = pk_bf16(o0, o1); o.y = pk_bf16(o2, o3); *(u32x2*)(HB + (size_t)row * D + c) = o;
                    if (!which) *(unsigned*)(P.ws + OFF_HB8 + (size_t)row * D + c) = pk_fp8x4(o0, o1, o2, o3); }
            }
        }
    }
}

__device__ __forceinline__ void ph_l3(const Params& P, int l, int bid, int nblk) {
    const int TID = tidx();
    const float* rc = (const float*)(P.ws + OFF_ROPE); const float* rs = rc + SEQ * 32;
    {
        const int sub = TID & 7; const bool hi_half = (sub & 2) != 0;
        const f32x4 gq0 = *(const f32x4*)(P.q_norm + l * 64 + sub * 8), gq1 = *(const f32x4*)(P.q_norm + l * 64 + sub * 8 + 4), gk0 = *(const f32x4*)(P.k_norm + l * 64 + sub * 8), gk1 = *(const f32x4*)(P.k_norm + l * 64 + sub * 8 + 4);
        const int stride = nblk * 64, NI = NT * 10;
        for (int i0 = (bid * 512 + TID) >> 3; i0 < NI; i0 += 4 * stride) {
            u32x4 vv[4]; f32x4 rc0[4], rc1[4], rs0[4], rs1[4]; bf16_t* pp[4];
#pragma unroll
            for (int b4 = 0; b4 < 4; ++b4) { const int i = min(i0 + b4 * stride, NI - 1); const int row = i / 10, slot = i - row * 10; const bool isq = slot < 8;
                pp[b4] = (isq ? (bf16_t*)(P.ws + OFF_QR) + (size_t)row * 512 + slot * 64 : (bf16_t*)(P.ws + OFF_KALL) + (size_t)kv_row(row) * 128 + (slot - 8) * 64) + sub * 8;
                vv[b4] = *(const u32x4*)pp[b4];
                const int tix = (row & 2047) * 32 + (sub >> 2) * 16 + (sub & 1) * 8;
                rc0[b4] = *(const f32x4*)(rc + tix); rc1[b4] = *(const f32x4*)(rc + tix + 4); rs0[b4] = *(const f32x4*)(rs + tix); rs1[b4] = *(const f32x4*)(rs + tix + 4); }
            asm volatile("" : "+v"(vv[0]), "+v"(vv[1]), "+v"(vv[2]), "+v"(vv[3]));
#pragma unroll
            for (int b4 = 0; b4 < 4; ++b4) { const int i = i0 + b4 * stride; const int ic = min(i, NI - 1); const int row = ic / 10, slot = ic - row * 10; const bool isq = slot < 8;
                const unsigned v0 = vv[b4].x, v1 = vv[b4].y, v2 = vv[b4].z, v3 = vv[b4].w;
                float x[8] = {bf_lo(v0), bf_hi(v0), bf_lo(v1), bf_hi(v1), bf_lo(v2), bf_hi(v2), bf_lo(v3), bf_hi(v3)};
                float ss = 0.f;
#pragma unroll
                for (int d = 0; d < 8; ++d) ss += x[d] * x[d];
                ss = sum8(ss);
                const float rstd = rsqrtf(ss * (1.0f / 64.0f) + EPS) * (isq ? C2 : 1.0f);
                const f32x4 g0 = isq ? gq0 : gk0, g1 = isq ? gq1 : gk1;
                x[0] *= rstd * g0.x; x[1] *= rstd * g0.y; x[2] *= rstd * g0.z; x[3] *= rstd * g0.w; x[4] *= rstd * g1.x; x[5] *= rstd * g1.y; x[6] *= rstd * g1.z; x[7] *= rstd * g1.w;
                {
                    const f32x4 c0 = rc0[b4], c1 = rc1[b4], s0 = rs0[b4], s1 = rs1[b4]; const bool lat = row < NL;
                    const float cc[8] = {c0.x, c0.y, c0.z, c0.w, c1.x, c1.y, c1.z, c1.w}, sn[8] = {s0.x, s0.y, s0.z, s0.w, s1.x, s1.y, s1.z, s1.w};
#pragma unroll
                    for (int d = 0; d < 8; ++d) { const float other = DPP_F(x[d], 0x4E);
                        const float r = hi_half ? (x[d] * cc[d] + other * sn[d]) : (x[d] * cc[d] - other * sn[d]); x[d] = lat ? r : x[d]; }
                }
                u32x4 o; o.x = pk_bf16(x[0], x[1]); o.y = pk_bf16(x[2], x[3]); o.z = pk_bf16(x[4], x[5]); o.w = pk_bf16(x[6], x[7]);
                if (i < NI) *(u32x4*)pp[b4] = o;
            }
        }
    }
    const bf16_t* PP = (const bf16_t*)(P.ws + OFF_PP); bf16_t* MIX = (bf16_t*)(P.ws + OFF_MIX);
    for (int i = bid * 512 + TID; i < NT * 32; i += nblk * 512) {
        const int row = i >> 5, ch = (i & 31) * 8, g = ch >> 6, win = 2 << g;
        int base, t, L; if (row < NL) { base = row & ~2047; t = row & 2047; L = SEQ; } else { base = NL + ((row - NL) & ~255); t = (row - NL) & 255; L = CTX; }
        const int lo = max(t - win / 2, 0), hi = min(t + win - win / 2, L);
        float s[8];
#pragma unroll
        for (int q = 0; q < 8; ++q) s[q] = 0.f;
        u32x4 wv[16];
#pragma unroll
        for (int k = 0; k < 16; ++k) wv[k] = *(const u32x4*)(PP + (size_t)(base + min(lo + k, hi - 1)) * 256 + ch);
#pragma unroll
        for (int k = 0; k < 16; ++k) { const float w = lo + k < hi ? 1.0f : 0.0f; const unsigned a0 = wv[k].x, a1 = wv[k].y, a2 = wv[k].z, a3 = wv[k].w;
            s[0] += w * bf_lo(a0); s[1] += w * bf_hi(a0); s[2] += w * bf_lo(a1); s[3] += w * bf_hi(a1); s[4] += w * bf_lo(a2); s[5] += w * bf_hi(a2); s[6] += w * bf_lo(a3); s[7] += w * bf_hi(a3); }
        const float inv = 1.0f / (float)(hi - lo); const u32x4 me = *(const u32x4*)(PP + (size_t)row * 256 + ch);
        u32x4 o; o.x = pk_bf16(s[0] * inv - bf_lo(me.x), s[1] * inv - bf_hi(me.x)); o.y = pk_bf16(s[2] * inv - bf_lo(me.y), s[3] * inv - bf_hi(me.y));
        o.z = pk_bf16(s[4] * inv - bf_lo(me.z), s[5] * inv - bf_hi(me.z)); o.w = pk_bf16(s[6] * inv - bf_lo(me.w), s[7] * inv - bf_hi(me.w));
        *(u32x4*)(MIX + (size_t)row * D + 256 + ch) = o;
    }
}

__device__ __forceinline__ int fkey(float v) { const int b = __float_as_int(v); return b ^ ((b >> 31) & 0x7fffffff); }
__device__ __forceinline__ float kval(int k) { return __int_as_float(k ^ ((k >> 31) & 0x7fffffff)); }
__device__ __forceinline__ float kval16(int k) { const int s = k >> 16; return __int_as_float((s ^ ((s >> 31) & 0x7fff)) << 16); }
#define CE_DESC(a, b) do { const int hi_ = max(a, b), lo_ = min(a, b); a = hi_; b = lo_; } while (0)
__device__ __forceinline__ void bitonic_merge16(int (&a)[16]) {
#pragma unroll
    for (int j = 8; j > 0; j >>= 1)
#pragma unroll
        for (int i = 0; i < 16; ++i) { const int l = i ^ j; if (l > i) CE_DESC(a[i], a[l]); }
}
__device__ __forceinline__ void bitonic_sort16(int (&a)[16]) {
#pragma unroll
    for (int k = 2; k <= 16; k <<= 1)
#pragma unroll
        for (int j = k >> 1; j > 0; j >>= 1)
#pragma unroll
            for (int i = 0; i < 16; ++i) { const int l = i ^ j; if (l > i) { if ((i & k) == 0 || k == 16) CE_DESC(a[i], a[l]); else CE_DESC(a[l], a[i]); } }
}
__device__ __forceinline__ void top16_merge(int (&run)[16], int (&c)[16]) {
    bitonic_sort16(c);
#pragma unroll
    for (int i = 0; i < 16; ++i) run[i] = max(run[i], c[15 - i]);
    bitonic_merge16(run);
}
__device__ __forceinline__ void ph_topk(const Params& P, int ntok, int bid, int nblk, unsigned char* lds) {
    const int TID = tidx();
    const int wid = __builtin_amdgcn_readfirstlane(TID >> 6), lane = TID & 63;
    const bf16_t* ST = (const bf16_t*)(P.ws + OFF_ST); unsigned* EID = (unsigned*)(P.ws + OFF_EID); float* GW = (float*)(P.ws + OFF_GW);
    unsigned char* myl = lds + TID * 36;
    for (int u = bid * 8 + wid; u < (ntok / 64) * 8; u += nblk * 8) {
        const int h = u & 7, tok = (u >> 3) * 64 + lane;
        int l1[16], l2[16];
        const bf16_t* s1 = ST + (size_t)(h * 256) * NT + tok; const bf16_t* s2 = s1 + (size_t)128 * NT;
        unsigned fa[16], fb[16];
#pragma unroll
        for (int q = 0; q < 16; ++q) { fa[q] = s1[(size_t)q * NT]; fb[q] = s2[(size_t)q * NT]; }
#pragma unroll 1
        for (int j0 = 0; j0 < 128; j0 += 16) {
            int a[16], b[16];
#pragma unroll
            for (int q = 0; q < 16; ++q) { a[q] = (int)((fa[q] << 16) | (unsigned)(127 - (j0 + q))); b[q] = (int)((fb[q] << 16) | (unsigned)(127 - (j0 + q))); }
            const int jn = j0 + 16 < 128 ? j0 + 16 : j0;
#pragma unroll
            for (int q = 0; q < 16; ++q) { fa[q] = s1[(size_t)(jn + q) * NT]; fb[q] = s2[(size_t)(jn + q) * NT]; }
            if (j0 == 0) { bitonic_sort16(a); bitonic_sort16(b);
#pragma unroll
                for (int i = 0; i < 16; ++i) { l1[i] = a[i]; l2[i] = b[i]; } }
            else { top16_merge(l1, a); top16_merge(l2, b); }
        }
        float v1[16], v2[16];
#pragma unroll
        for (int i = 0; i < 16; ++i) { v1[i] = kval16(l1[i]); v2[i] = kval16(l2[i]); myl[i] = (unsigned char)(127 - (l1[i] & 127)); myl[16 + i] = (unsigned char)(127 - (l2[i] & 127)); }
        int cd[64];
        { int n = 0;
#pragma unroll
          for (int i = 0; i < 16; ++i)
#pragma unroll
              for (int j = 0; j < 16; ++j) if ((i + 1) * (j + 1) <= 16) { cd[n] = (fkey(v1[i] + v2[j]) & ~255) | (255 - (i * 16 + j)); ++n; }
#pragma unroll
          for (int q = 50; q < 64; ++q) cd[q] = INT_MIN; }
        int l3[16], c[16];
#pragma unroll
        for (int q = 0; q < 16; ++q) l3[q] = cd[q];
        bitonic_sort16(l3);
#pragma unroll
        for (int ch = 1; ch < 4; ++ch) {
#pragma unroll
            for (int q = 0; q < 16; ++q) c[q] = cd[ch * 16 + q];
            top16_merge(l3, c); }
        float t[16]; float sum = 0.f; const float t0 = kval((l3[0] & ~255) | 128);
#pragma unroll
        for (int k = 0; k < 16; ++k) { t[k] = __expf(kval((l3[k] & ~255) | 128) - t0); sum += t[k]; }
        const float inv = 1.0f / sum;
        int e[16];
#pragma unroll
        for (int k = 0; k < 16; ++k) { const int pos = 255 - (l3[k] & 255); e[k] = (int)myl[pos >> 4] * 128 + (int)myl[16 + (pos & 15)]; t[k] *= inv; }
#pragma unroll
        for (int k = 0; k < 16; k += 4) *(f32x4*)(GW + (size_t)tok * 128 + h * 16 + k) = (f32x4){t[k], t[k + 1], t[k + 2], t[k + 3]};
#pragma unroll
        for (int k = 0; k < 16; k += 4) *(u32x4*)(EID + (size_t)tok * 128 + h * 16 + k) = (u32x4){(unsigned)e[k] * 128u, (unsigned)e[k + 1] * 128u, (unsigned)e[k + 2] * 128u, (unsigned)e[k + 3] * 128u};
    }
}

constexpr size_t OFF_PB = OFF_ST;
constexpr size_t OFF_CV = OFF_ST + 144 * MiB;
__device__ __forceinline__ int id16(const u32x4& a, const u32x4& b, int it) {
    const unsigned w = it < 8 ? (it < 4 ? (it < 2 ? a.x : a.y) : (it < 6 ? a.z : a.w)) : (it < 12 ? (it < 10 ? b.x : b.y) : (it < 14 ? b.z : b.w));
    return (it & 1) ? (int)(w >> 16) : (int)(w & 0xffffu);
}
__device__ __forceinline__ void unpk_fp8x16p(const u32x4& w, f32x2_t (&f)[8]) {
    const unsigned d0 = w.x, d1 = w.y, d2 = w.z, d3 = w.w;
    f[0] = __builtin_amdgcn_cvt_pk_f32_fp8((int)d0, false); f[1] = __builtin_amdgcn_cvt_pk_f32_fp8((int)d0, true); f[2] = __builtin_amdgcn_cvt_pk_f32_fp8((int)d1, false); f[3] = __builtin_amdgcn_cvt_pk_f32_fp8((int)d1, true);
    f[4] = __builtin_amdgcn_cvt_pk_f32_fp8((int)d2, false); f[5] = __builtin_amdgcn_cvt_pk_f32_fp8((int)d2, true); f[6] = __builtin_amdgcn_cvt_pk_f32_fp8((int)d3, false); f[7] = __builtin_amdgcn_cvt_pk_f32_fp8((int)d3, true);
}
__device__ __forceinline__ void unpk_fp8x16(const u32x4& w, float (&f)[16]) {
    const unsigned d0 = w.x, d1 = w.y, d2 = w.z, d3 = w.w;
    f32x2_t t;
    t = __builtin_amdgcn_cvt_pk_f32_fp8((int)d0, false); f[0] = t.x; f[1] = t.y; t = __builtin_amdgcn_cvt_pk_f32_fp8((int)d0, true); f[2] = t.x; f[3] = t.y;
    t = __builtin_amdgcn_cvt_pk_f32_fp8((int)d1, false); f[4] = t.x; f[5] = t.y; t = __builtin_amdgcn_cvt_pk_f32_fp8((int)d1, true); f[6] = t.x; f[7] = t.y;
    t = __builtin_amdgcn_cvt_pk_f32_fp8((int)d2, false); f[8] = t.x; f[9] = t.y; t = __builtin_amdgcn_cvt_pk_f32_fp8((int)d2, true); f[10] = t.x; f[11] = t.y;
    t = __builtin_amdgcn_cvt_pk_f32_fp8((int)d3, false); f[12] = t.x; f[13] = t.y; t = __builtin_amdgcn_cvt_pk_f32_fp8((int)d3, true); f[14] = t.x; f[15] = t.y;
}
__device__ __forceinline__ void ph_peer_u(const Params& P, int l, int ntok, int bid, int nblk) {
    const int TID = tidx(); const int wid = __builtin_amdgcn_readfirstlane(TID >> 6), lane = TID & 63, c8 = lane & 7, q = lane >> 3;
    const int grp = bid & 7, nw = (nblk >> 3) * 8, w0 = (bid >> 3) * 8 + wid;
    if (w0 >= ntok) return;
    const int tl = w0 + ((ntok - 1 - w0) / nw) * nw;
    const bf16_t* HB = (const bf16_t*)(P.ws + OFF_HB) + grp * 128 + c8 * 16; const unsigned* EID = (const unsigned*)(P.ws + OFF_EID) + q * 16;
    float* PB = (float*)(P.ws + OFF_PB) + (size_t)grp * NT * 128 + lane;
    const unsigned char* Tu = P.ws + OFF_PU + ((size_t)(l * 8 + grp) * NEXP) * 128;
    const unsigned lo16 = (unsigned)c8 * 16u;
    u32x4 buf[16], idN[4], idNN[4], xaC, xbC, xaN, xbN, xaNN, xbNN;
#define PU_LOADI(T, ID, XA, XB) do { const int T_ = min((T), tl); _Pragma("unroll") for (int i_ = 0; i_ < 4; ++i_) ID[i_] = *(const u32x4*)(EID + (size_t)T_ * 128 + i_ * 4); XA = *(const u32x4*)(HB + (size_t)T_ * D); XB = *(const u32x4*)(HB + (size_t)T_ * D + 8); } while (0)
    { u32x4 id0[4]; PU_LOADI(w0, id0, xaC, xbC);
#pragma unroll
      for (int it = 0; it < 16; ++it) buf[it] = *(const u32x4*)(Tu + (id0[it >> 2][it & 3] + lo16)); }
    PU_LOADI(w0 + nw, idN, xaN, xbN);
    for (int t0 = w0; t0 < ntok; t0 += nw) {
        PU_LOADI(t0 + 2 * nw, idNN, xaNN, xbNN);
        const unsigned x0 = xaC.x, x1 = xaC.y, x2 = xaC.z, x3 = xaC.w, x4 = xbC.x, x5 = xbC.y, x6 = xbC.z, x7 = xbC.w;
        const f32x2_t xv[8] = {{bf_lo(x0), bf_hi(x0)}, {bf_lo(x1), bf_hi(x1)}, {bf_lo(x2), bf_hi(x2)}, {bf_lo(x3), bf_hi(x3)}, {bf_lo(x4), bf_hi(x4)}, {bf_lo(x5), bf_hi(x5)}, {bf_lo(x6), bf_hi(x6)}, {bf_lo(x7), bf_hi(x7)}};
        float r0 = 0.f, r1 = 0.f;
#pragma unroll
        for (int it = 0; it < 16; ++it) { f32x2_t uf[8]; unpk_fp8x16p(buf[it], uf);
            buf[it] = *(const u32x4*)(Tu + (idN[it >> 2][it & 3] + lo16));
            f32x2_t d = uf[0] * xv[0];
#pragma unroll
            for (int i = 1; i < 8; ++i) d = __builtin_elementwise_fma(uf[i], xv[i], d);
            const float p = sum8(d.x + d.y); if (c8 == (it & 7)) { if (it < 8) r0 = p; else r1 = p; } }
        float* pb = PB + (size_t)t0 * 128; pb[0] = r0; pb[64] = r1;
        xaC = xaN; xbC = xbN; xaN = xaNN; xbN = xbNN;
#pragma unroll
        for (int i = 0; i < 4; ++i) idN[i] = idNN[i];
    }
#undef PU_LOADI
}
__device__ __forceinline__ void ph_peer_a(const Params& P, int ntok, int bid, int nblk) {
    const int TID = tidx(); const int wid = __builtin_amdgcn_readfirstlane(TID >> 6), lane = TID & 63;
    const float* PB = (const float*)(P.ws + OFF_PB); const float* GW = (const float*)(P.ws + OFF_GW); float* CV = (float*)(P.ws + OFF_CV);
    constexpr int TB = 4;
    const int stride = nblk * 8;
    for (int t0 = bid * 8 + wid; t0 < ntok; t0 += TB * stride) {
        float pb[TB][2][8], gw[TB][2];
#pragma unroll
        for (int h = 0; h < TB; ++h) { const int t = min(t0 + h * stride, ntok - 1);
#pragma unroll
            for (int k = 0; k < 2; ++k) {
#pragma unroll
                for (int j = 0; j < 8; ++j) pb[h][k][j] = PB[((size_t)j * NT + t) * 128 + k * 64 + lane];
                gw[h][k] = GW[(size_t)t * 128 + (lane >> 3) * 16 + k * 8 + (lane & 7)]; } }
        asm volatile("" : "+v"(gw[0][0]), "+v"(gw[1][0]), "+v"(gw[2][0]), "+v"(gw[3][0]), "+v"(gw[0][1]), "+v"(gw[1][1]), "+v"(gw[2][1]), "+v"(gw[3][1]));
#pragma unroll
        for (int h = 0; h < TB; ++h) { const int t = t0 + h * stride;
            if (t < ntok) {
#pragma unroll
                for (int k = 0; k < 2; ++k) { float a = 0.f;
#pragma unroll
                    for (int j = 0; j < 8; ++j) a += pb[h][k][j];
                    const int p = (lane >> 3) * 16 + k * 8 + (lane & 7);
                    CV[(size_t)t * 128 + p] = gw[h][k] * gelu_tanh(a * (1.0f / U_SCALE)) * (1.0f / V_SCALE); } } }
    }
}
__device__ __forceinline__ float red16(float a, float b) { auto r = __builtin_amdgcn_permlane16_swap(__builtin_bit_cast(unsigned, a), __builtin_bit_cast(unsigned, b), false, false); return __builtin_bit_cast(float, (unsigned)r[0]) + __builtin_bit_cast(float, (unsigned)r[1]); }
__device__ __forceinline__ float red32(float a, float b) { auto r = __builtin_amdgcn_permlane32_swap(__builtin_bit_cast(unsigned, a), __builtin_bit_cast(unsigned, b), false, false); return __builtin_bit_cast(float, (unsigned)r[0]) + __builtin_bit_cast(float, (unsigned)r[1]); }
__device__ __forceinline__ void ph_peer_v(const Params& P, int l, int ntok, int bid, int nblk, const bool dry = false) {
    const int TID = tidx(); const int wid = __builtin_amdgcn_readfirstlane(TID >> 6), lane = TID & 63, c8 = lane & 7, q = lane >> 3;
    const int grp = bid & 7, nw = (nblk >> 3) * 8, w0 = (bid >> 3) * 8 + wid;
    if (w0 >= ntok) return;
    const int tl = w0 + ((ntok - 1 - w0) / nw) * nw;
    const unsigned* EID = (const unsigned*)(P.ws + OFF_EID) + q * 16; const float* CV = (const float*)(P.ws + OFF_CV) + q * 16;
    const unsigned char* Tv = P.ws + OFF_PV + ((size_t)(l * 8 + grp) * NEXP) * 128;
    const unsigned lo16 = (unsigned)c8 * 16u;
    const int xcol = grp * 128 + c8 * 16 + 4 * (lane >> 4);
    const bool writer = (lane & 8) == 0;
    u32x4 buf[16], idN[4], idNN[4]; f32x2_t cvC[8], cvN[8];
#define PV_LOADI(T, ID) do { const int T_ = min((T), tl); _Pragma("unroll") for (int i_ = 0; i_ < 4; ++i_) ID[i_] = *(const u32x4*)(EID + (size_t)T_ * 128 + i_ * 4); } while (0)
#define PV_LOADC(T, CVX) do { const int T_ = min((T), tl); _Pragma("unroll") for (int i_ = 0; i_ < 4; ++i_) { const f32x4 c4_ = *(const f32x4*)(CV + (size_t)T_ * 128 + i_ * 4); CVX[2 * i_] = (f32x2_t){c4_.x, c4_.y}; CVX[2 * i_ + 1] = (f32x2_t){c4_.z, c4_.w}; } } while (0)
    { u32x4 id0[4]; PV_LOADI(w0, id0); PV_LOADC(w0, cvC);
#pragma unroll
      for (int it = 0; it < 16; ++it) buf[it] = *(const u32x4*)(Tv + (id0[it >> 2][it & 3] + lo16)); }
    PV_LOADI(w0 + nw, idN);
    for (int t0 = w0; t0 < ntok; t0 += nw) {
        PV_LOADI(t0 + 2 * nw, idNN); PV_LOADC(t0 + nw, cvN);
        float* xp = xrow_ptr(P, t0) + xcol; const float* m5 = mod_ptr(P, l, mod_r(t0), 5) + xcol;
        f32x4 xpre, gpre;
        if (!dry && writer) { xpre = *(const f32x4*)xp; gpre = *(const f32x4*)m5; }
        f32x2_t o2[8];
#pragma unroll
        for (int i = 0; i < 8; ++i) o2[i] = (f32x2_t){0.f, 0.f};
#pragma unroll
        for (int it = 0; it < 16; ++it) { f32x2_t vf[8]; unpk_fp8x16p(buf[it], vf);
            buf[it] = *(const u32x4*)(Tv + (idN[it >> 2][it & 3] + lo16));
#pragma unroll
            for (int i = 0; i < 8; ++i) { if (it & 1) asm("v_pk_fma_f32 %0, %1, %2, %0 op_sel:[0,1,0] op_sel_hi:[1,1,1]" : "+v"(o2[i]) : "v"(vf[i]), "v"(cvC[it >> 1]));
                                          else        asm("v_pk_fma_f32 %0, %1, %2, %0 op_sel_hi:[1,0,1]" : "+v"(o2[i]) : "v"(vf[i]), "v"(cvC[it >> 1])); } }
        float w[16];
#pragma unroll
        for (int i = 0; i < 8; ++i) { const float ox = o2[i].x, oy = o2[i].y; w[2 * i] = ox + DPP_F(ox, 0x128); w[2 * i + 1] = oy + DPP_F(oy, 0x128); }
        float z[4];
#pragma unroll
        for (int j = 0; j < 4; ++j) z[j] = red32(red16(w[j], w[4 + j]), red16(w[8 + j], w[12 + j]));
        if (dry) {
#pragma unroll
            for (int j = 0; j < 4; ++j) asm volatile("" :: "v"(z[j]));
        } else if (writer) {
            f32x4 x = xpre; x.x += gpre.x * z[0]; x.y += gpre.y * z[1]; x.z += gpre.z * z[2]; x.w += gpre.w * z[3]; *(f32x4*)xp = x;
        }
#pragma unroll
        for (int i = 0; i < 8; ++i) cvC[i] = cvN[i];
#pragma unroll
        for (int i = 0; i < 4; ++i) idN[i] = idNN[i];
    }
#undef PV_LOADI
#undef PV_LOADC
}

namespace pg8 {
#define PG8_LAS __attribute__((address_space(3)))
constexpr int BM = 256, BK = 64, HALF = 128, HTB = HALF * BK * 2, STAGE_BYTES = 8 * HTB, NXCD = 8, WGM = 4;
__host__ __device__ __forceinline__ int lds_byte(int r, int c) { const int ch = (c >> 3) ^ ((r >> 1) & 7); return r * 128 + ch * 16 + (c & 7) * 2; }
__host__ __device__ __forceinline__ void stage_rc(int b, int& R, int& C) { R = b >> 7; C = ((((b >> 4) & 7) ^ ((R >> 1) & 7)) << 3) + ((b & 15) >> 1); }
__host__ __device__ __forceinline__ int perm32(int rho) { const int n = rho >> 4, i = rho & 15; return 8 * (i >> 2) + 4 * n + (i & 3); }
struct Unit { int pm, pn, nt, kofs, tag; };
struct Gemm { const bf16_t* A; const bf16_t* Bt; int lda, ldb; };
struct TileOrder {
    int nM, nN, nwg, G, c;
    __device__ __forceinline__ void init(int nM_, int nN_, int G_, int c_) { nM = nM_; nN = nN_; nwg = nM * nN; G = G_; c = c_; }
    __device__ __forceinline__ bool tile(int i, int& pm, int& pn) const {
        const long L = (long)i * G + c; if (L >= nwg) return false;
        int wgid = (int)L; { const int q = nwg / NXCD, r = nwg % NXCD, xcd = wgid % NXCD, off = wgid / NXCD; wgid = (xcd < r ? xcd * (q + 1) : r * (q + 1) + (xcd - r) * q) + off; }
        const int nig = WGM * nN, gid = wgid / nig, fm = gid * WGM, gsz = (nM - fm) < WGM ? (nM - fm) : WGM;
        pm = fm + ((wgid % nig) % gsz); pn = (wgid % nig) / gsz; return true;
    }
};
struct PlainSched { TileOrder T; int nt;
    __device__ __forceinline__ bool next(int i, Unit& u) const { if (!T.tile(i, u.pm, u.pn)) return false; u.nt = nt; u.kofs = 0; u.tag = 0; return true; } };
struct CtxZSched { int c, G, nt;
    __device__ __forceinline__ bool next(int i, Unit& u) const { const int L = i * G + c; if (L >= 32) return false; u.pm = L & 1; u.pn = 128 + (L >> 1); u.nt = nt; u.kofs = 0; u.tag = 0; return true; } };
struct MergeSched { TileOrder T;
    __device__ __forceinline__ bool next(int i, Unit& u) const { const int ti = i / 3, br = i - 3 * ti; if (!T.tile(ti, u.pm, u.pn)) return false;
        u.tag = br; u.nt = br == 2 ? 8 : 4; u.kofs = br == 0 ? 0 : br == 1 ? 512 : 1024; return true; } };

template <class Epi, class Sched, bool FP8 = false>
__device__ __forceinline__ void gemm_phase(PG8_LAS unsigned char* lds, const Gemm g, const Sched& S, const Epi& E) {
    const int TID = tidx();
    const int tid = TID, wid = __builtin_amdgcn_readfirstlane(tid >> 6), lane = tid & 63, wr = wid >> 2, wc = wid & 3, fr = lane & 15, fq = lane >> 4;
    unsigned voffA[2], voffB[2];
#pragma unroll
    for (int i = 0; i < 2; ++i) { int R, C; stage_rc(tid * 16 + i * 8192, R, C); const int Rb = Epi::PERM ? ((R & ~31) + perm32(R & 31)) : R;
        voffA[i] = (unsigned)(R * g.lda + C) * 2u; voffB[i] = (unsigned)(Rb * g.ldb + C) * 2u; }
    const size_t kstep = (size_t)(BK * 2);
    const size_t hstepA = (size_t)HALF * g.lda * 2, hstepB = (size_t)HALF * g.ldb * 2;
    const size_t tstepA = 2 * hstepA, tstepB = 2 * hstepB;
    const unsigned ldsw = (unsigned)wid * 1024u;
    const int aoffk[2] = {lds_byte(wr * 64 + fr, fq * 8), lds_byte(wr * 64 + fr, fq * 8 + 32)}, boffk[2] = {lds_byte(wc * 32 + fr, fq * 8), lds_byte(wc * 32 + fr, fq * 8 + 32)};
#define PG8_SA(b, h) (((b) * 2 + (h)) * HTB)
#define PG8_SB(b, h) ((4 + (b) * 2 + (h)) * HTB)
#define PG8_STAGE(bufoff, gbase, voff) do { _Pragma("unroll") for (int _i = 0; _i < 2; ++_i) \
        __builtin_amdgcn_global_load_lds((const unsigned*)((const char*)(gbase) + (voff)[_i]), (PG8_LAS unsigned*)(lds + (bufoff) + ldsw + _i * 8192), 16, 0, 0); } while (0)
#define PG8_LDA(dst, b, h) do { _Pragma("unroll") for (int m = 0; m < 4; ++m) { if constexpr (FP8) { const i32x4_ lo_ = *(const PG8_LAS i32x4_*)(lds + PG8_SA(b, h) + aoffk[0] + m * 2048), hi_ = *(const PG8_LAS i32x4_*)(lds + PG8_SA(b, h) + aoffk[1] + m * 2048); dst##8[m] = __builtin_shufflevector(lo_, hi_, 0, 1, 2, 3, 4, 5, 6, 7); } \
        else { _Pragma("unroll") for (int k = 0; k < 2; ++k) dst[m][k] = *(const PG8_LAS bf16x8*)(lds + PG8_SA(b, h) + aoffk[k] + m * 2048); } } } while (0)
#define PG8_LDB(dst, b, h) do { _Pragma("unroll") for (int n = 0; n < 2; ++n) { if constexpr (FP8) { const i32x4_ lo_ = *(const PG8_LAS i32x4_*)(lds + PG8_SB(b, h) + boffk[0] + n * 2048), hi_ = *(const PG8_LAS i32x4_*)(lds + PG8_SB(b, h) + boffk[1] + n * 2048); dst##8[n] = __builtin_shufflevector(lo_, hi_, 0, 1, 2, 3, 4, 5, 6, 7); } \
        else { _Pragma("unroll") for (int k = 0; k < 2; ++k) dst[n][k] = *(const PG8_LAS bf16x8*)(lds + PG8_SB(b, h) + boffk[k] + n * 2048); } } } while (0)
#define PG8_MMA(ai, bj, At, Bt) do { __builtin_amdgcn_s_setprio(1); _Pragma("unroll") for (int m = 0; m < 4; ++m) _Pragma("unroll") for (int n = 0; n < 2; ++n) { \
        if constexpr (FP8) asm volatile("v_mfma_scale_f32_16x16x128_f8f6f4 %0, %1, %2, %0, %3, %3 op_sel_hi:[0,0,0]" : "+v"(acc[ai][bj][m][n]) : "v"(Bt##8[n]), "v"(At##8[m]), "v"(scale1));   \
        else { _Pragma("unroll") for (int k = 0; k < 2; ++k) acc[ai][bj][m][n] = __builtin_amdgcn_mfma_f32_16x16x32_bf16(Bt[n][k], At[m][k], acc[ai][bj][m][n], 0, 0, 0); } } \
        __builtin_amdgcn_s_setprio(0); } while (0)
#define PG8_WAIT_V(n) asm volatile("s_waitcnt vmcnt(" #n ")" ::: "memory")
#define PG8_WAIT_L(n) asm volatile("s_waitcnt lgkmcnt(" #n ")" ::: "memory")
#define PG8_BAR __builtin_amdgcn_s_barrier()
#define PG8_SCHED __builtin_amdgcn_sched_barrier(0)
    Unit cur, nxt; int ui = 0;
    if (!S.next(0, cur)) return;
    int scale1 = 0x7F7F7F7F; asm volatile("" : "+v"(scale1));
    f32x4 acc[2][2][4][2];
#pragma unroll
    for (int a = 0; a < 2; ++a)
#pragma unroll
        for (int b = 0; b < 2; ++b)
#pragma unroll
            for (int m = 0; m < 4; ++m)
#pragma unroll
                for (int n = 0; n < 2; ++n) acc[a][b][m][n] = (f32x4){0.f, 0.f, 0.f, 0.f};
    bf16x8 At[4][2], B0[2][2], B1[2][2];
    i32x8 At8[4], B08[2], B18[2];
    const char* cA = (const char*)g.A + (size_t)cur.pm * tstepA + cur.kofs; const char* cB = (const char*)g.Bt + (size_t)cur.pn * tstepB + cur.kofs;
    PG8_STAGE(PG8_SB(0, 0), cB, voffB); PG8_STAGE(PG8_SB(0, 1), cB + hstepB, voffB); PG8_STAGE(PG8_SA(0, 0), cA, voffA); PG8_STAGE(PG8_SA(0, 1), cA + hstepA, voffA);
    if (wr == 1) PG8_BAR;
    PG8_WAIT_V(2); PG8_BAR;
    PG8_STAGE(PG8_SB(1, 0), cB + kstep, voffB); PG8_STAGE(PG8_SA(1, 0), cA + kstep, voffA); PG8_STAGE(PG8_SB(1, 1), cB + hstepB + kstep, voffB);
    PG8_WAIT_V(6); PG8_BAR;
    for (;;) {
        const bool has_next = S.next(ui + 1, nxt);
        const char* nA = has_next ? (const char*)g.A + (size_t)nxt.pm * tstepA + nxt.kofs : cA; const char* nB = has_next ? (const char*)g.Bt + (size_t)nxt.pn * tstepB + nxt.kofs : cB;
        const int nt = cur.nt;
        for (int t = 0; t < nt; t += 2) {
            const bool last = (t == nt - 2);
            const char* a1 = cA + (size_t)(t + 1) * kstep;
            const char* a2 = last ? nA : cA + (size_t)(t + 2) * kstep; const char* b2 = last ? nB : cB + (size_t)(t + 2) * kstep;
            const char* a3 = a2 + kstep; const char* b3 = b2 + kstep;
            PG8_LDB(B0, 0, 0); PG8_LDB(B1, 0, 1); PG8_SCHED; PG8_LDA(At, 0, 0); PG8_STAGE(PG8_SA(1, 1), a1 + hstepA, voffA);
            PG8_WAIT_V(8); PG8_WAIT_L(0); PG8_BAR; PG8_MMA(0, 0, At, B0); PG8_MMA(0, 1, At, B1); PG8_BAR; PG8_SCHED;
            PG8_LDA(At, 0, 1); PG8_STAGE(PG8_SB(0, 0), b2, voffB); PG8_STAGE(PG8_SB(0, 1), b2 + hstepB, voffB); PG8_STAGE(PG8_SA(0, 0), a2, voffA);
            PG8_WAIT_V(8); PG8_WAIT_L(0); PG8_BAR; PG8_MMA(1, 0, At, B0); PG8_MMA(1, 1, At, B1); PG8_BAR; PG8_SCHED;
            PG8_LDB(B0, 1, 0); PG8_LDB(B1, 1, 1); PG8_SCHED; PG8_LDA(At, 1, 0); PG8_STAGE(PG8_SA(0, 1), a2 + hstepA, voffA);
            PG8_WAIT_V(8); PG8_WAIT_L(0); PG8_BAR; PG8_MMA(0, 0, At, B0); PG8_MMA(0, 1, At, B1); PG8_BAR; PG8_SCHED;
            PG8_LDA(At, 1, 1); PG8_STAGE(PG8_SB(1, 0), b3, voffB); PG8_STAGE(PG8_SB(1, 1), b3 + hstepB, voffB); PG8_STAGE(PG8_SA(1, 0), a3, voffA);
            PG8_WAIT_V(8); PG8_WAIT_L(0); PG8_BAR; PG8_MMA(1, 0, At, B0); PG8_MMA(1, 1, At, B1); PG8_BAR; PG8_SCHED;
        }
        if (wr == 0) PG8_BAR;
        if constexpr (FP8) asm volatile("s_nop 15\n\ts_nop 15" ::: "memory");
        E(acc, cur, wr, wc, fr, fq);
        if (!has_next) break;
        if (!E.keeps(cur)) {
#pragma unroll
        for (int a = 0; a < 2; ++a)
#pragma unroll
            for (int b = 0; b < 2; ++b)
#pragma unroll
                for (int m = 0; m < 4; ++m)
#pragma unroll
                    for (int n = 0; n < 2; ++n) acc[a][b][m][n] = (f32x4){0.f, 0.f, 0.f, 0.f};
        }
        cur = nxt; cA = nA; cB = nB; ++ui;
        if (wr == 1) PG8_BAR;
    }
    PG8_WAIT_V(0);
    PG8_BAR;
#undef PG8_SA
#undef PG8_SB
#undef PG8_STAGE
#undef PG8_LDA
#undef PG8_LDB
#undef PG8_MMA
#undef PG8_WAIT_V
#undef PG8_WAIT_L
#undef PG8_BAR
#undef PG8_SCHED
}
__device__ __forceinline__ u32x4 pack8(f32x4 v0, f32x4 v1) { u32x4 w; w.x = pk_bf16(v0[0], v0[1]); w.y = pk_bf16(v0[2], v0[3]); w.z = pk_bf16(v1[0], v1[1]); w.w = pk_bf16(v1[2], v1[3]); return w; }
__device__ __forceinline__ u32x2 pack8u(f32x4 a, f32x4 b) {
    u32x2 w;
    w.x = (unsigned)__builtin_rintf(a[0] * 255.f) | ((unsigned)__builtin_rintf(a[1] * 255.f) << 8) | ((unsigned)__builtin_rintf(a[2] * 255.f) << 16) | ((unsigned)__builtin_rintf(a[3] * 255.f) << 24);
    w.y = (unsigned)__builtin_rintf(b[0] * 255.f) | ((unsigned)__builtin_rintf(b[1] * 255.f) << 8) | ((unsigned)__builtin_rintf(b[2] * 255.f) << 16) | ((unsigned)__builtin_rintf(b[3] * 255.f) << 24);
    return w;
}
__device__ __forceinline__ void unpk8u(u32x2 w, float (&f)[8]) {
    const unsigned x = w.x, y = w.y; const float k = 1.0f / 255.0f;
    f[0] = (float)(x & 255u) * k; f[1] = (float)((x >> 8) & 255u) * k; f[2] = (float)((x >> 16) & 255u) * k; f[3] = (float)(x >> 24) * k;
    f[4] = (float)(y & 255u) * k; f[5] = (float)((y >> 8) & 255u) * k; f[6] = (float)((y >> 16) & 255u) * k; f[7] = (float)(y >> 24) * k;
}
__device__ __forceinline__ f32x4 sig4(f32x4 v) { return (f32x4){sigmoidf_(v[0]), sigmoidf_(v[1]), sigmoidf_(v[2]), sigmoidf_(v[3])}; }
struct EpiG1 {
    static constexpr bool PERM = true; __device__ __forceinline__ bool keeps(const Unit&) const { return false; } unsigned char* ws;
    __device__ __forceinline__ void operator()(const f32x4 (&acc)[2][2][4][2], const Unit& u, int wr, int wc, int fr, int fq) const {
        const int rl = wr * 64 + fr, cl = wc * 32 + 8 * fq; const int row0 = u.pm * BM + rl;
        const int kvb = (u.pm < 128 ? (u.pm >> 3) * KV + (u.pm & 7) * 256 : (u.pm - 128) * KV + SEQ) + rl;
#pragma unroll
        for (int ai = 0; ai < 2; ++ai)
#pragma unroll
            for (int m = 0; m < 4; ++m) { const int ro = ai * HALF + m * 16;
#pragma unroll
                for (int bj = 0; bj < 2; ++bj) { const f32x4 v0 = acc[ai][bj][m][0], v1 = acc[ai][bj][m][1];
                    if (u.pn == 0) *(u32x4*)((bf16_t*)(ws + OFF_PP) + (size_t)(row0 + ro) * 256 + bj * HALF + cl) = pack8(v0, v1);
                    else if (u.pn < 3) *(u32x4*)((bf16_t*)(ws + OFF_QR) + (size_t)(row0 + ro) * 512 + (u.pn - 1) * 256 + bj * HALF + cl) = pack8(v0, v1);
                    else if (u.pn == 3) *(u32x4*)((bf16_t*)(ws + (bj ? OFF_VALL : OFF_KALL)) + (size_t)(kvb + ro) * 128 + cl) = pack8(v0, v1);
                    else *(u32x2*)(ws + OFF_GT + (size_t)(row0 + ro) * 3072 + (u.pn - 4) * 256 + bj * HALF + cl) = pack8u(sig4(v0), sig4(v1)); } }
    }
};
struct EpiG8 {
    static constexpr bool PERM = true; __device__ __forceinline__ bool keeps(const Unit&) const { return false; } unsigned char* ws; const PG8_LAS unsigned char* lut;
    __device__ __forceinline__ unsigned g4(const f32x4 v) const {
        const unsigned i0 = min((unsigned)(v[0] + 512.5f), 1023u), i1 = min((unsigned)(v[1] + 512.5f), 1023u), i2 = min((unsigned)(v[2] + 512.5f), 1023u), i3 = min((unsigned)(v[3] + 512.5f), 1023u);
        return (unsigned)lut[i0] | ((unsigned)lut[i1] << 8) | ((unsigned)lut[i2] << 16) | ((unsigned)lut[i3] << 24);
    }
    __device__ __forceinline__ void operator()(const f32x4 (&acc)[2][2][4][2], const Unit& u, int wr, int wc, int fr, int fq) const {
        const int row0 = u.pm * BM + wr * 64 + fr, cl = wc * 32 + 8 * (fq & ~1); const int odd = fq & 1;
#pragma unroll
        for (int ai = 0; ai < 2; ++ai)
#pragma unroll
            for (int bj = 0; bj < 2; ++bj)
#pragma unroll
                for (int mp = 0; mp < 2; ++mp) {
                    const unsigned a0 = g4(acc[ai][bj][2 * mp][0]), a1 = g4(acc[ai][bj][2 * mp][1]), b0 = g4(acc[ai][bj][2 * mp + 1][0]), b1 = g4(acc[ai][bj][2 * mp + 1][1]);
                    auto s0 = __builtin_amdgcn_permlane16_swap(a0, b0, false, false); auto s1 = __builtin_amdgcn_permlane16_swap(a1, b1, false, false);
                    u32x4 o; o.x = (unsigned)s0[0]; o.y = (unsigned)s1[0]; o.z = (unsigned)s0[1]; o.w = (unsigned)s1[1];
                    *(u32x4*)(ws + OFF_GT + (size_t)(row0 + ai * HALF + (2 * mp + odd) * 16) * 3072 + u.pn * 256 + bj * HALF + cl) = o; }
    }
};
struct EpiGZ {
    static constexpr bool PERM = true; __device__ __forceinline__ bool keeps(const Unit&) const { return false; } unsigned char* ws;
    __device__ __forceinline__ void operator()(const f32x4 (&acc)[2][2][4][2], const Unit& u, int wr, int wc, int fr, int fq) const {
        const int ch0 = wr * 64 + fr, tl = wc * 32 + 8 * fq;
        bf16_t* base; int pitch;
        if (u.pn < 128) { base = (bf16_t*)(ws + OFF_ZTL) + (size_t)((u.pn >> 3) * 256) * 4096 + u.pm * 2048 + (u.pn & 7) * 256; pitch = 4096; }
        else { base = (bf16_t*)(ws + OFF_ZTC) + (size_t)((u.pn - 128) * 256) * 512 + u.pm * 256; pitch = 512; }
#pragma unroll
        for (int ai = 0; ai < 2; ++ai)
#pragma unroll
            for (int m = 0; m < 4; ++m) { const int ch = ch0 + ai * HALF + m * 16;
#pragma unroll
                for (int bj = 0; bj < 2; ++bj) *(u32x4*)(base + (size_t)ch * pitch + bj * HALF + tl) = pack8(acc[ai][bj][m][0], acc[ai][bj][m][1]); }
    }
};
struct EpiRe8 {
    static constexpr bool PERM = true; __device__ __forceinline__ bool keeps(const Unit&) const { return false; } bf16_t* mix; int ctx;
    __device__ __forceinline__ void operator()(const f32x4 (&acc)[2][2][4][2], const Unit& u, int wr, int wc, int fr, int fq) const {
        const int rb = (ctx ? NL + u.tag * CTX : u.tag * SEQ + (u.pm & 7) * 256) + wr * 64 + fr, cl = wc * 32 + 8 * fq;
        const float sc = ctx ? 1.0f / 128.0f : 0.0027621358640099515f;
#pragma unroll
        for (int ai = 0; ai < 2; ++ai)
#pragma unroll
            for (int m = 0; m < 4; ++m)
#pragma unroll
                for (int bj = 0; bj < 2; ++bj) *(u32x4*)(mix + (size_t)(rb + ai * HALF + m * 16) * D + bj * HALF + cl) = pack8(acc[ai][bj][m][0] * sc, acc[ai][bj][m][1] * sc);
    }
};
struct EpiMg {
    static constexpr bool PERM = true; unsigned char* ws;
    __device__ __forceinline__ bool keeps(const Unit& u) const { return u.tag != 2; }
    __device__ __forceinline__ void operator()(f32x4 (&acc)[2][2][4][2], const Unit& u, int wr, int wc, int fr, int fq) const {
        const int row0 = u.pm * BM + wr * 64 + fr, col0 = u.pn * BM + wc * 32 + 8 * fq;
        const unsigned char* gt = ws + OFF_GT + u.tag * 1024; bf16_t* U = (bf16_t*)(ws + OFF_HB);
        const unsigned go = (unsigned)row0 * 3072u + (unsigned)col0, dofs = u.tag != 2 ? 1024u : 0u; const bool ratio = u.tag != 2;
#pragma unroll
        for (int g = 0; g < 4; ++g) {
            u32x2 gn[2][2], gd[2][2];
#pragma unroll
            for (int mm = 0; mm < 2; ++mm)
#pragma unroll
                for (int bj = 0; bj < 2; ++bj) { const unsigned o = go + (unsigned)((g >> 1) * HALF + ((g & 1) * 2 + mm) * 16) * 3072u + (unsigned)(bj * HALF);
                    gn[mm][bj] = *(const u32x2*)(gt + o); gd[mm][bj] = *(const u32x2*)(gt + (o + dofs)); }
#pragma unroll
            for (int mm = 0; mm < 2; ++mm)
#pragma unroll
                for (int bj = 0; bj < 2; ++bj) { const int ai = g >> 1, m = (g & 1) * 2 + mm; float f[8], d[8];
                    u32x2 dd = gd[mm][bj]; dd.x = ratio ? dd.x : 0xFFFFFFFFu; dd.y = ratio ? dd.y : 0xFFFFFFFFu;
                    unpk8u(gn[mm][bj], f); unpk8u(dd, d);
#pragma unroll
                    for (int i = 0; i < 8; ++i) f[i] = fmaxf(f[i], 1e-20f) * __builtin_amdgcn_rcpf(fmaxf(d[i], 1e-20f));
                    f32x4 v0 = acc[ai][bj][m][0], v1 = acc[ai][bj][m][1];
                    v0[0] *= f[0]; v0[1] *= f[1]; v0[2] *= f[2]; v0[3] *= f[3]; v1[0] *= f[4]; v1[1] *= f[5]; v1[2] *= f[6]; v1[3] *= f[7];
                    acc[ai][bj][m][0] = v0; acc[ai][bj][m][1] = v1; }
        }
        if (u.tag == 2) {
#pragma unroll
            for (int ai = 0; ai < 2; ++ai)
#pragma unroll
                for (int m = 0; m < 4; ++m)
#pragma unroll
                    for (int bj = 0; bj < 2; ++bj) *(u32x4*)(U + (size_t)(row0 + ai * HALF + m * 16) * D + col0 + bj * HALF) = pack8(acc[ai][bj][m][0], acc[ai][bj][m][1]);
        }
    }
};
struct EpiO {
    static constexpr bool PERM = false; __device__ __forceinline__ bool keeps(const Unit&) const { return false; } float* out; unsigned char* ws; int l; const float* xin; const float* cin;
    __device__ __forceinline__ void operator()(const f32x4 (&acc)[2][2][4][2], const Unit& u, int wr, int wc, int fr, int fq) const {
        const int rl = wr * 64 + fr, col0 = u.pn * BM + wc * 32 + 4 * fq;
        float* xb = (u.pm < 128 ? out + (size_t)u.pm * BM * D : (float*)(ws + OFF_XC) + (size_t)(u.pm - 128) * BM * D) + (size_t)rl * D + col0;
        const float* xr = (u.pm < 128 ? xin + (size_t)u.pm * BM * D : cin + (size_t)(u.pm - 128) * BM * D) + (size_t)rl * D + col0;
        const float* m2 = (const float*)(ws + OFF_MOD) + ((size_t)(l * 17 + (u.pm < 128 ? (u.pm >> 3) : 16)) * 6 + 2) * D + col0;
        f32x4 gv[2][2];
#pragma unroll
        for (int bj = 0; bj < 2; ++bj)
#pragma unroll
            for (int n = 0; n < 2; ++n) gv[bj][n] = *(const f32x4*)(m2 + bj * HALF + n * 16);
        f32x4 xv[2][2][2][2];
#define EO_LOAD(G, BUF) do { _Pragma("unroll") for (int mm = 0; mm < 2; ++mm) { const int ai_ = (G) >> 1, m_ = ((G) & 1) * 2 + mm; const size_t ro_ = (size_t)(ai_ * HALF + m_ * 16) * D; \
            _Pragma("unroll") for (int bj = 0; bj < 2; ++bj) _Pragma("unroll") for (int n = 0; n < 2; ++n) xv[BUF][mm][bj][n] = *(const f32x4*)(xr + ro_ + bj * HALF + n * 16); } } while (0)
        EO_LOAD(0, 0);
#pragma unroll
        for (int g = 0; g < 4; ++g) { const int cb = g & 1;
            if (g < 3) EO_LOAD(g + 1, cb ^ 1);
            asm volatile("" : "+v"(xv[cb][0][0][0]), "+v"(xv[cb][0][0][1]), "+v"(xv[cb][0][1][0]), "+v"(xv[cb][0][1][1]), "+v"(xv[cb][1][0][0]), "+v"(xv[cb][1][0][1]), "+v"(xv[cb][1][1][0]), "+v"(xv[cb][1][1][1]));
#pragma unroll
            for (int mm = 0; mm < 2; ++mm) { const int ai = g >> 1, m = (g & 1) * 2 + mm; const size_t ro = (size_t)(ai * HALF + m * 16) * D;
#pragma unroll
                for (int bj = 0; bj < 2; ++bj)
#pragma unroll
                    for (int n = 0; n < 2; ++n) *(f32x4*)(xb + ro + bj * HALF + n * 16) = xv[cb][mm][bj][n] + gv[bj][n] * acc[ai][bj][m][n]; }
        }
#undef EO_LOAD
    }
};
struct EpiS {
    static constexpr bool PERM = true; __device__ __forceinline__ bool keeps(const Unit&) const { return false; } bf16_t* st;
    __device__ __forceinline__ void operator()(const f32x4 (&acc)[2][2][4][2], const Unit& u, int wr, int wc, int fr, int fq) const {
        bf16_t* base = st + (size_t)(u.pm * BM + wr * 64 + fr) * NT + u.pn * BM + wc * 32 + 8 * fq;
#pragma unroll
        for (int ai = 0; ai < 2; ++ai)
#pragma unroll
            for (int m = 0; m < 4; ++m)
#pragma unroll
                for (int bj = 0; bj < 2; ++bj) { u32x4 p = pack8(acc[ai][bj][m][0], acc[ai][bj][m][1]);
                    p.x ^= ((p.x >> 15) & 0x00010001u) * 0x7fffu; p.y ^= ((p.y >> 15) & 0x00010001u) * 0x7fffu; p.z ^= ((p.z >> 15) & 0x00010001u) * 0x7fffu; p.w ^= ((p.w >> 15) & 0x00010001u) * 0x7fffu;
                    *(u32x4*)(base + (size_t)(ai * HALF + m * 16) * NT + bj * HALF) = p; }
    }
};
struct DftSched { int G, c, ctx;
    __device__ __forceinline__ bool next(int i, Unit& u) const { const int L = i * G + c; const int n = ctx ? NB : NB * 8; if (L >= n) return false;
        if (ctx) { u.pm = 0; u.pn = L; u.tag = L; u.nt = 8; } else { u.pm = L & 7; u.pn = L >> 3; u.tag = L >> 3; u.nt = 64; }
        u.kofs = 0; return true; } };
}


__device__ __forceinline__ void ph_gemm1_pg(const Params& P, int l, int bid, int nblk, unsigned char* smem) {
    PG8_LAS unsigned char* lds = (PG8_LAS unsigned char*)smem; const bf16_t* HB = (const bf16_t*)(P.ws + OFF_HB);
    { pg8::Gemm g{(const bf16_t*)(P.ws + OFF_HB8), (const bf16_t*)(P.ws + OFF_WG8 + (size_t)l * 3072 * D), D / 2, D / 2}; pg8::PlainSched S; S.T.init(NT / 256, 12, nblk, bid); S.nt = 8; pg8::EpiG8 E{P.ws, (const PG8_LAS unsigned char*)(lds + SIGLUT_OFF)};
      pg8::gemm_phase<pg8::EpiG8, pg8::PlainSched, true>(lds, g, S, E); }
    { pg8::Gemm g{HB, (const bf16_t*)(P.ws + OFF_W1T) + (size_t)l * 4096 * D, D, D}; pg8::PlainSched S; S.T.init(NT / 256, 4, nblk, nblk == 256 ? (bid + 64) & 255 : bid); S.nt = 16; pg8::EpiG1 E{P.ws}; pg8::gemm_phase(lds, g, S, E); }
    { pg8::Gemm g{(const bf16_t*)(P.ws + OFF_WFT) + (size_t)l * 512 * D, HB, D, D}; pg8::PlainSched S; S.T.init(2, NL / 256, nblk, bid); S.nt = 16; pg8::EpiGZ E{P.ws}; pg8::gemm_phase(lds, g, S, E); }
}
__device__ __forceinline__ void ph_gemm1_ctxz(const Params& P, int l, int c, int G, unsigned char* smem) {
    PG8_LAS unsigned char* lds = (PG8_LAS unsigned char*)smem;
    pg8::Gemm g{(const bf16_t*)(P.ws + OFF_WFT) + (size_t)l * 512 * D, (const bf16_t*)(P.ws + OFF_HB), D, D}; pg8::CtxZSched S{c, G, 16}; pg8::EpiGZ E{P.ws}; pg8::gemm_phase(lds, g, S, E);
}
__device__ __forceinline__ void ph_merge_pg(const Params& P, int l, int ntok, int bid, int nblk, unsigned char* smem) {
    PG8_LAS unsigned char* lds = (PG8_LAS unsigned char*)smem;
    pg8::Gemm g{(const bf16_t*)(P.ws + OFF_MIX), (const bf16_t*)(P.ws + OFF_WMT) + (size_t)l * D * D, D, D}; pg8::MergeSched S; S.T.init(ntok / 256, 4, nblk, bid); pg8::EpiMg E{P.ws}; pg8::gemm_phase(lds, g, S, E);
}
__device__ __forceinline__ void ph_out_pg(const Params& P, int l, int ntok, int bid, int nblk, unsigned char* smem) {
    PG8_LAS unsigned char* lds = (PG8_LAS unsigned char*)smem;
    pg8::Gemm g{(const bf16_t*)(P.ws + OFF_HB), (const bf16_t*)(P.ws + OFF_WOT) + (size_t)l * D * D, D, D}; pg8::PlainSched S; S.T.init(ntok / 256, 4, nblk, bid); S.nt = 16; pg8::EpiO E{P.out, P.ws, l, l == 0 ? P.x : (const float*)P.out, l == 0 ? P.ctx : (const float*)(P.ws + OFF_XC)}; pg8::gemm_phase(lds, g, S, E);
}
__device__ __forceinline__ void ph_score_pg(const Params& P, int l, int ntok, int bid, int nblk, unsigned char* smem) {
    PG8_LAS unsigned char* lds = (PG8_LAS unsigned char*)smem;
    pg8::Gemm g{(const bf16_t*)(P.ws + OFF_WST) + (size_t)l * 2048 * D, (const bf16_t*)(P.ws + OFF_HB), D, D}; pg8::PlainSched S; S.T.init(8, ntok / 256, nblk, bid); S.nt = 16; pg8::EpiS E{(bf16_t*)(P.ws + OFF_ST)}; pg8::gemm_phase(lds, g, S, E);
}


namespace attn_body {
using bf16=__hip_bfloat16;
using bf16x8=__attribute__((ext_vector_type(8)))short;
using s16x4=__attribute__((ext_vector_type(4)))short;
using f32x16=__attribute__((ext_vector_type(16)))float;
using u32x4=__attribute__((ext_vector_type(4)))unsigned;
constexpr int D=64,QP=512,KP=128,OP=1024;
constexpr int NW=8,QBLK=32,QB=QBLK*NW,KVBLK=64;
__device__ __forceinline__ int crow(int r,int hi){return (r&3)+8*(r>>2)+4*hi;}
#define SBAR() __builtin_amdgcn_sched_barrier(0)
constexpr int NSLOT=3, SLOTB=8192;
constexpr int LDS_K=0, LDS_V=NSLOT*SLOTB, LDS_WS=2*NSLOT*SLOTB, LDS_OST=LDS_WS+NW*64*4, LDS_BYTES=LDS_OST+NW*4096;
constexpr float C2=0.125f*1.4426950408889634f;
__device__ __forceinline__ void glds16(const void*gsrc,unsigned lds_dst){unsigned keep;
  asm volatile("s_mov_b32 %0, m0\n\ts_mov_b32 m0, %2\n\ts_nop 0\n\tglobal_load_lds_dwordx4 %1, off\n\ts_mov_b32 m0, %0":"=&s"(keep):"v"(gsrc),"s"(lds_dst):"memory");}
__device__ __forceinline__ float max3f(float a,float b,float c){float r;asm("v_max3_f32 %0, %1, %2, %3":"=v"(r):"v"(a),"v"(b),"v"(c));return r;}
__device__ __forceinline__ float max2f(float a,float b){float r;asm("v_max_f32_e32 %0, %1, %2":"=v"(r):"v"(a),"v"(b));return r;}
__device__ __forceinline__ float fadd_s(float a,float b){float r;asm("v_add_f32_e32 %0, %1, %2":"=v"(r):"v"(a),"v"(b));return r;}
__device__ __forceinline__ float fsub_s(float a,float b){float r;asm("v_sub_f32_e32 %0, %1, %2":"=v"(r):"v"(a),"v"(b));return r;}
typedef float f32x2_t __attribute__((ext_vector_type(2))); typedef __bf16 bf16x2_t __attribute__((ext_vector_type(2)));
__device__ __forceinline__ unsigned cvtpk_s(float lo,float hi){f32x2_t v={lo,hi};bf16x2_t b=__builtin_convertvector(v,bf16x2_t);return __builtin_bit_cast(unsigned,b);}
#define WAIT_BAR(N) asm volatile("s_waitcnt vmcnt(" #N ") lgkmcnt(0)\n\ts_barrier":::"memory")

__device__ __forceinline__ void qkt(f32x16&p0,f32x16&p1,const char*Kslot,const bf16x8*qr,const f32x16&negm,int r32,int hi){
  const char*kb=Kslot+hi*1024+r32*16;
  #pragma unroll
  for(int d0=0;d0<4;++d0){
    const bf16x8 b0=*reinterpret_cast<const bf16x8*>(kb+d0*2048);
    const bf16x8 b1=*reinterpret_cast<const bf16x8*>(kb+d0*2048+512);
    if(d0==0){p0=__builtin_amdgcn_mfma_f32_32x32x16_bf16(b0,qr[0],negm,0,0,0);p1=__builtin_amdgcn_mfma_f32_32x32x16_bf16(b1,qr[0],negm,0,0,0);}
    else{p0=__builtin_amdgcn_mfma_f32_32x32x16_bf16(b0,qr[d0],p0,0,0,0);p1=__builtin_amdgcn_mfma_f32_32x32x16_bf16(b1,qr[d0],p1,0,0,0);}}
}
typedef __attribute__((address_space(3))) const char* lds_cptr;
typedef short v4i16_t __attribute__((ext_vector_type(4)));
__device__ __forceinline__ void kload8(bf16x8*kf,lds_cptr kp){
  kf[0]=*(const __attribute__((address_space(3))) bf16x8*)(kp);      kf[1]=*(const __attribute__((address_space(3))) bf16x8*)(kp+512);
  kf[2]=*(const __attribute__((address_space(3))) bf16x8*)(kp+2048); kf[3]=*(const __attribute__((address_space(3))) bf16x8*)(kp+2560);
  kf[4]=*(const __attribute__((address_space(3))) bf16x8*)(kp+4096); kf[5]=*(const __attribute__((address_space(3))) bf16x8*)(kp+4608);
  kf[6]=*(const __attribute__((address_space(3))) bf16x8*)(kp+6144); kf[7]=*(const __attribute__((address_space(3))) bf16x8*)(kp+6656);
}
__device__ __forceinline__ void kload2(bf16x8*kf,lds_cptr kp,int j){ kf[2*j]=*(const __attribute__((address_space(3))) bf16x8*)(kp+j*2048); kf[2*j+1]=*(const __attribute__((address_space(3))) bf16x8*)(kp+j*2048+512); }
__device__ __forceinline__ s16x4 vtr(lds_cptr p){ return __builtin_bit_cast(s16x4,__builtin_amdgcn_ds_read_tr16_b64_v4i16((__attribute__((address_space(3))) v4i16_t*)p)); }
__device__ __forceinline__ float rowmax(const f32x16&p0,const f32x16&p1){
  float a=max3f(p0[0],p0[1],p1[0]),b=max3f(p0[2],p0[3],p1[1]);a=max3f(a,p1[2],p1[3]);
  #pragma unroll
  for(int r=4;r<16;r+=4){a=max3f(a,p0[r],p0[r+1]);b=max3f(b,p0[r+2],p0[r+3]);a=max3f(a,p1[r],p1[r+1]);b=max3f(b,p1[r+2],p1[r+3]);}
  const float m=max2f(a,b);
  auto rr=__builtin_amdgcn_permlane32_swap(__float_as_uint(m),__float_as_uint(m),false,false);
  return max2f(__uint_as_float(rr[0]),__uint_as_float(rr[1]));
}
__device__ __forceinline__ void pv(f32x16*o,int vb,bf16x8 pa0,bf16x8 pa1,bf16x8 pa2,bf16x8 pa3){
  #pragma unroll
  for(int d0=0;d0<2;++d0){s16x4 lo[4],hi[4];
    #pragma unroll
    for(int ks=0;ks<4;++ks){
      asm volatile("ds_read_b64_tr_b16 %0,%1 offset:%c2":"=&v"(lo[ks]):"v"(vb),"i"(d0*4096+ks*1024):"memory");
      asm volatile("ds_read_b64_tr_b16 %0,%1 offset:%c2":"=&v"(hi[ks]):"v"(vb),"i"(d0*4096+ks*1024+512):"memory");}
    asm volatile("s_waitcnt lgkmcnt(0)":::"memory");SBAR();
    #define PK(k) (bf16x8){lo[k][0],lo[k][1],lo[k][2],lo[k][3],hi[k][0],hi[k][1],hi[k][2],hi[k][3]}
    o[d0]=__builtin_amdgcn_mfma_f32_32x32x16_bf16(pa0,PK(0),o[d0],0,0,0);
    o[d0]=__builtin_amdgcn_mfma_f32_32x32x16_bf16(pa1,PK(1),o[d0],0,0,0);
    o[d0]=__builtin_amdgcn_mfma_f32_32x32x16_bf16(pa2,PK(2),o[d0],0,0,0);
    o[d0]=__builtin_amdgcn_mfma_f32_32x32x16_bf16(pa3,PK(3),o[d0],0,0,0);
    #undef PK
  }
}

#ifndef ATTN_STORE16
#define ATTN_STORE16(p,v) (*(u32x4*)(p)=(v))
#endif
template<int THRL> __device__ __forceinline__ void attn_unit(const bf16*Qu,const bf16*__restrict__ Kh,const bf16*__restrict__ Vh,bf16*Ou,const int NT,char*shm){
  const int tid=tidx(),lane=tid&63,r32=lane&31,hi=lane>>5; const int wid=__builtin_amdgcn_readfirstlane(tid>>6);
  const bf16*Qw=Qu+(long)(wid*QBLK)*QP;
  const unsigned lds0=(unsigned)(uintptr_t)shm;
  float*wsf=(float*)(shm+LDS_WS)+wid*64;
  const bf16*ksrc=Kh+(long)lane*KP+wid*8;
  const bf16*vsrc=Vh+(long)(16*(wid&3)+(lane>>2))*KP+(wid>>2)*32+(lane&3)*8;
  const unsigned kdst=lds0+LDS_K+wid*1024, vdst=lds0+LDS_V+wid*1024;
  #define DMA_K(t,slot) glds16(ksrc+(long)(t)*KVBLK*KP,(unsigned)__builtin_amdgcn_readfirstlane(kdst+(slot)))
  #define DMA_V(t,slot) glds16(vsrc+(long)(t)*KVBLK*KP,(unsigned)__builtin_amdgcn_readfirstlane(vdst+(slot)))
  const int vb0=(int)(lds0+LDS_V)+((lane>>4)&1)*32+(lane&3)*8+(4*hi+((lane&15)>>2))*64;
  const char*Kbase=shm+LDS_K; bf16x8 kf[8];
  const lds_cptr shm3=(lds_cptr)shm; const lds_cptr kp0=shm3+LDS_K+hi*1024+r32*16; const lds_cptr vp0=shm3+LDS_V+((lane>>4)&1)*32+(lane&3)*8+(4*hi+((lane&15)>>2))*64;
  DMA_K(0,0);DMA_V(0,0);DMA_K(1,SLOTB);
  bf16x8 qr[4];
  #pragma unroll
  for(int d0=0;d0<4;++d0)qr[d0]=*reinterpret_cast<const bf16x8*>(&Qw[(long)r32*QP+d0*16+hi*8]);
  float mhat=0.f,l_reg=0.f;f32x16 o[2];o[0]=f32x16{};o[1]=f32x16{};f32x16 negm=f32x16{};asm volatile("":"+v"(negm));
  #define CMASK(P0,P1,t) do{}while(0)
  bool resc=false;
  #define START(P0,P1) do{ const float rm=rowmax(P0,P1); resc=false; \
    { const float dl=rm; mhat=fadd_s(mhat,dl); \
      _Pragma("unroll") for(int r=0;r<16;++r){P0[r]=fsub_s(P0[r],dl);P1[r]=fsub_s(P1[r],dl);} \
      _Pragma("unroll") for(int r=0;r<16;++r)negm[r]=-mhat; asm volatile("":"+v"(negm)); } \
    _Pragma("unroll") for(int r=0;r<16;++r)P0[r]=__builtin_amdgcn_exp2f(P0[r]); }while(0)
  #define RESC() do{ if(resc){ asm volatile("s_waitcnt lgkmcnt(0)":::"memory"); \
      _Pragma("unroll") for(int d_=0;d_<2;++d_) _Pragma("unroll") for(int r=0;r<16;++r)o[d_][r]*=wsf[crow(r,hi)]; } }while(0)
  f32x16 pA0,pA1,pB0,pB1;
  int sl_prev=0,sl_cur=0,sl_next=SLOTB;
  #define ROT() do{sl_prev=sl_cur;sl_cur=sl_next;sl_next=(sl_next==(NSLOT-1)*SLOTB)?0:sl_next+SLOTB;}while(0)
  DMA_K(2,2*SLOTB);
  WAIT_BAR(3);
  qkt(pA0,pA1,Kbase,qr,negm,r32,hi);asm volatile("s_nop 15\n\ts_nop 7":"+v"(pA0),"+v"(pA1));CMASK(pA0,pA1,0);
  START(pA0,pA1);
  _Pragma("unroll") for(int r=0;r<16;++r)pA1[r]=__builtin_amdgcn_exp2f(pA1[r]);
  WAIT_BAR(0);
  DMA_K(3,0);DMA_V(1,SLOTB);
  ROT();
  kload8(kf,kp0+sl_cur);
  WAIT_BAR(2);
  s16x4 vlo[8],vhi[8]; u32x4 pw0,pw1,pw2,pw3;
  #define PKW(P,B) cvtpk_s(P[B],P[B+1])
  #define PAF(k) __builtin_bit_cast(bf16x8,pw##k)
  #define VFR(i) (bf16x8){vlo[i][0],vlo[i][1],vlo[i][2],vlo[i][3],vhi[i][0],vhi[i][1],vhi[i][2],vhi[i][3]}
  #define PIN(x) asm volatile("":"+v"(x))
  #define MX3(a,b,c) __builtin_fmaxf(__builtin_fmaxf((a),(b)),(c))
  #define GAPA(MF,A0,A1,A2,A3,W0,W1,PW) do{ MF; sacc+=A0; sacc+=A1; sacc+=A2; sacc+=A3; PIN(sacc); W0; W1; PIN(PW); SBAR(); }while(0)
  #define EX(v) __builtin_amdgcn_exp2f(v)
  #define GAPB(MF,X,B) do{ MF; X[B]=EX(X[B]); X[B+1]=EX(X[B+1]); X[B+2]=EX(X[B+2]); X[B+3]=EX(X[B+3]); PIN(X); SBAR(); }while(0)
  #define VRD(i) do{ vlo[i]=vtr(vp_+(((i)>>2)*4096+((i)&3)*1024)); vhi[i]=vtr(vp_+(((i)>>2)*4096+((i)&3)*1024+512)); }while(0)
  #define KRD(G,j) do{ if(G){ kload2(kf,kp0+sl_next,j); SBAR(); } }while(0)
  #define STEP(C0,C1,P0,P1,t,GK,GV,GL) do{ SBAR(); \
    const lds_cptr vp_=vp0+sl_prev; \
    VRD(0); SBAR(); float sacc=(P0[0]+P0[1]); \
    GAPA(C0=__builtin_amdgcn_mfma_f32_32x32x16_bf16(kf[0],qr[0],negm,0,0,0), P0[2],P0[3],P0[4],P0[5],     pw0[0]=PKW(P0,0), pw0[1]=PKW(P0,2), pw0); \
    VRD(4); SBAR(); GAPA(C1=__builtin_amdgcn_mfma_f32_32x32x16_bf16(kf[1],qr[0],negm,0,0,0), P0[6],P0[7],P0[8],P0[9],     pw0[2]=PKW(P0,4), pw0[3]=PKW(P0,6), pw0); \
    VRD(1); SBAR(); GAPA(C0=__builtin_amdgcn_mfma_f32_32x32x16_bf16(kf[2],qr[1],C0,0,0,0),   P0[10],P0[11],P0[12],P0[13], pw1[0]=PKW(P0,8), pw1[1]=PKW(P0,10), pw1); \
    VRD(5); SBAR(); GAPA(C1=__builtin_amdgcn_mfma_f32_32x32x16_bf16(kf[3],qr[1],C1,0,0,0),   P0[14],P0[15],P1[0],P1[1],   pw1[2]=PKW(P0,12),pw1[3]=PKW(P0,14), pw1); \
    VRD(2); SBAR(); GAPA(C0=__builtin_amdgcn_mfma_f32_32x32x16_bf16(kf[4],qr[2],C0,0,0,0),   P1[2],P1[3],P1[4],P1[5],     pw2[0]=PKW(P1,0), pw2[1]=PKW(P1,2), pw2); \
    VRD(6); SBAR(); GAPA(C1=__builtin_amdgcn_mfma_f32_32x32x16_bf16(kf[5],qr[2],C1,0,0,0),   P1[6],P1[7],P1[8],P1[9],     pw2[2]=PKW(P1,4), pw2[3]=PKW(P1,6), pw2); \
    VRD(3); SBAR(); GAPA(C0=__builtin_amdgcn_mfma_f32_32x32x16_bf16(kf[6],qr[3],C0,0,0,0),   P1[10],P1[11],P1[12],P1[13], pw3[0]=PKW(P1,8), pw3[1]=PKW(P1,10), pw3); \
    VRD(7); SBAR(); GAPA(C1=__builtin_amdgcn_mfma_f32_32x32x16_bf16(kf[7],qr[3],C1,0,0,0),   P1[14],P1[15],0.f,0.f,       pw3[2]=PKW(P1,12),pw3[3]=PKW(P1,14), pw3); \
    l_reg+=sacc; \
    if(GK){DMA_K((t)+3,sl_cur);} if(GV){DMA_V((t)+1,sl_next);} \
    CMASK(C0,C1,t); \
    { float a=MX3(C0[0],C0[1],C1[0]),b=MX3(C0[2],C0[3],C1[1]); a=MX3(a,C1[2],C1[3]); \
      _Pragma("unroll") for(int r=4;r<16;r+=4){a=MX3(a,C0[r],C0[r+1]);b=MX3(b,C0[r+2],C0[r+3]);a=MX3(a,C1[r],C1[r+1]);b=MX3(b,C1[r+2],C1[r+3]);} \
      float rm=__builtin_fmaxf(a,b); { auto rr=__builtin_amdgcn_permlane32_swap(__float_as_uint(rm),__float_as_uint(rm),false,false); rm=__builtin_fmaxf(__uint_as_float(rr[0]),__uint_as_float(rr[1])); } \
      resc=false; \
      if(__builtin_expect(__any(rm>(float)THRL),0)){ const float dl=__builtin_fmaxf(rm,0.f); mhat+=dl; \
        _Pragma("unroll") for(int r=0;r<16;++r){C0[r]-=dl;C1[r]-=dl;} \
        _Pragma("unroll") for(int r=0;r<16;++r)negm[r]=-mhat; asm volatile("":"+v"(negm)); \
        const float f=__builtin_amdgcn_exp2f(-dl); l_reg*=f; if(hi==0)wsf[r32]=f; resc=true; } } \
    SBAR(); \
    GAPB(o[0]=__builtin_amdgcn_mfma_f32_32x32x16_bf16(PAF(0),VFR(0),o[0],0,0,0), C0,0); \
    GAPB(o[1]=__builtin_amdgcn_mfma_f32_32x32x16_bf16(PAF(0),VFR(4),o[1],0,0,0), C0,4); \
    KRD(GL,0); GAPB(o[0]=__builtin_amdgcn_mfma_f32_32x32x16_bf16(PAF(1),VFR(1),o[0],0,0,0), C0,8); \
    KRD(GL,1); GAPB(o[1]=__builtin_amdgcn_mfma_f32_32x32x16_bf16(PAF(1),VFR(5),o[1],0,0,0), C0,12); \
    KRD(GL,2); GAPB(o[0]=__builtin_amdgcn_mfma_f32_32x32x16_bf16(PAF(2),VFR(2),o[0],0,0,0), C1,0); \
    KRD(GL,3); GAPB(o[1]=__builtin_amdgcn_mfma_f32_32x32x16_bf16(PAF(2),VFR(6),o[1],0,0,0), C1,4); \
    GAPB(o[0]=__builtin_amdgcn_mfma_f32_32x32x16_bf16(PAF(3),VFR(3),o[0],0,0,0), C1,8); \
    GAPB(o[1]=__builtin_amdgcn_mfma_f32_32x32x16_bf16(PAF(3),VFR(7),o[1],0,0,0), C1,12); \
    }while(0)
  int t=1;
  #undef CMASK
  #define CMASK(P0,P1,t) do{}while(0)
  for(;t+5<NT;t+=2){
    STEP(pB0,pB1,pA0,pA1,t,true,true,true);     WAIT_BAR(2); RESC(); ROT();
    STEP(pA0,pA1,pB0,pB1,t+1,true,true,true);   WAIT_BAR(2); RESC(); ROT();
  }
  #undef CMASK
  #define CMASK(P0,P1,t) do{}while(0)
  #define ENDW(tt) do{ if((tt)+3<NT){WAIT_BAR(2);} else if((tt)+2<NT){WAIT_BAR(1);} else {WAIT_BAR(0);} }while(0)
  for(;t+1<NT;t+=2){
    STEP(pB0,pB1,pA0,pA1,t,(t+3<NT),(t+1<NT),(t+1<NT));       ENDW(t);   RESC(); ROT();
    STEP(pA0,pA1,pB0,pB1,t+1,(t+4<NT),(t+2<NT),(t+2<NT));     ENDW(t+1); RESC(); ROT();
  }
  STEP(pB0,pB1,pA0,pA1,NT-1,false,false,false); RESC();
  { float sacc=pB0[0]+pB0[1]; _Pragma("unroll") for(int r=2;r<16;++r)sacc+=pB0[r]; _Pragma("unroll") for(int r=0;r<16;++r)sacc+=pB1[r]; l_reg+=sacc;
    pw0=(u32x4){PKW(pB0,0),PKW(pB0,2),PKW(pB0,4),PKW(pB0,6)};pw1=(u32x4){PKW(pB0,8),PKW(pB0,10),PKW(pB0,12),PKW(pB0,14)};pw2=(u32x4){PKW(pB1,0),PKW(pB1,2),PKW(pB1,4),PKW(pB1,6)};pw3=(u32x4){PKW(pB1,8),PKW(pB1,10),PKW(pB1,12),PKW(pB1,14)};
    SBAR(); pv(o,vb0+sl_cur,PAF(0),PAF(1),PAF(2),PAF(3)); }
  #undef PKW
  #undef PAF
  #undef VFR
  #undef PIN
  #undef MX3
  #undef GAPA
  #undef GAPB
  #undef EX
  #undef VRD
  #undef KRD
  #undef STEP
  #undef ENDW
  {auto rr=__builtin_amdgcn_permlane32_swap(__float_as_uint(l_reg),__float_as_uint(l_reg),false,false);l_reg=__uint_as_float(rr[0])+__uint_as_float(rr[1]);}
  if(hi==0)wsf[32+r32]=l_reg;asm volatile("s_waitcnt lgkmcnt(0)":::"memory");
  float rli[16];
  #pragma unroll
  for(int r=0;r<16;++r)rli[r]=__builtin_amdgcn_rcpf(wsf[32+crow(r,hi)]);
  bf16*Ow=Ou+(long)(wid*QBLK)*OP;
  { bf16*stg=(bf16*)(shm+LDS_OST)+wid*2048;
    #pragma unroll
    for(int r=0;r<16;++r){const int orow=crow(r,hi);
      #pragma unroll
      for(int d0=0;d0<2;++d0)stg[orow*64+d0*32+r32]=__float2bfloat16(o[d0][r]*rli[r]);}
    asm volatile("s_waitcnt lgkmcnt(0)":::"memory");
    #pragma unroll
    for(int i=0;i<4;++i){const int row=i*8+(lane>>3),ch=lane&7; const u32x4 v=*(const u32x4*)(stg+row*64+ch*8); ATTN_STORE16(Ow+(long)row*OP+ch*8,v);} }
  asm volatile("s_waitcnt lgkmcnt(0)\n\ts_barrier":::"memory");
  #undef DMA_K
  #undef DMA_V
  #undef CMASK
  #undef START
  #undef RESC
  #undef ROT
}
constexpr int ATTN_LDS_BYTES=LDS_BYTES;
#undef SBAR
#undef WAIT_BAR
}

__device__ __forceinline__ void ph_attn_dft(const Params& P, int bid, int nblk, unsigned char* smem, int with_ctx) {
    PG8_LAS unsigned char* lds = (PG8_LAS unsigned char*)smem; bf16_t* MIXb = (bf16_t*)(P.ws + OFF_MIX);
    const bool bal = (nblk == 256);
    { pg8::Gemm g{(const bf16_t*)(P.ws + OFF_ADFT), (const bf16_t*)(P.ws + OFF_ZTL), 4096, 4096}; pg8::DftSched S{nblk, bid, 0}; pg8::EpiRe8 E{MIXb, 0}; pg8::gemm_phase(lds, g, S, E); }
    if (with_ctx) { pg8::Gemm g{(const bf16_t*)(P.ws + OFF_ADFTC), (const bf16_t*)(P.ws + OFF_ZTC), 512, 512}; pg8::DftSched S{nblk, bal ? (bid >= 128 ? bid - 128 : 1 << 20) : bid, 1}; pg8::EpiRe8 E{MIXb, 1}; pg8::gemm_phase(lds, g, S, E); }
    __syncthreads();
    const attn_body::bf16* QR = (const attn_body::bf16*)(P.ws + OFF_QR); const attn_body::bf16* KA = (const attn_body::bf16*)(P.ws + OFF_KALL); const attn_body::bf16* VA = (const attn_body::bf16*)(P.ws + OFF_VALL);
    attn_body::bf16* MIX = (attn_body::bf16*)(P.ws + OFF_MIX);
    int start, cnt, stride, shortU;
    if (bal) { if (bid < 128) { start = 3 * ((bid & 7) * 16 + (bid >> 3)); cnt = 3; stride = 1; shortU = -1; }
               else { const int vj = (bid & 7) * 16 + ((bid - 128) >> 3); start = 384 + 5 * vj; cnt = 5; stride = 1; shortU = with_ctx ? 1024 + vj : -1; } }
    else { const int vcu = (nblk % 8 == 0) ? (bid % 8) * (nblk / 8) + bid / 8 : bid; const int nU = with_ctx ? 1152 : 1024; start = vcu; stride = nblk; cnt = vcu < nU ? (nU - 1 - vcu) / nblk + 1 : 0; shortU = -1; }
    for (int k = 0; k <= cnt; ++k) {
        const int U = k < cnt ? start + k * stride : shortU; if (U < 0) break;
        int b, h, qrow, krow, NTl;
        if (U < 1024) { b = U >> 6; h = (U >> 3) & 7; qrow = b * SEQ + (U & 7) * 256; krow = b * KV; NTl = KV / 64; }
        else { const int j = U - 1024; b = j >> 3; h = j & 7; qrow = NL + b * CTX; krow = b * KV + SEQ; NTl = CTX / 64; }
        attn_body::attn_unit<8>(QR + (size_t)qrow * 512 + h * 64, KA + (size_t)krow * 128 + (h >> 2) * 64, VA + (size_t)krow * 128 + (h >> 2) * 64, MIX + (size_t)qrow * D + 512 + h * 64, NTl, (char*)smem);
    }
}

#define XB_TMO      128
#define XB_XCNT(j)  (256  + 64 * (j))
#define XB_XSUB(j)  (1280 + 64 * (j))
#define XB_XGEN(j)  (2304 + 64 * (j))
#define XB_TOP      3328
#define XB_TOPGEN   3392
#define XCD_BAR_WORDS 3456
#define XB_SPIN_CAP (1u << 18)
#define LAS __attribute__((address_space(3)))

__device__ __forceinline__ unsigned xb_ld(unsigned* p)              { return __hip_atomic_load(p, __ATOMIC_RELAXED, __HIP_MEMORY_SCOPE_AGENT); }
__device__ __forceinline__ unsigned xb_add(unsigned* p, unsigned v) { return __hip_atomic_fetch_add(p, v, __ATOMIC_RELAXED, __HIP_MEMORY_SCOPE_AGENT); }
__device__ __forceinline__ unsigned xb_xcc_id() { return (unsigned)__builtin_amdgcn_s_getreg((3 << 11) | 20) & 0xFu; }
#define XB_SPIN(cond, bar) do { unsigned _sp = 0; while (cond) { __builtin_amdgcn_s_sleep(1); \
    if ((++_sp & 255u) == 0u) { if (xb_ld(&(bar)[XB_TMO])) break; if (_sp > XB_SPIN_CAP) { atomicAdd(&(bar)[XB_TMO], 1u); break; } } } } while (0)

struct XcdBarrier {
    unsigned* bar; unsigned x;
    volatile LAS unsigned* st;
};
__device__ __forceinline__ XcdBarrier xcd_barrier_post(unsigned* bar, volatile LAS unsigned* st) {
    XcdBarrier b; b.bar = bar; b.x = xb_xcc_id(); b.st = st;
    if (threadIdx.x == 0) (void)xb_add(&bar[XB_XCNT(b.x)], 1u);
    return b;
}
__device__ __forceinline__ void xcd_barrier_complete(unsigned* bar, unsigned x, unsigned& nloc, unsigned& nx) {
    const unsigned G = gridDim.x * gridDim.y * gridDim.z;
    unsigned sum, cnt, mine, sp = 0u;
    for (;;) {
        sum = 0u; cnt = 0u; mine = 0u;
#pragma unroll
        for (unsigned j = 0; j < 16; ++j) { const unsigned c = xb_ld(&bar[XB_XCNT(j)]); sum += c; cnt += (c > 0u) ? 1u : 0u; mine = (j == x) ? c : mine; }
        if (sum == G) break;
        __builtin_amdgcn_s_sleep(1);
        if ((++sp & 255u) == 0u) { if (xb_ld(&bar[XB_TMO])) break; if (sp > XB_SPIN_CAP) { atomicAdd(&bar[XB_TMO], 1u); break; } }
    }
    nloc = mine > 0u ? mine : 1u; nx = cnt > 0u ? cnt : 1u;
}
__device__ __forceinline__ void xcd_barrier(const XcdBarrier& b) {
    asm volatile("s_waitcnt vmcnt(0)" ::: "memory");
    __syncthreads();
    if (threadIdx.x == 0) {
        unsigned* bar = b.bar; const unsigned bx = xb_xcc_id();
        __builtin_amdgcn_s_waitcnt(0);
        unsigned nloc = b.st[0], nx = b.st[1];
        if (nloc == 0u) { xcd_barrier_complete(bar, bx, nloc, nx); b.st[0] = nloc; b.st[1] = nx; }
        const unsigned old = xb_add(&bar[XB_XSUB(bx)], 1u);
        const unsigned gen = old / nloc;
        if (old + 1u == (gen + 1u) * nloc) {
            __builtin_amdgcn_fence(__ATOMIC_RELEASE, "agent");
            asm volatile("s_waitcnt vmcnt(0)" ::: "memory");
            const unsigned og = xb_add(&bar[XB_TOP], 1u);
            const unsigned tg = og / nx;
            if (og + 1u == (tg + 1u) * nx) xb_add(&bar[XB_TOPGEN], 1u);
            else XB_SPIN(xb_ld(&bar[XB_TOPGEN]) == tg, bar);
            __builtin_amdgcn_fence(__ATOMIC_ACQUIRE, "agent");
            xb_add(&bar[XB_XGEN(bx)], 1u);
            asm volatile("s_waitcnt vmcnt(0)" ::: "memory");
        } else {
            XB_SPIN(xb_ld(&bar[XB_XGEN(bx)]) == gen, bar);
            __builtin_amdgcn_fence(__ATOMIC_ACQUIRE, "agent");
            asm volatile("s_waitcnt vmcnt(0)" ::: "memory");
        }
    }
    __syncthreads();
}

constexpr int LDS_BYTES = 147456;
constexpr int MISC_OFF = 131072 + 320;

__global__ void __launch_bounds__(512, 2) mega_fwd(Params P) {
    extern __shared__ __attribute__((aligned(16))) unsigned char smem[];
    const int bid = blockIdx.x, nblk = gridDim.x;
    for (int u = threadIdx.x; u < (LDS_BYTES - 131072) / 4; u += 512) ((LAS unsigned*)((LAS unsigned char*)smem + 131072))[u] = 0u;
    __syncthreads();
    for (int u = threadIdx.x; u < 1024; u += 512) ((LAS unsigned char*)smem)[SIGLUT_OFF + u] = (unsigned char)__builtin_rintf(255.0f * sigmoidf_((float)(u - 512) * (1.0f / 64.0f)));
    __syncthreads();
    XcdBarrier bar = xcd_barrier_post((unsigned*)(P.ws + OFF_CTL), (volatile LAS unsigned*)((LAS unsigned char*)smem + MISC_OFF) + 8);
    float* ldsf = (float*)smem;
#define GASQ __attribute__((address_space(1)))
#define LND(m) Q.m = (decltype(Q.m))((const char*)Q.m + z_)
#ifndef DUPM
#define DUPM 0
#endif
#define DUP(bit, call) do { call; if (DUPM & (1 << (bit))) { call; } } while (0)
#define PH(call) do { Params Q = P; long z_ = 0; asm volatile("" : "+s"(z_)); LND(ws); LND(out); LND(x); LND(c); LND(ctx); LND(c_ctx); LND(ada_w); LND(ada_b); LND(norm_mix); LND(w_in); LND(fourier_w); LND(pool_w); LND(pool_scale); LND(pool_proj); \
        LND(q_norm); LND(k_norm); LND(attn_proj); LND(w_out); LND(norm_ffn); LND(peer_wq); LND(peer_keys); LND(peer_u); LND(peer_v); call; } while (0)
    for (int rep = 0; rep < ((DUPM & (1 << 11)) ? 2 : 1); ++rep) {
    PH(ph_mod(Q, bid, nblk, ldsf)); PH(ph_tables(Q, bid, nblk)); PH(ph_wtrans(Q, bid, nblk, ldsf)); PH(ph_wft(Q, bid, nblk, ldsf)); PH(ph_wg8(Q, bid, nblk, ldsf)); PH(ph_wpool(Q, bid, nblk, ldsf)); PH(ph_wst(Q, bid, nblk, 0, 1)); PH(ph_peer_cvt(Q, bid, nblk, 0, 1));
    }
    xcd_barrier(bar);
#pragma unroll 1
    for (int l = 0; l < DEPTH; ++l) {
        const int ntok = (l == DEPTH - 1) ? NL : NT;
        DUP(0, PH(ph_norm(Q, l, 0, NT, bid, nblk, l == 0)));      xcd_barrier(bar);
        DUP(1, PH(ph_gemm1_pg(Q, l, bid, nblk, smem)));        xcd_barrier(bar);
        {
            const bool withz = l < DEPTH - 1, split = withz && nblk > 64;
            const int zc = split ? bid : bid, zG = split ? (1 << 20) : nblk;
            if (withz && (split ? bid < 32 : true)) { PH(ph_gemm1_ctxz(Q, l, zc, zG, smem)); }
            if (!split || bid >= 32) { PH(ph_l3(Q, l, split ? bid - 32 : bid, split ? nblk - 32 : nblk)); }
        }
        xcd_barrier(bar);
        DUP(3, PH(ph_attn_dft(Q, bid, nblk, smem, l < DEPTH - 1)));      xcd_barrier(bar);
        DUP(4, PH(ph_merge_pg(Q, l, ntok, bid, nblk, smem)));
        if (l < DEPTH - 1) {
            if (nblk == 256) { if (bid >= 64) { PH(ph_peer_cvt(Q, bid - 64, 192, l + 1, l + 2, 0, 1)); PH(ph_wst(Q, bid - 64, 192, l + 1, l + 2)); } }
            else { PH(ph_peer_cvt(Q, bid, nblk, l + 1, l + 2)); PH(ph_wst(Q, bid, nblk, l + 1, l + 2)); }
        }
        xcd_barrier(bar);
        PH(ph_out_pg(Q, l, ntok, bid, nblk, smem));          xcd_barrier(bar);
        DUP(5, PH(ph_norm(Q, l, 1, ntok, bid, nblk)));      xcd_barrier(bar);
        DUP(6, PH(ph_score_pg(Q, l, ntok, bid, nblk, smem)));        xcd_barrier(bar);
        DUP(7, PH(ph_topk(Q, ntok, bid, nblk, smem)));
        if (l < DEPTH - 1 && nblk == 256 && bid >= 64) { PH(ph_peer_cvt(Q, bid - 64, 192, l + 1, l + 2, 1, 2)); }
        xcd_barrier(bar);
        DUP(8, PH(ph_peer_u(Q, l, ntok, bid, nblk)));    xcd_barrier(bar);
        DUP(9, PH(ph_peer_a(Q, ntok, bid, nblk)));       xcd_barrier(bar);
        PH(ph_peer_v(Q, l, ntok, bid, nblk)); if (DUPM & (1 << 10)) { PH(ph_peer_v(Q, l, ntok, bid, nblk, true)); }   xcd_barrier(bar);
    }
#undef PH
#undef DUP
#undef LND
#undef GASQ
}

extern "C" void kernel_launch(void* const* d_in, const int* in_sizes, int n_in, void* d_out, int out_size, void* d_ws, size_t ws_size, hipStream_t stream) {
    static int grid = 0;
    if (grid == 0) {
        if (n_in != 21 || ws_size < WS_END) { grid = -1; return; }
        int dev = 0, cus = 0, per_cu = 0;
        if (hipGetDevice(&dev) != hipSuccess || hipDeviceGetAttribute(&cus, hipDeviceAttributeMultiprocessorCount, dev) != hipSuccess) { grid = -1; return; }
        if (hipFuncSetAttribute((const void*)mega_fwd, hipFuncAttributeMaxDynamicSharedMemorySize, LDS_BYTES) != hipSuccess) { grid = -1; return; }
        if (hipOccupancyMaxActiveBlocksPerMultiprocessor(&per_cu, (const void*)mega_fwd, 512, LDS_BYTES) != hipSuccess || per_cu < 1) { (void)hipGetLastError(); }
        grid = (cus / 8) * 8;
    }
    if (grid < 0) return;
    (void)hipMemsetAsync((char*)d_ws + OFF_CTL, 0, 65536, stream);
    Params P{};
    const float** f = (const float**)&P;
    for (int i = 0; i < 21; ++i) f[i] = (const float*)d_in[i];
    P.out = (float*)d_out; P.ws = (unsigned char*)d_ws;
    hipLaunchKernelGGL(mega_fwd, dim3(grid), dim3(512), LDS_BYTES, stream, P);
}
```

```cpp
#include <hip/hip_runtime.h>
#include <stdint.h>
#include <hip/hip_bf16.h>
#include <cmath>

typedef unsigned short bf16_t;
typedef short bf16x8 __attribute__((ext_vector_type(8)));
typedef float f32x4 __attribute__((ext_vector_type(4)));
typedef float f32x16 __attribute__((ext_vector_type(16)));
typedef unsigned u32x4 __attribute__((ext_vector_type(4)));
typedef unsigned u32x2 __attribute__((ext_vector_type(2)));
typedef float f32x2_t __attribute__((ext_vector_type(2)));
typedef __bf16 bf16x2_t __attribute__((ext_vector_type(2)));
typedef int i32x8 __attribute__((ext_vector_type(8)));
typedef int i32x4_ __attribute__((ext_vector_type(4)));
constexpr int SIGLUT_OFF = 131072 + 1024;
constexpr float G8_SCALE = 64.0f;

constexpr int D = 1024, NB = 16, SEQ = 2048, DEPTH = 4, CTX = 256;
constexpr int NL = NB * SEQ, NC = NB * CTX, NT = NL + NC;
constexpr int INC = 4352;
constexpr int KV = SEQ + CTX;
constexpr int NEXP = 16384;
constexpr float C2 = 0.125f * 1.4426950408889634f;
constexpr float EPS = 1e-6f;

constexpr size_t MiB = 1u << 20;
constexpr size_t OFF_CTL = 0;
constexpr size_t OFF_MOD = 1 * MiB;
constexpr size_t OFF_SC = 3 * MiB + 512 * 1024;
constexpr size_t OFF_ROPE = 3 * MiB;
constexpr size_t OFF_XC = 4 * MiB;
constexpr size_t OFF_HB = 20 * MiB;
constexpr size_t OFF_MIX = 92 * MiB;
constexpr size_t OFF_KALL = 164 * MiB;
constexpr size_t OFF_VALL = 173 * MiB;
constexpr size_t OFF_EID = 182 * MiB;
constexpr size_t OFF_GW = 200 * MiB;
constexpr size_t OFF_GT = 218 * MiB;
constexpr size_t OFF_QR = 434 * MiB;
constexpr size_t OFF_ZTL = 470 * MiB;
constexpr size_t OFF_ZTC = 502 * MiB;
constexpr size_t OFF_PP = 506 * MiB;
constexpr size_t OFF_ST = 218 * MiB;
constexpr size_t OFF_W1T = 524 * MiB;
constexpr size_t OFF_WFT = 556 * MiB;
constexpr size_t OFF_WMT = 560 * MiB;
constexpr size_t OFF_WOT = 568 * MiB;
constexpr size_t OFF_WST = 576 * MiB;
constexpr size_t OFF_ADFT = 592 * MiB;
constexpr size_t OFF_ADFTC = 608 * MiB;
constexpr size_t OFF_PU = 609 * MiB;
constexpr size_t OFF_PV = 737 * MiB;
constexpr size_t OFF_WG8 = 866 * MiB;
constexpr size_t OFF_HB8 = 880 * MiB;
constexpr size_t WS_END = 916 * MiB;

struct Params {
    const float *x, *c, *ctx, *c_ctx, *ada_w, *ada_b, *norm_mix, *w_in, *fourier_w, *pool_w, *pool_scale, *pool_proj, *q_norm, *k_norm,
        *attn_proj, *w_out, *norm_ffn, *peer_wq, *peer_keys, *peer_u, *peer_v;
    float* out;
    unsigned char* ws;
};

__device__ __forceinline__ unsigned pk_bf16(float lo, float hi) { f32x2_t v = {lo, hi}; bf16x2_t b = __builtin_convertvector(v, bf16x2_t); return __builtin_bit_cast(unsigned, b); }
__device__ __forceinline__ float bf_lo(unsigned u) { return __uint_as_float(u << 16); }
__device__ __forceinline__ float bf_hi(unsigned u) { return __uint_as_float(u & 0xffff0000u); }
__device__ __forceinline__ float sigmoidf_(float x) { return __builtin_amdgcn_rcpf(1.0f + __expf(-x)); }
__device__ __forceinline__ float gelu_tanh(float x) { const float y = 0.7978845608028654f * (x + 0.044715f * x * x * x); const float t = 1.0f - 2.0f * __builtin_amdgcn_rcpf(1.0f + __expf(2.0f * y)); return 0.5f * x * (1.0f + t); }
template <int CTRL> __device__ __forceinline__ float dpp_f(float v) { return __builtin_bit_cast(float, __builtin_amdgcn_update_dpp(0, __builtin_bit_cast(int, v), CTRL, 0xF, 0xF, true)); }
#define DPP_F(v, ctrl) dpp_f<(ctrl)>(v)
__device__ __forceinline__ float xsum16(float v) { const unsigned u = __builtin_bit_cast(unsigned, v); auto r = __builtin_amdgcn_permlane16_swap(u, u, false, false); return __builtin_bit_cast(float, (unsigned)r[0]) + __builtin_bit_cast(float, (unsigned)r[1]); }
__device__ __forceinline__ float xsum32(float v) { const unsigned u = __builtin_bit_cast(unsigned, v); auto r = __builtin_amdgcn_permlane32_swap(u, u, false, false); return __builtin_bit_cast(float, (unsigned)r[0]) + __builtin_bit_cast(float, (unsigned)r[1]); }
__device__ __forceinline__ float sum8(float v) { v += DPP_F(v, 0xB1); v += DPP_F(v, 0x4E); v += DPP_F(v, 0x141); return v; }
__device__ __forceinline__ float wave_sum(float v) { v = sum8(v); v += DPP_F(v, 0x140); v = xsum16(v); return xsum32(v); }
__device__ __forceinline__ int tidx() { int t = threadIdx.x; asm volatile("" : "+v"(t)); return t; }
__device__ __forceinline__ float dot2bf(unsigned a, unsigned b, float acc) { return __builtin_amdgcn_fdot2_f32_bf16(__builtin_bit_cast(bf16x2_t, a), __builtin_bit_cast(bf16x2_t, b), acc, false); }
__device__ __forceinline__ float dot8(u32x4 a, u32x4 b, float acc) {
    const unsigned a0 = a.x, a1 = a.y, a2 = a.z, a3 = a.w, b0 = b.x, b1 = b.y, b2 = b.z, b3 = b.w;
    acc = dot2bf(a0, b0, acc); acc = dot2bf(a1, b1, acc); acc = dot2bf(a2, b2, acc); acc = dot2bf(a3, b3, acc);
    return acc;
}
__device__ __forceinline__ float* xrow_ptr(const Params& P, int row) { return row < NL ? P.out + (size_t)row * D : (float*)(P.ws + OFF_XC) + (size_t)(row - NL) * D; }
__device__ __forceinline__ int mod_r(int row) { return row < NL ? (row >> 11) : 16; }
__device__ __forceinline__ const float* mod_ptr(const Params& P, int l, int r, int j) { return (const float*)(P.ws + OFF_MOD) + ((size_t)(l * 17 + r) * 6 + j) * D; }
__device__ __forceinline__ int kv_row(int row) { return row < NL ? (row >> 11) * KV + (row & 2047) : ((row - NL) >> 8) * KV + SEQ + ((row - NL) & 255); }

__device__ __forceinline__ void ph_tables(const Params& P, int bid, int nblk) {
    const int TID = tidx();
    float* rc = (float*)(P.ws + OFF_ROPE); float* rs = rc + SEQ * 32;
    for (int i = bid * 512 + TID; i < SEQ * 32; i += nblk * 512) {
        const int t = i >> 5, f = i & 31; const float pos = (float)(f < 16 ? (t >> 6) : (t & 63));
        const float inv = powf(10000.0f, -(float)(f & 15) / 16.0f); const float ang = pos * inv;
        float s, c; sincosf(ang, &s, &c); rc[i] = c; rs[i] = s;
    }
    bf16_t* A = (bf16_t*)(P.ws + OFF_ADFT);
    for (size_t i = (size_t)bid * 512 + TID; i < (size_t)2048 * 2048; i += (size_t)nblk * 512) {
        const int kp = (int)(i >> 11), t = (int)(i & 2047); const int m = (kp * t) & 2047;
        float s, c; sincospif((float)m * (1.0f / 1024.0f), &s, &c);
        A[(size_t)kp * 4096 + t] = (bf16_t)(pk_bf16(c, 0.f) & 0xffff); A[(size_t)kp * 4096 + 2048 + t] = (bf16_t)(pk_bf16(-s, 0.f) & 0xffff);
    }
    bf16_t* Ac = (bf16_t*)(P.ws + OFF_ADFTC);
    for (int i = bid * 512 + TID; i < 256 * 256; i += nblk * 512) {
        const int kp = i >> 8, t = i & 255; const int m = (kp * t) & 255;
        float s, c; sincospif((float)m * (1.0f / 128.0f), &s, &c);
        Ac[kp * 512 + t] = (bf16_t)(pk_bf16(c, 0.f) & 0xffff); Ac[kp * 512 + 256 + t] = (bf16_t)(pk_bf16(-s, 0.f) & 0xffff);
    }
}
__device__ __forceinline__ void ph_mod(const Params& P, int bid, int nblk, float* lds) {
    const int TID = tidx();
    const int tid = TID, c4 = tid & 7, ks = tid >> 3, lane = tid & 63, wid = tid >> 6;
    float* mod = (float*)(P.ws + OFF_MOD);
    float* lsc = lds;
    float* red = lds + 17 * D;
    __syncthreads();
    for (int i = tid; i < 17 * D; i += 512) { const float v = i < 16 * D ? P.c[i] : P.c_ctx[i - 16 * D]; lsc[i] = v * sigmoidf_(v); }
    __syncthreads();
    for (int u = bid; u < DEPTH * 192; u += nblk) {
        const int l = u / 192;
        f32x4 acc[17];
#pragma unroll
        for (int r = 0; r < 17; ++r) acc[r] = (f32x4){0.f, 0.f, 0.f, 0.f};
        const float* w = P.ada_w + ((size_t)l * D + ks * 16) * 6144 + (u % 192) * 32 + c4 * 4;
        f32x4 wv[16];
#pragma unroll
        for (int q = 0; q < 16; ++q) wv[q] = *(const f32x4*)(w + (size_t)q * 6144);
#pragma unroll
        for (int q4 = 0; q4 < 4; ++q4)
#pragma unroll
            for (int r = 0; r < 17; ++r) { const f32x4 cc = *(const f32x4*)(lsc + r * D + ks * 16 + 4 * q4);
                acc[r] += cc.x * wv[4 * q4] + cc.y * wv[4 * q4 + 1] + cc.z * wv[4 * q4 + 2] + cc.w * wv[4 * q4 + 3]; }
#pragma unroll
        for (int r = 0; r < 17; ++r)
#pragma unroll
            for (int e = 0; e < 4; ++e) { float v = acc[r][e]; v += dpp_f<0x128>(v);
                auto sw = __builtin_amdgcn_permlane16_swap(__builtin_bit_cast(unsigned, v), __builtin_bit_cast(unsigned, v), false, false);
                acc[r][e] = __builtin_bit_cast(float, (unsigned)sw[0]) + __builtin_bit_cast(float, (unsigned)sw[1]); }
        __syncthreads();
        if ((lane & 24) == 0) { const int g = wid * 2 + (lane >> 5);
#pragma unroll
            for (int r = 0; r < 17; ++r) *(f32x4*)(red + (g * 17 + r) * 32 + c4 * 4) = acc[r]; }
        __syncthreads();
        for (int i = tid; i < 17 * 32; i += 512) { const int r = i >> 5, c = i & 31; float sum = 0.f;
#pragma unroll
            for (int q = 0; q < 16; ++q) sum += red[(q * 17 + r) * 32 + c];
            const int jj = (u % 192) * 32 + c; mod[(size_t)(l * 17 + r) * 6144 + jj] = sum + P.ada_b[l * 6144 + jj]; }
    }
}
__device__ __forceinline__ void tr_cvt_tile_w(const float* src, int ldn, bf16_t* dst, int ldk, int N, int tile, float* lw, int lane) {
    const int tn = N / 64; const int k0 = (tile / tn) * 32, n0 = (tile % tn) * 64;
    float v[32];
#pragma unroll
    for (int kk = 0; kk < 32; ++kk) v[kk] = src[(size_t)(k0 + kk) * ldn + n0 + lane];
#pragma unroll
    for (int kk = 0; kk < 32; ++kk) lw[kk * 65 + lane] = v[kk];
    asm volatile("s_waitcnt lgkmcnt(0)" ::: "memory");
#pragma unroll
    for (int it = 0; it < 4; ++it) { const int row = it * 16 + (lane >> 2), ch = (lane & 3) * 8; u32x4 o;
        o.x = pk_bf16(lw[(ch + 0) * 65 + row], lw[(ch + 1) * 65 + row]); o.y = pk_bf16(lw[(ch + 2) * 65 + row], lw[(ch + 3) * 65 + row]);
        o.z = pk_bf16(lw[(ch + 4) * 65 + row], lw[(ch + 5) * 65 + row]); o.w = pk_bf16(lw[(ch + 6) * 65 + row], lw[(ch + 7) * 65 + row]);
        *(u32x4*)(dst + (size_t)(n0 + row) * ldk + k0 + ch) = o; }
    asm volatile("s_waitcnt lgkmcnt(0)" ::: "memory");
}
__device__ __forceinline__ void ph_wtrans(const Params& P, int bid, int nblk, float* lds) {
    const int TID = tidx(); const int wid = __builtin_amdgcn_readfirstlane(TID >> 6), lane = TID & 63;
    float* lw = lds + wid * (32 * 65);
    __syncthreads();
    for (int u = bid * 8 + wid; u < DEPTH * 2944; u += nblk * 8) {
        const int l = u / 2944; int t = u % 2944;
        if (t < 2048) tr_cvt_tile_w(P.w_in + (size_t)l * D * INC + 256, INC, (bf16_t*)(P.ws + OFF_W1T) + (size_t)l * 4096 * D, D, 4096, t, lw, lane);
        else if (t < 2560) tr_cvt_tile_w(P.w_out + (size_t)l * D * D, D, (bf16_t*)(P.ws + OFF_WOT) + (size_t)l * D * D, D, D, t - 2048, lw, lane);
        else if (t < 2688) tr_cvt_tile_w(P.fourier_w + (size_t)l * 256 * D, D, (bf16_t*)(P.ws + OFF_WMT) + (size_t)l * D * D, D, D, t - 2560, lw, lane);
        else tr_cvt_tile_w(P.attn_proj + (size_t)l * 512 * D, D, (bf16_t*)(P.ws + OFF_WMT) + (size_t)l * D * D + 512, D, D, t - 2688, lw, lane);
    }
    __syncthreads();
}
__device__ __forceinline__ void ph_wft(const Params& P, int bid, int nblk, float* lds) {
    const int TID = tidx();
    const int tid = TID, lane = TID & 63, r = lane & 31, hi = lane >> 5; const int wid = __builtin_amdgcn_readfirstlane(TID >> 6);
    __syncthreads();
    if (tid < 64) { float s, c; sincospif((float)tid * (1.0f / 32.0f), &s, &c); lds[tid] = c; lds[64 + tid] = s; }
    __syncthreads();
    bf16_t* W = (bf16_t*)(P.ws + OFF_WFT);
    for (int u = bid * 8 + wid; u < DEPTH * 512; u += nblk * 8) {
        const int kt = u & 31, jt = (u >> 5) & 1, part = (u >> 6) & 1, g = (u >> 7) & 3, l = u >> 9;
        const float* tab = lds + part * 64; const int j = jt * 32 + r;
        const float* bp = P.w_in + ((size_t)l * D + kt * 32 + r) * INC + g * 64;
        f32x4 bv[16];
#pragma unroll
        for (int q = 0; q < 16; ++q) bv[q] = *(const f32x4*)(bp + 4 * q);
        f32x16 acc;
#pragma unroll
        for (int q = 0; q < 16; ++q) acc[q] = 0.f;
#pragma unroll
        for (int s2 = 0; s2 < 32; ++s2) { const float a = tab[((2 * s2 + hi) * j) & 63]; const f32x4 b4 = bv[s2 >> 1];
            const float bb = (s2 & 1) ? (hi ? b4.w : b4.z) : (hi ? b4.y : b4.x);
            acc = __builtin_amdgcn_mfma_f32_32x32x2f32(a, bb, acc, 0, 0, 0); }
#pragma unroll
        for (int q = 0; q < 16; ++q) { const int jj = jt * 32 + 8 * (q >> 2) + 4 * hi + (q & 3);
            W[((size_t)l * 512 + part * 256 + g * 64 + jj) * D + kt * 32 + r] = (bf16_t)(pk_bf16(acc[q], 0.f) & 0xffff); }
    }
    __syncthreads();
}
__device__ __forceinline__ unsigned pk_fp8x4(float a, float b, float c, float d) { int w = __builtin_amdgcn_cvt_pk_fp8_f32(a, b, 0, false); w = __builtin_amdgcn_cvt_pk_fp8_f32(c, d, w, true); return (unsigned)w; }
__device__ __forceinline__ void ph_wg8(const Params& P, int bid, int nblk, float* lds) {
    const int TID = tidx(); const int wid = __builtin_amdgcn_readfirstlane(TID >> 6), lane = TID & 63;
    float* lw = lds + wid * (32 * 65);
    __syncthreads();
    for (int u = bid * 8 + wid; u < DEPTH * 1536; u += nblk * 8) {
        const int l = u / 1536, t = u % 1536; const int k0 = (t / 48) * 32, n0 = (t % 48) * 64;
        const float* src = P.w_in + (size_t)l * D * INC + 1280; unsigned char* dst = P.ws + OFF_WG8 + (size_t)l * 3072 * D;
        float v[32];
#pragma unroll
        for (int kk = 0; kk < 32; ++kk) v[kk] = src[(size_t)(k0 + kk) * INC + n0 + lane];
#pragma unroll
        for (int kk = 0; kk < 32; ++kk) lw[kk * 65 + lane] = v[kk] * G8_SCALE;
        asm volatile("s_waitcnt lgkmcnt(0)" ::: "memory");
#pragma unroll
        for (int it = 0; it < 2; ++it) { const int row = it * 32 + (lane >> 1), ch = (lane & 1) * 16; u32x4 o;
            o.x = pk_fp8x4(lw[(ch + 0) * 65 + row], lw[(ch + 1) * 65 + row], lw[(ch + 2) * 65 + row], lw[(ch + 3) * 65 + row]);
            o.y = pk_fp8x4(lw[(ch + 4) * 65 + row], lw[(ch + 5) * 65 + row], lw[(ch + 6) * 65 + row], lw[(ch + 7) * 65 + row]);
            o.z = pk_fp8x4(lw[(ch + 8) * 65 + row], lw[(ch + 9) * 65 + row], lw[(ch + 10) * 65 + row], lw[(ch + 11) * 65 + row]);
            o.w = pk_fp8x4(lw[(ch + 12) * 65 + row], lw[(ch + 13) * 65 + row], lw[(ch + 14) * 65 + row], lw[(ch + 15) * 65 + row]);
            *(u32x4*)(dst + (size_t)(n0 + row) * D + k0 + ch) = o; }
        asm volatile("s_waitcnt lgkmcnt(0)" ::: "memory");
    }
    __syncthreads();
}
__device__ __forceinline__ void ph_wpool(const Params& P, int bid, int nblk, float* lds) {
    const int TID = tidx();
    bf16_t* W = (bf16_t*)(P.ws + OFF_WMT);
    for (int u = bid; u < DEPTH * 4 * 16; u += nblk) {
        const int nc = u & 15, g = (u >> 4) & 3, l = u >> 6; const int n = nc * 64 + (TID & 63), c0 = (TID >> 6) * 8;
        __syncthreads();
        for (int i = TID; i < 64 * 64; i += 512) lds[i] = P.pool_w[(size_t)(l * 4 + g) * 4096 + i];
        __syncthreads();
        float pr[64];
#pragma unroll
        for (int e = 0; e < 64; ++e) pr[e] = P.pool_proj[((size_t)l * 256 + g * 64 + e) * D + n] * P.pool_scale[l * 256 + g * 64 + e];
        float a[8];
#pragma unroll
        for (int c = 0; c < 8; ++c) { a[c] = 0.f;
#pragma unroll
            for (int e = 0; e < 64; ++e) a[c] += lds[(c0 + c) * 64 + e] * pr[e]; }
        u32x4 o; o.x = pk_bf16(a[0], a[1]); o.y = pk_bf16(a[2], a[3]); o.z = pk_bf16(a[4], a[5]); o.w = pk_bf16(a[6], a[7]);
        *(u32x4*)(W + ((size_t)l * D + n) * D + 256 + g * 64 + c0) = o;
    }
}
__device__ __forceinline__ void ph_wst(const Params& P, int bid, int nblk, int l0, int l1) {
    const int TID = tidx();
    bf16_t* W = (bf16_t*)(P.ws + OFF_WST);
    const int wid = __builtin_amdgcn_readfirstlane(TID >> 6), lane = TID & 63, r = lane & 31, hi = lane >> 5;
    for (int u = l0 * 2048 + bid * 8 + wid; u < l1 * 2048; u += nblk * 8) {
        const int kt = u & 31, jt = (u >> 5) & 3, hp = (u >> 7) & 15, l = u >> 11;
        const float* ap = P.peer_keys + ((size_t)(l * 16 + hp) * 128 + jt * 32 + r) * 128;
        const float* bp = P.peer_wq + ((size_t)l * D + kt * 32 + r) * 2048 + hp * 128;
        f32x16 acc;
#pragma unroll
        for (int q = 0; q < 16; ++q) acc[q] = 0.f;
#pragma unroll 1
        for (int q0 = 0; q0 < 32; q0 += 8) { f32x4 av[8], bv[8];
#pragma unroll
            for (int q = 0; q < 8; ++q) { av[q] = *(const f32x4*)(ap + 4 * (q0 + q)); bv[q] = *(const f32x4*)(bp + 4 * (q0 + q)); }
#pragma unroll
            for (int q = 0; q < 8; ++q) {
                acc = __builtin_amdgcn_mfma_f32_32x32x2f32(hi ? av[q].y : av[q].x, hi ? bv[q].y : bv[q].x, acc, 0, 0, 0);
                acc = __builtin_amdgcn_mfma_f32_32x32x2f32(hi ? av[q].w : av[q].z, hi ? bv[q].w : bv[q].z, acc, 0, 0, 0); } }
#pragma unroll
        for (int q = 0; q < 16; ++q) { const int j = jt * 32 + 8 * (q >> 2) + 4 * hi + (q & 3);
            W[((size_t)l * 2048 + hp * 128 + j) * D + kt * 32 + r] = (bf16_t)(pk_bf16(acc[q], 0.f) & 0xffff); }
    }
}
constexpr float U_SCALE = 64.0f, V_SCALE = 8.0f;
__device__ __forceinline__ void ph_peer_cvt(const Params& P, int bid, int nblk, int l0, int l1, int w0 = 0, int w1 = 2) {
    const int TID = tidx();
    const size_t per = (size_t)NEXP * D / 16, nbeg = (size_t)l0 * per, n16 = (size_t)l1 * per;
    for (int w = w0; w < w1; ++w) {
        const f32x4* s = (const f32x4*)(w ? P.peer_v : P.peer_u); unsigned char* d = P.ws + (w ? OFF_PV : OFF_PU); const float sc = w ? V_SCALE : U_SCALE;
        for (size_t i = nbeg + (size_t)bid * 512 + TID; i < n16; i += (size_t)nblk * 512) {
            const f32x4 a = __builtin_nontemporal_load(s + 4 * i), b = __builtin_nontemporal_load(s + 4 * i + 1), c = __builtin_nontemporal_load(s + 4 * i + 2), e4 = __builtin_nontemporal_load(s + 4 * i + 3);
            u32x4 o; o.x = pk_fp8x4(a.x * sc, a.y * sc, a.z * sc, a.w * sc); o.y = pk_fp8x4(b.x * sc, b.y * sc, b.z * sc, b.w * sc); o.z = pk_fp8x4(c.x * sc, c.y * sc, c.z * sc, c.w * sc); o.w = pk_fp8x4(e4.x * sc, e4.y * sc, e4.z * sc, e4.w * sc);
            const size_t row = i >> 6; const int c16 = (int)(i & 63);
            const size_t l = row >> 14, e = row & (NEXP - 1);
            *(u32x4*)(d + (((l * 8 + (c16 >> 3)) * NEXP + e) * 128 + (c16 & 7) * 16)) = o; }
    }
}

__device__ __forceinline__ void ph_norm(const Params& P, int l, int which, int nrows, int bid, int nblk, const bool from_input = false) {
    const int TID = tidx();
    const int wid = __builtin_amdgcn_readfirstlane(TID >> 6), lane = TID & 63;
    const float* gain = (which ? P.norm_ffn : P.norm_mix) + l * D;
    bf16_t* HB = (bf16_t*)(P.ws + OFF_HB);
    f32x4 gg[4];
#pragma unroll
    for (int i = 0; i < 4; ++i) gg[i] = *(const f32x4*)(gain + i * 256 + lane * 4);
    const int stride = nblk * 8;
    for (int row0 = bid * 8 + wid; row0 < nrows; row0 += 2 * stride) {
        f32x4 v[2][4], sa[2][4], sb[2][4];
#pragma unroll
        for (int h = 0; h < 2; ++h) { const int row = min(row0 + h * stride, nrows - 1);
            const float* xr = from_input ? (row < NL ? P.x + (size_t)row * D : P.ctx + (size_t)(row - NL) * D) : xrow_ptr(P, row); const int r = mod_r(row);
            const float* sh = mod_ptr(P, l, r, which ? 3 : 0); const float* sc = mod_ptr(P, l, r, which ? 4 : 1);
#pragma unroll
            for (int i = 0; i < 4; ++i) { v[h][i] = *(const f32x4*)(xr + i * 256 + lane * 4); sa[h][i] = *(const f32x4*)(sc + i * 256 + lane * 4); sb[h][i] = *(const f32x4*)(sh + i * 256 + lane * 4); } }
        asm volatile("" : "+v"(v[0][0]), "+v"(v[0][1]), "+v"(v[0][2]), "+v"(v[0][3]), "+v"(v[1][0]), "+v"(v[1][1]), "+v"(v[1][2]), "+v"(v[1][3]));
#pragma unroll
        for (int h = 0; h < 2; ++h) { const int row = row0 + h * stride;
            float ss = 0.f;
#pragma unroll
            for (int i = 0; i < 4; ++i) ss += v[h][i].x * v[h][i].x + v[h][i].y * v[h][i].y + v[h][i].z * v[h][i].z + v[h][i].w * v[h][i].w;
            ss = wave_sum(ss); const float rstd = rsqrtf(ss * (1.0f / D) + EPS);
            if (row < nrows) {
#pragma unroll
                for (int i = 0; i < 4; ++i) { const int c = i * 256 + lane * 4; const f32x4 g = gg[i], a = sa[h][i], b = sb[h][i];
                    const float o0 = v[h][i].x * rstd * g.x * (1.f + a.x) + b.x, o1 = v[h][i].y * rstd * g.y * (1.f + a.y) + b.y, o2 = v[h][i].z * rstd * g.z * (1.f + a.z) + b.z, o3 = v[h][i].w * rstd * g.w * (1.f + a.w) + b.w;
                    u32x2 o; o.x = pk_bf16(o0, o1); o.y = pk_bf16(o2, o3); *(u32x2*)(HB + (size_t)row * D + c) = o;
                    if (!which) *(unsigned*)(P.ws + OFF_HB8 + (size_t)row * D + c) = pk_fp8x4(o0, o1, o2, o3); }
            }
        }
    }
}

__device__ __forceinline__ void ph_l3(const Params& P, int l, int bid, int nblk) {
    const int TID = tidx();
    const float* rc = (const float*)(P.ws + OFF_ROPE); const float* rs = rc + SEQ * 32;
    {
        const int sub = TID & 7; const bool hi_half = (sub & 2) != 0;
        const f32x4 gq0 = *(const f32x4*)(P.q_norm + l * 64 + sub * 8), gq1 = *(const f32x4*)(P.q_norm + l * 64 + sub * 8 + 4), gk0 = *(const f32x4*)(P.k_norm + l * 64 + sub * 8), gk1 = *(const f32x4*)(P.k_norm + l * 64 + sub * 8 + 4);
        const int stride = nblk * 64, NI = NT * 10;
        for (int i0 = (bid * 512 + TID) >> 3; i0 < NI; i0 += 4 * stride) {
            u32x4 vv[4]; f32x4 rc0[4], rc1[4], rs0[4], rs1[4]; bf16_t* pp[4];
#pragma unroll
            for (int b4 = 0; b4 < 4; ++b4) { const int i = min(i0 + b4 * stride, NI - 1); const int row = i / 10, slot = i - row * 10; const bool isq = slot < 8;
                pp[b4] = (isq ? (bf16_t*)(P.ws + OFF_QR) + (size_t)row * 512 + slot * 64 : (bf16_t*)(P.ws + OFF_KALL) + (size_t)kv_row(row) * 128 + (slot - 8) * 64) + sub * 8;
                vv[b4] = *(const u32x4*)pp[b4];
                const int tix = (row & 2047) * 32 + (sub >> 2) * 16 + (sub & 1) * 8;
                rc0[b4] = *(const f32x4*)(rc + tix); rc1[b4] = *(const f32x4*)(rc + tix + 4); rs0[b4] = *(const f32x4*)(rs + tix); rs1[b4] = *(const f32x4*)(rs + tix + 4); }
            asm volatile("" : "+v"(vv[0]), "+v"(vv[1]), "+v"(vv[2]), "+v"(vv[3]));
#pragma unroll
            for (int b4 = 0; b4 < 4; ++b4) { const int i = i0 + b4 * stride; const int ic = min(i, NI - 1); const int row = ic / 10, slot = ic - row * 10; const bool isq = slot < 8;
                const unsigned v0 = vv[b4].x, v1 = vv[b4].y, v2 = vv[b4].z, v3 = vv[b4].w;
                float x[8] = {bf_lo(v0), bf_hi(v0), bf_lo(v1), bf_hi(v1), bf_lo(v2), bf_hi(v2), bf_lo(v3), bf_hi(v3)};
                float ss = 0.f;
#pragma unroll
                for (int d = 0; d < 8; ++d) ss += x[d] * x[d];
                ss = sum8(ss);
                const float rstd = rsqrtf(ss * (1.0f / 64.0f) + EPS) * (isq ? C2 : 1.0f);
                const f32x4 g0 = isq ? gq0 : gk0, g1 = isq ? gq1 : gk1;
                x[0] *= rstd * g0.x; x[1] *= rstd * g0.y; x[2] *= rstd * g0.z; x[3] *= rstd * g0.w; x[4] *= rstd * g1.x; x[5] *= rstd * g1.y; x[6] *= rstd * g1.z; x[7] *= rstd * g1.w;
                {
                    const f32x4 c0 = rc0[b4], c1 = rc1[b4], s0 = rs0[b4], s1 = rs1[b4]; const bool lat = row < NL;
                    const float cc[8] = {c0.x, c0.y, c0.z, c0.w, c1.x, c1.y, c1.z, c1.w}, sn[8] = {s0.x, s0.y, s0.z, s0.w, s1.x, s1.y, s1.z, s1.w};
#pragma unroll
                    for (int d = 0; d < 8; ++d) { const float other = DPP_F(x[d], 0x4E);
                        const float r = hi_half ? (x[d] * cc[d] + other * sn[d]) : (x[d] * cc[d] - other * sn[d]); x[d] = lat ? r : x[d]; }
                }
                u32x4 o; o.x = pk_bf16(x[0], x[1]); o.y = pk_bf16(x[2], x[3]); o.z = pk_bf16(x[4], x[5]); o.w = pk_bf16(x[6], x[7]);
                if (i < NI) *(u32x4*)pp[b4] = o;
            }
        }
    }
    const bf16_t* PP = (const bf16_t*)(P.ws + OFF_PP); bf16_t* MIX = (bf16_t*)(P.ws + OFF_MIX);
    for (int i = bid * 512 + TID; i < NT * 32; i += nblk * 512) {
        const int row = i >> 5, ch = (i & 31) * 8, g = ch >> 6, win = 2 << g;
        int base, t, L; if (row < NL) { base = row & ~2047; t = row & 2047; L = SEQ; } else { base = NL + ((row - NL) & ~255); t = (row - NL) & 255; L = CTX; }
        const int lo = max(t - win / 2, 0), hi = min(t + win - win / 2, L);
        float s[8];
#pragma unroll
        for (int q = 0; q < 8; ++q) s[q] = 0.f;
        u32x4 wv[16];
#pragma unroll
        for (int k = 0; k < 16; ++k) wv[k] = *(const u32x4*)(PP + (size_t)(base + min(lo + k, hi - 1)) * 256 + ch);
#pragma unroll
        for (int k = 0; k < 16; ++k) { const float w = lo + k < hi ? 1.0f : 0.0f; const unsigned a0 = wv[k].x, a1 = wv[k].y, a2 = wv[k].z, a3 = wv[k].w;
            s[0] += w * bf_lo(a0); s[1] += w * bf_hi(a0); s[2] += w * bf_lo(a1); s[3] += w * bf_hi(a1); s[4] += w * bf_lo(a2); s[5] += w * bf_hi(a2); s[6] += w * bf_lo(a3); s[7] += w * bf_hi(a3); }
        const float inv = 1.0f / (float)(hi - lo); const u32x4 me = *(const u32x4*)(PP + (size_t)row * 256 + ch);
        u32x4 o; o.x = pk_bf16(s[0] * inv - bf_lo(me.x), s[1] * inv - bf_hi(me.x)); o.y = pk_bf16(s[2] * inv - bf_lo(me.y), s[3] * inv - bf_hi(me.y));
        o.z = pk_bf16(s[4] * inv - bf_lo(me.z), s[5] * inv - bf_hi(me.z)); o.w = pk_bf16(s[6] * inv - bf_lo(me.w), s[7] * inv - bf_hi(me.w));
        *(u32x4*)(MIX + (size_t)row * D + 256 + ch) = o;
    }
}

__device__ __forceinline__ int fkey(float v) { const int b = __float_as_int(v); return b ^ ((b >> 31) & 0x7fffffff); }
__device__ __forceinline__ float kval(int k) { return __int_as_float(k ^ ((k >> 31) & 0x7fffffff)); }
__device__ __forceinline__ float kval16(int k) { const int s = k >> 16; return __int_as_float((s ^ ((s >> 31) & 0x7fff)) << 16); }
#define CE_DESC(a, b) do { const int hi_ = max(a, b), lo_ = min(a, b); a = hi_; b = lo_; } while (0)
__device__ __forceinline__ void bitonic_merge16(int (&a)[16]) {
#pragma unroll
    for (int j = 8; j > 0; j >>= 1)
#pragma unroll
        for (int i = 0; i < 16; ++i) { const int l = i ^ j; if (l > i) CE_DESC(a[i], a[l]); }
}
__device__ __forceinline__ void bitonic_sort16(int (&a)[16]) {
#pragma unroll
    for (int k = 2; k <= 16; k <<= 1)
#pragma unroll
        for (int j = k >> 1; j > 0; j >>= 1)
#pragma unroll
            for (int i = 0; i < 16; ++i) { const int l = i ^ j; if (l > i) { if ((i & k) == 0 || k == 16) CE_DESC(a[i], a[l]); else CE_DESC(a[l], a[i]); } }
}
__device__ __forceinline__ void top16_merge(int (&run)[16], int (&c)[16]) {
    bitonic_sort16(c);
#pragma unroll
    for (int i = 0; i < 16; ++i) run[i] = max(run[i], c[15 - i]);
    bitonic_merge16(run);
}
__device__ __forceinline__ void ph_topk(const Params& P, int ntok, int bid, int nblk, unsigned char* lds) {
    const int TID = tidx();
    const int wid = __builtin_amdgcn_readfirstlane(TID >> 6), lane = TID & 63;
    const bf16_t* ST = (const bf16_t*)(P.ws + OFF_ST); unsigned* EID = (unsigned*)(P.ws + OFF_EID); float* GW = (float*)(P.ws + OFF_GW);
    unsigned char* myl = lds + TID * 36;
    for (int u = bid * 8 + wid; u < (ntok / 64) * 8; u += nblk * 8) {
        const int h = u & 7, tok = (u >> 3) * 64 + lane;
        int l1[16], l2[16];
        const bf16_t* s1 = ST + (size_t)(h * 256) * NT + tok; const bf16_t* s2 = s1 + (size_t)128 * NT;
        unsigned fa[16], fb[16];
#pragma unroll
        for (int q = 0; q < 16; ++q) { fa[q] = s1[(size_t)q * NT]; fb[q] = s2[(size_t)q * NT]; }
#pragma unroll 1
        for (int j0 = 0; j0 < 128; j0 += 16) {
            int a[16], b[16];
#pragma unroll
            for (int q = 0; q < 16; ++q) { a[q] = (int)((fa[q] << 16) | (unsigned)(127 - (j0 + q))); b[q] = (int)((fb[q] << 16) | (unsigned)(127 - (j0 + q))); }
            const int jn = j0 + 16 < 128 ? j0 + 16 : j0;
#pragma unroll
            for (int q = 0; q < 16; ++q) { fa[q] = s1[(size_t)(jn + q) * NT]; fb[q] = s2[(size_t)(jn + q) * NT]; }
            if (j0 == 0) { bitonic_sort16(a); bitonic_sort16(b);
#pragma unroll
                for (int i = 0; i < 16; ++i) { l1[i] = a[i]; l2[i] = b[i]; } }
            else { top16_merge(l1, a); top16_merge(l2, b); }
        }
        float v1[16], v2[16];
#pragma unroll
        for (int i = 0; i < 16; ++i) { v1[i] = kval16(l1[i]); v2[i] = kval16(l2[i]); myl[i] = (unsigned char)(127 - (l1[i] & 127)); myl[16 + i] = (unsigned char)(127 - (l2[i] & 127)); }
        int cd[64];
        { int n = 0;
#pragma unroll
          for (int i = 0; i < 16; ++i)
#pragma unroll
              for (int j = 0; j < 16; ++j) if ((i + 1) * (j + 1) <= 16) { cd[n] = (fkey(v1[i] + v2[j]) & ~255) | (255 - (i * 16 + j)); ++n; }
#pragma unroll
          for (int q = 50; q < 64; ++q) cd[q] = INT_MIN; }
        int l3[16], c[16];
#pragma unroll
        for (int q = 0; q < 16; ++q) l3[q] = cd[q];
#pragma unroll
        for (int q = 0; q < 8; ++q) c[q] = cd[16 + q];
        c[8] = INT_MIN; c[9] = INT_MIN; c[10] = INT_MIN; c[11] = cd[28]; c[12] = cd[27]; c[13] = cd[26]; c[14] = cd[25]; c[15] = cd[24];
        bitonic_merge16(c);
#pragma unroll
        for (int i = 0; i < 16; ++i) l3[i] = max(l3[i], c[15 - i]);
        bitonic_merge16(l3);
#pragma unroll
        for (int q = 0; q < 13; ++q) c[q] = cd[29 + q];
        c[13] = INT_MIN; c[14] = INT_MIN; c[15] = INT_MIN;
        top16_merge(l3, c);
#pragma unroll
        for (int i = 0; i < 8; ++i) l3[8 + i] = max(l3[8 + i], cd[49 - i]);
        bitonic_merge16(l3);
        float t[16]; float sum = 0.f; const float t0 = kval((l3[0] & ~255) | 128);
#pragma unroll
        for (int k = 0; k < 16; ++k) { t[k] = __expf(kval((l3[k] & ~255) | 128) - t0); sum += t[k]; }
        const float inv = 1.0f / sum;
        int e[16];
#pragma unroll
        for (int k = 0; k < 16; ++k) { const int pos = 255 - (l3[k] & 255); e[k] = (int)myl[pos >> 4] * 128 + (int)myl[16 + (pos & 15)]; t[k] *= inv; }
#pragma unroll
        for (int k = 0; k < 16; k += 4) *(f32x4*)(GW + (size_t)tok * 128 + h * 16 + k) = (f32x4){t[k], t[k + 1], t[k + 2], t[k + 3]};
#pragma unroll
        for (int k = 0; k < 16; k += 4) *(u32x4*)(EID + (size_t)tok * 128 + h * 16 + k) = (u32x4){(unsigned)e[k] * 128u, (unsigned)e[k + 1] * 128u, (unsigned)e[k + 2] * 128u, (unsigned)e[k + 3] * 128u};
    }
}

constexpr size_t OFF_PB = OFF_ST;
constexpr size_t OFF_CV = OFF_ST + 144 * MiB;
__device__ __forceinline__ int id16(const u32x4& a, const u32x4& b, int it) {
    const unsigned w = it < 8 ? (it < 4 ? (it < 2 ? a.x : a.y) : (it < 6 ? a.z : a.w)) : (it < 12 ? (it < 10 ? b.x : b.y) : (it < 14 ? b.z : b.w));
    return (it & 1) ? (int)(w >> 16) : (int)(w & 0xffffu);
}
__device__ __forceinline__ void unpk_fp8x16p(const u32x4& w, f32x2_t (&f)[8]) {
    const unsigned d0 = w.x, d1 = w.y, d2 = w.z, d3 = w.w;
    f[0] = __builtin_amdgcn_cvt_pk_f32_fp8((int)d0, false); f[1] = __builtin_amdgcn_cvt_pk_f32_fp8((int)d0, true); f[2] = __builtin_amdgcn_cvt_pk_f32_fp8((int)d1, false); f[3] = __builtin_amdgcn_cvt_pk_f32_fp8((int)d1, true);
    f[4] = __builtin_amdgcn_cvt_pk_f32_fp8((int)d2, false); f[5] = __builtin_amdgcn_cvt_pk_f32_fp8((int)d2, true); f[6] = __builtin_amdgcn_cvt_pk_f32_fp8((int)d3, false); f[7] = __builtin_amdgcn_cvt_pk_f32_fp8((int)d3, true);
}
__device__ __forceinline__ void unpk_fp8x16(const u32x4& w, float (&f)[16]) {
    const unsigned d0 = w.x, d1 = w.y, d2 = w.z, d3 = w.w;
    f32x2_t t;
    t = __builtin_amdgcn_cvt_pk_f32_fp8((int)d0, false); f[0] = t.x; f[1] = t.y; t = __builtin_amdgcn_cvt_pk_f32_fp8((int)d0, true); f[2] = t.x; f[3] = t.y;
    t = __builtin_amdgcn_cvt_pk_f32_fp8((int)d1, false); f[4] = t.x; f[5] = t.y; t = __builtin_amdgcn_cvt_pk_f32_fp8((int)d1, true); f[6] = t.x; f[7] = t.y;
    t = __builtin_amdgcn_cvt_pk_f32_fp8((int)d2, false); f[8] = t.x; f[9] = t.y; t = __builtin_amdgcn_cvt_pk_f32_fp8((int)d2, true); f[10] = t.x; f[11] = t.y;
    t = __builtin_amdgcn_cvt_pk_f32_fp8((int)d3, false); f[12] = t.x; f[13] = t.y; t = __builtin_amdgcn_cvt_pk_f32_fp8((int)d3, true); f[14] = t.x; f[15] = t.y;
}
__device__ __forceinline__ void ph_peer_u(const Params& P, int l, int ntok, int bid, int nblk) {
    const int TID = tidx(); const int wid = __builtin_amdgcn_readfirstlane(TID >> 6), lane = TID & 63, c8 = lane & 7, q = lane >> 3;
    const int grp = bid & 7, nw = (nblk >> 3) * 8, w0 = (bid >> 3) * 8 + wid;
    if (w0 >= ntok) return;
    const int tl = w0 + ((ntok - 1 - w0) / nw) * nw;
    const bf16_t* HB = (const bf16_t*)(P.ws + OFF_HB) + grp * 128 + c8 * 16; const unsigned* EID = (const unsigned*)(P.ws + OFF_EID) + q * 16;
    float* PB = (float*)(P.ws + OFF_PB) + (size_t)grp * NT * 128 + lane;
    const unsigned char* Tu = P.ws + OFF_PU + ((size_t)(l * 8 + grp) * NEXP) * 128;
    const unsigned lo16 = (unsigned)c8 * 16u;
    u32x4 buf[16], idN[4], idNN[4], xaC, xbC, xaN, xbN, xaNN, xbNN;
#define PU_LOADI(T, ID, XA, XB) do { const int T_ = min((T), tl); _Pragma("unroll") for (int i_ = 0; i_ < 4; ++i_) ID[i_] = *(const u32x4*)(EID + (size_t)T_ * 128 + i_ * 4); XA = *(const u32x4*)(HB + (size_t)T_ * D); XB = *(const u32x4*)(HB + (size_t)T_ * D + 8); } while (0)
    { u32x4 id0[4]; PU_LOADI(w0, id0, xaC, xbC);
#pragma unroll
      for (int it = 0; it < 16; ++it) buf[it] = *(const u32x4*)(Tu + (id0[it >> 2][it & 3] + lo16)); }
    PU_LOADI(w0 + nw, idN, xaN, xbN);
    for (int t0 = w0; t0 < ntok; t0 += nw) {
        PU_LOADI(t0 + 2 * nw, idNN, xaNN, xbNN);
        const unsigned x0 = xaC.x, x1 = xaC.y, x2 = xaC.z, x3 = xaC.w, x4 = xbC.x, x5 = xbC.y, x6 = xbC.z, x7 = xbC.w;
        const f32x2_t xv[8] = {{bf_lo(x0), bf_hi(x0)}, {bf_lo(x1), bf_hi(x1)}, {bf_lo(x2), bf_hi(x2)}, {bf_lo(x3), bf_hi(x3)}, {bf_lo(x4), bf_hi(x4)}, {bf_lo(x5), bf_hi(x5)}, {bf_lo(x6), bf_hi(x6)}, {bf_lo(x7), bf_hi(x7)}};
        float r0 = 0.f, r1 = 0.f;
#pragma unroll
        for (int it = 0; it < 16; ++it) { f32x2_t uf[8]; unpk_fp8x16p(buf[it], uf);
            buf[it] = *(const u32x4*)(Tu + (idN[it >> 2][it & 3] + lo16));
            f32x2_t d = uf[0] * xv[0];
#pragma unroll
            for (int i = 1; i < 8; ++i) d = __builtin_elementwise_fma(uf[i], xv[i], d);
            const float p = sum8(d.x + d.y); if (c8 == (it & 7)) { if (it < 8) r0 = p; else r1 = p; } }
        float* pb = PB + (size_t)t0 * 128; pb[0] = r0; pb[64] = r1;
        xaC = xaN; xbC = xbN; xaN = xaNN; xbN = xbNN;
#pragma unroll
        for (int i = 0; i < 4; ++i) idN[i] = idNN[i];
    }
#undef PU_LOADI
}
__device__ __forceinline__ void ph_peer_a(const Params& P, int ntok, int bid, int nblk) {
    const int TID = tidx(); const int wid = __builtin_amdgcn_readfirstlane(TID >> 6), lane = TID & 63;
    const float* PB = (const float*)(P.ws + OFF_PB); const float* GW = (const float*)(P.ws + OFF_GW); float* CV = (float*)(P.ws + OFF_CV);
    constexpr int TB = 4;
    const int stride = nblk * 8;
    for (int t0 = bid * 8 + wid; t0 < ntok; t0 += TB * stride) {
        float pb[TB][2][8], gw[TB][2];
#pragma unroll
        for (int h = 0; h < TB; ++h) { const int t = min(t0 + h * stride, ntok - 1);
#pragma unroll
            for (int k = 0; k < 2; ++k) {
#pragma unroll
                for (int j = 0; j < 8; ++j) pb[h][k][j] = PB[((size_t)j * NT + t) * 128 + k * 64 + lane];
                gw[h][k] = GW[(size_t)t * 128 + (lane >> 3) * 16 + k * 8 + (lane & 7)]; } }
        asm volatile("" : "+v"(gw[0][0]), "+v"(gw[1][0]), "+v"(gw[2][0]), "+v"(gw[3][0]), "+v"(gw[0][1]), "+v"(gw[1][1]), "+v"(gw[2][1]), "+v"(gw[3][1]));
#pragma unroll
        for (int h = 0; h < TB; ++h) { const int t = t0 + h * stride;
            if (t < ntok) {
#pragma unroll
                for (int k = 0; k < 2; ++k) { float a = 0.f;
#pragma unroll
                    for (int j = 0; j < 8; ++j) a += pb[h][k][j];
                    const int p = (lane >> 3) * 16 + k * 8 + (lane & 7);
                    CV[(size_t)t * 128 + p] = gw[h][k] * gelu_tanh(a * (1.0f / U_SCALE)) * (1.0f / V_SCALE); } } }
    }
}
__device__ __forceinline__ float red16(float a, float b) { auto r = __builtin_amdgcn_permlane16_swap(__builtin_bit_cast(unsigned, a), __builtin_bit_cast(unsigned, b), false, false); return __builtin_bit_cast(float, (unsigned)r[0]) + __builtin_bit_cast(float, (unsigned)r[1]); }
__device__ __forceinline__ float red32(float a, float b) { auto r = __builtin_amdgcn_permlane32_swap(__builtin_bit_cast(unsigned, a), __builtin_bit_cast(unsigned, b), false, false); return __builtin_bit_cast(float, (unsigned)r[0]) + __builtin_bit_cast(float, (unsigned)r[1]); }
__device__ __forceinline__ void ph_peer_v(const Params& P, int l, int ntok, int bid, int nblk, const bool dry = false) {
    const int TID = tidx(); const int wid = __builtin_amdgcn_readfirstlane(TID >> 6), lane = TID & 63, c8 = lane & 7, q = lane >> 3;
    const int grp = bid & 7, nw = (nblk >> 3) * 8, w0 = (bid >> 3) * 8 + wid;
    if (w0 >= ntok) return;
    const int tl = w0 + ((ntok - 1 - w0) / nw) * nw;
    const unsigned* EID = (const unsigned*)(P.ws + OFF_EID) + q * 16; const float* CV = (const float*)(P.ws + OFF_CV) + q * 16;
    const unsigned char* Tv = P.ws + OFF_PV + ((size_t)(l * 8 + grp) * NEXP) * 128;
    const unsigned lo16 = (unsigned)c8 * 16u;
    const int xcol = grp * 128 + c8 * 16 + 4 * (lane >> 4);
    const bool writer = (lane & 8) == 0;
    u32x4 buf[16], idN[4], idNN[4]; f32x2_t cvC[8], cvN[8];
#define PV_LOADI(T, ID) do { const int T_ = min((T), tl); _Pragma("unroll") for (int i_ = 0; i_ < 4; ++i_) ID[i_] = *(const u32x4*)(EID + (size_t)T_ * 128 + i_ * 4); } while (0)
#define PV_LOADC(T, CVX) do { const int T_ = min((T), tl); _Pragma("unroll") for (int i_ = 0; i_ < 4; ++i_) { const f32x4 c4_ = *(const f32x4*)(CV + (size_t)T_ * 128 + i_ * 4); CVX[2 * i_] = (f32x2_t){c4_.x, c4_.y}; CVX[2 * i_ + 1] = (f32x2_t){c4_.z, c4_.w}; } } while (0)
    { u32x4 id0[4]; PV_LOADI(w0, id0); PV_LOADC(w0, cvC);
#pragma unroll
      for (int it = 0; it < 16; ++it) buf[it] = *(const u32x4*)(Tv + (id0[it >> 2][it & 3] + lo16)); }
    PV_LOADI(w0 + nw, idN);
    f32x4 gpre = {0.f, 0.f, 0.f, 0.f}; int rcur = -1;
    for (int t0 = w0; t0 < ntok; t0 += nw) {
        PV_LOADI(t0 + 2 * nw, idNN); PV_LOADC(t0 + nw, cvN);
        float* xp = xrow_ptr(P, t0) + xcol; const float* m5 = mod_ptr(P, l, mod_r(t0), 5) + xcol;
        f32x4 xpre;
        if (!dry && writer) { xpre = *(const f32x4*)xp; const int rr_ = mod_r(t0); if (rr_ != rcur) { gpre = *(const f32x4*)m5; rcur = rr_; } }
        f32x2_t o2[8];
#pragma unroll
        for (int i = 0; i < 8; ++i) o2[i] = (f32x2_t){0.f, 0.f};
#pragma unroll
        for (int it = 0; it < 16; ++it) { f32x2_t vf[8]; unpk_fp8x16p(buf[it], vf);
            buf[it] = *(const u32x4*)(Tv + (idN[it >> 2][it & 3] + lo16));
#pragma unroll
            for (int i = 0; i < 8; ++i) { if (it & 1) asm("v_pk_fma_f32 %0, %1, %2, %0 op_sel:[0,1,0] op_sel_hi:[1,1,1]" : "+v"(o2[i]) : "v"(vf[i]), "v"(cvC[it >> 1]));
                                          else        asm("v_pk_fma_f32 %0, %1, %2, %0 op_sel_hi:[1,0,1]" : "+v"(o2[i]) : "v"(vf[i]), "v"(cvC[it >> 1])); } }
        float w[16];
#pragma unroll
        for (int i = 0; i < 8; ++i) { const float ox = o2[i].x, oy = o2[i].y; w[2 * i] = ox + DPP_F(ox, 0x128); w[2 * i + 1] = oy + DPP_F(oy, 0x128); }
        float z[4];
#pragma unroll
        for (int j = 0; j < 4; ++j) z[j] = red32(red16(w[j], w[4 + j]), red16(w[8 + j], w[12 + j]));
        if (dry) {
#pragma unroll
            for (int j = 0; j < 4; ++j) asm volatile("" :: "v"(z[j]));
        } else if (writer) {
            f32x4 x = xpre; x.x += gpre.x * z[0]; x.y += gpre.y * z[1]; x.z += gpre.z * z[2]; x.w += gpre.w * z[3]; *(f32x4*)xp = x;
        }
#pragma unroll
        for (int i = 0; i < 8; ++i) cvC[i] = cvN[i];
#pragma unroll
        for (int i = 0; i < 4; ++i) idN[i] = idNN[i];
    }
#undef PV_LOADI
#undef PV_LOADC
}

namespace pg8 {
#define PG8_LAS __attribute__((address_space(3)))
constexpr int BM = 256, BK = 64, HALF = 128, HTB = HALF * BK * 2, STAGE_BYTES = 8 * HTB, NXCD = 8, WGM = 4;
__host__ __device__ __forceinline__ int lds_byte(int r, int c) { const int ch = (c >> 3) ^ ((r >> 1) & 7); return r * 128 + ch * 16 + (c & 7) * 2; }
__host__ __device__ __forceinline__ void stage_rc(int b, int& R, int& C) { R = b >> 7; C = ((((b >> 4) & 7) ^ ((R >> 1) & 7)) << 3) + ((b & 15) >> 1); }
__host__ __device__ __forceinline__ int perm32(int rho) { const int n = rho >> 4, i = rho & 15; return 8 * (i >> 2) + 4 * n + (i & 3); }
struct Unit { int pm, pn, nt, kofs, tag; };
struct Gemm { const bf16_t* A; const bf16_t* Bt; int lda, ldb; };
struct TileOrder {
    int nM, nN, nwg, G, c;
    __device__ __forceinline__ void init(int nM_, int nN_, int G_, int c_) { nM = nM_; nN = nN_; nwg = nM * nN; G = G_; c = c_; }
    __device__ __forceinline__ bool tile(int i, int& pm, int& pn) const {
        const long L = (long)i * G + c; if (L >= nwg) return false;
        int wgid = (int)L; { const int q = nwg / NXCD, r = nwg % NXCD, xcd = wgid % NXCD, off = wgid / NXCD; wgid = (xcd < r ? xcd * (q + 1) : r * (q + 1) + (xcd - r) * q) + off; }
        const int nig = WGM * nN, gid = wgid / nig, fm = gid * WGM, gsz = (nM - fm) < WGM ? (nM - fm) : WGM;
        pm = fm + ((wgid % nig) % gsz); pn = (wgid % nig) / gsz; return true;
    }
};
struct PlainSched { TileOrder T; int nt;
    __device__ __forceinline__ bool next(int i, Unit& u) const { if (!T.tile(i, u.pm, u.pn)) return false; u.nt = nt; u.kofs = 0; u.tag = 0; return true; } };
struct CtxZSched { int c, G, nt;
    __device__ __forceinline__ bool next(int i, Unit& u) const { const int L = i * G + c; if (L >= 32) return false; u.pm = L & 1; u.pn = 128 + (L >> 1); u.nt = nt; u.kofs = 0; u.tag = 0; return true; } };
struct MergeSched { TileOrder T;
    __device__ __forceinline__ bool next(int i, Unit& u) const { const int ti = i / 3, br = i - 3 * ti; if (!T.tile(ti, u.pm, u.pn)) return false;
        u.tag = br; u.nt = br == 2 ? 8 : 4; u.kofs = br == 0 ? 0 : br == 1 ? 512 : 1024; return true; } };

template <class Epi, class Sched, bool FP8 = false>
__device__ __forceinline__ void gemm_phase(PG8_LAS unsigned char* lds, const Gemm g, const Sched& S, const Epi& E) {
    const int TID = tidx();
    const int tid = TID, wid = __builtin_amdgcn_readfirstlane(tid >> 6), lane = tid & 63, wr = wid >> 2, wc = wid & 3, fr = lane & 15, fq = lane >> 4;
    unsigned voffA[2], voffB[2];
#pragma unroll
    for (int i = 0; i < 2; ++i) { int R, C; stage_rc(tid * 16 + i * 8192, R, C); const int Rb = Epi::PERM ? ((R & ~31) + perm32(R & 31)) : R;
        voffA[i] = (unsigned)(R * g.lda + C) * 2u; voffB[i] = (unsigned)(Rb * g.ldb + C) * 2u; }
    const size_t kstep = (size_t)(BK * 2);
    const size_t hstepA = (size_t)HALF * g.lda * 2, hstepB = (size_t)HALF * g.ldb * 2;
    const size_t tstepA = 2 * hstepA, tstepB = 2 * hstepB;
    const unsigned ldsw = (unsigned)wid * 1024u;
    const int aoffk[2] = {lds_byte(wr * 64 + fr, fq * 8), lds_byte(wr * 64 + fr, fq * 8 + 32)}, boffk[2] = {lds_byte(wc * 32 + fr, fq * 8), lds_byte(wc * 32 + fr, fq * 8 + 32)};
#define PG8_SA(b, h) (((b) * 2 + (h)) * HTB)
#define PG8_SB(b, h) ((4 + (b) * 2 + (h)) * HTB)
#define PG8_STAGE(bufoff, gbase, voff) do { _Pragma("unroll") for (int _i = 0; _i < 2; ++_i) \
        __builtin_amdgcn_global_load_lds((const unsigned*)((const char*)(gbase) + (voff)[_i]), (PG8_LAS unsigned*)(lds + (bufoff) + ldsw + _i * 8192), 16, 0, 0); } while (0)
#define PG8_LDA(dst, b, h) do { _Pragma("unroll") for (int m = 0; m < 4; ++m) { if constexpr (FP8) { const i32x4_ lo_ = *(const PG8_LAS i32x4_*)(lds + PG8_SA(b, h) + aoffk[0] + m * 2048), hi_ = *(const PG8_LAS i32x4_*)(lds + PG8_SA(b, h) + aoffk[1] + m * 2048); dst##8[m] = __builtin_shufflevector(lo_, hi_, 0, 1, 2, 3, 4, 5, 6, 7); } \
        else { _Pragma("unroll") for (int k = 0; k < 2; ++k) dst[m][k] = *(const PG8_LAS bf16x8*)(lds + PG8_SA(b, h) + aoffk[k] + m * 2048); } } } while (0)
#define PG8_LDB(dst, b, h) do { _Pragma("unroll") for (int n = 0; n < 2; ++n) { if constexpr (FP8) { const i32x4_ lo_ = *(const PG8_LAS i32x4_*)(lds + PG8_SB(b, h) + boffk[0] + n * 2048), hi_ = *(const PG8_LAS i32x4_*)(lds + PG8_SB(b, h) + boffk[1] + n * 2048); dst##8[n] = __builtin_shufflevector(lo_, hi_, 0, 1, 2, 3, 4, 5, 6, 7); } \
        else { _Pragma("unroll") for (int k = 0; k < 2; ++k) dst[n][k] = *(const PG8_LAS bf16x8*)(lds + PG8_SB(b, h) + boffk[k] + n * 2048); } } } while (0)
#define PG8_MMA(ai, bj, At, Bt) do { __builtin_amdgcn_s_setprio(1); _Pragma("unroll") for (int m = 0; m < 4; ++m) _Pragma("unroll") for (int n = 0; n < 2; ++n) { \
        if constexpr (FP8) asm volatile("v_mfma_scale_f32_16x16x128_f8f6f4 %0, %1, %2, %0, %3, %3 op_sel_hi:[0,0,0]" : "+v"(acc[ai][bj][m][n]) : "v"(Bt##8[n]), "v"(At##8[m]), "v"(scale1));   \
        else { _Pragma("unroll") for (int k = 0; k < 2; ++k) acc[ai][bj][m][n] = __builtin_amdgcn_mfma_f32_16x16x32_bf16(Bt[n][k], At[m][k], acc[ai][bj][m][n], 0, 0, 0); } } \
        __builtin_amdgcn_s_setprio(0); } while (0)
#define PG8_WAIT_V(n) asm volatile("s_waitcnt vmcnt(" #n ")" ::: "memory")
#define PG8_WAIT_L(n) asm volatile("s_waitcnt lgkmcnt(" #n ")" ::: "memory")
#define PG8_BAR __builtin_amdgcn_s_barrier()
#define PG8_SCHED __builtin_amdgcn_sched_barrier(0)
    Unit cur, nxt; int ui = 0;
    if (!S.next(0, cur)) return;
    int scale1 = 0x7F7F7F7F; asm volatile("" : "+v"(scale1));
    f32x4 acc[2][2][4][2];
#pragma unroll
    for (int a = 0; a < 2; ++a)
#pragma unroll
        for (int b = 0; b < 2; ++b)
#pragma unroll
            for (int m = 0; m < 4; ++m)
#pragma unroll
                for (int n = 0; n < 2; ++n) acc[a][b][m][n] = (f32x4){0.f, 0.f, 0.f, 0.f};
    bf16x8 At[4][2], B0[2][2], B1[2][2];
    i32x8 At8[4], B08[2], B18[2];
    const char* cA = (const char*)g.A + (size_t)cur.pm * tstepA + cur.kofs; const char* cB = (const char*)g.Bt + (size_t)cur.pn * tstepB + cur.kofs;
    PG8_STAGE(PG8_SB(0, 0), cB, voffB); PG8_STAGE(PG8_SB(0, 1), cB + hstepB, voffB); PG8_STAGE(PG8_SA(0, 0), cA, voffA); PG8_STAGE(PG8_SA(0, 1), cA + hstepA, voffA);
    if (wr == 1) PG8_BAR;
    PG8_WAIT_V(2); PG8_BAR;
    PG8_STAGE(PG8_SB(1, 0), cB + kstep, voffB); PG8_STAGE(PG8_SA(1, 0), cA + kstep, voffA); PG8_STAGE(PG8_SB(1, 1), cB + hstepB + kstep, voffB);
    PG8_WAIT_V(6); PG8_BAR;
    for (;;) {
        const bool has_next = S.next(ui + 1, nxt);
        const char* nA = has_next ? (const char*)g.A + (size_t)nxt.pm * tstepA + nxt.kofs : cA; const char* nB = has_next ? (const char*)g.Bt + (size_t)nxt.pn * tstepB + nxt.kofs : cB;
        const int nt = cur.nt;
        for (int t = 0; t < nt; t += 2) {
            const bool last = (t == nt - 2);
            const char* a1 = cA + (size_t)(t + 1) * kstep;
            const char* a2 = last ? nA : cA + (size_t)(t + 2) * kstep; const char* b2 = last ? nB : cB + (size_t)(t + 2) * kstep;
            const char* a3 = a2 + kstep; const char* b3 = b2 + kstep;
            PG8_LDB(B0, 0, 0); PG8_LDB(B1, 0, 1); PG8_SCHED; PG8_LDA(At, 0, 0); PG8_STAGE(PG8_SA(1, 1), a1 + hstepA, voffA);
            PG8_WAIT_V(8); PG8_WAIT_L(0); PG8_BAR; PG8_MMA(0, 0, At, B0); PG8_MMA(0, 1, At, B1); PG8_BAR; PG8_SCHED;
            PG8_LDA(At, 0, 1); PG8_STAGE(PG8_SB(0, 0), b2, voffB); PG8_STAGE(PG8_SB(0, 1), b2 + hstepB, voffB); PG8_STAGE(PG8_SA(0, 0), a2, voffA);
            PG8_WAIT_V(8); PG8_WAIT_L(0); PG8_BAR; PG8_MMA(1, 0, At, B0); PG8_MMA(1, 1, At, B1); PG8_BAR; PG8_SCHED;
            PG8_LDB(B0, 1, 0); PG8_LDB(B1, 1, 1); PG8_SCHED; PG8_LDA(At, 1, 0); PG8_STAGE(PG8_SA(0, 1), a2 + hstepA, voffA);
            PG8_WAIT_V(8); PG8_WAIT_L(0); PG8_BAR; PG8_MMA(0, 0, At, B0); PG8_MMA(0, 1, At, B1); PG8_BAR; PG8_SCHED;
            PG8_LDA(At, 1, 1); PG8_STAGE(PG8_SB(1, 0), b3, voffB); PG8_STAGE(PG8_SB(1, 1), b3 + hstepB, voffB); PG8_STAGE(PG8_SA(1, 0), a3, voffA);
            PG8_WAIT_V(8); PG8_WAIT_L(0); PG8_BAR; PG8_MMA(1, 0, At, B0); PG8_MMA(1, 1, At, B1); PG8_BAR; PG8_SCHED;
        }
        if (wr == 0) PG8_BAR;
        if constexpr (FP8) asm volatile("s_nop 15\n\ts_nop 15" ::: "memory");
        E(acc, cur, wr, wc, fr, fq);
        if (!has_next) break;
        if (!E.keeps(cur)) {
#pragma unroll
        for (int a = 0; a < 2; ++a)
#pragma unroll
            for (int b = 0; b < 2; ++b)
#pragma unroll
                for (int m = 0; m < 4; ++m)
#pragma unroll
                    for (int n = 0; n < 2; ++n) acc[a][b][m][n] = (f32x4){0.f, 0.f, 0.f, 0.f};
        }
        cur = nxt; cA = nA; cB = nB; ++ui;
        if (wr == 1) PG8_BAR;
    }
    PG8_WAIT_V(0);
    PG8_BAR;
#undef PG8_SA
#undef PG8_SB
#undef PG8_STAGE
#undef PG8_LDA
#undef PG8_LDB
#undef PG8_MMA
#undef PG8_WAIT_V
#undef PG8_WAIT_L
#undef PG8_BAR
#undef PG8_SCHED
}
__device__ __forceinline__ u32x4 pack8(f32x4 v0, f32x4 v1) { u32x4 w; w.x = pk_bf16(v0[0], v0[1]); w.y = pk_bf16(v0[2], v0[3]); w.z = pk_bf16(v1[0], v1[1]); w.w = pk_bf16(v1[2], v1[3]); return w; }
__device__ __forceinline__ u32x2 pack8u(f32x4 a, f32x4 b) {
    u32x2 w;
    w.x = (unsigned)__builtin_rintf(a[0] * 255.f) | ((unsigned)__builtin_rintf(a[1] * 255.f) << 8) | ((unsigned)__builtin_rintf(a[2] * 255.f) << 16) | ((unsigned)__builtin_rintf(a[3] * 255.f) << 24);
    w.y = (unsigned)__builtin_rintf(b[0] * 255.f) | ((unsigned)__builtin_rintf(b[1] * 255.f) << 8) | ((unsigned)__builtin_rintf(b[2] * 255.f) << 16) | ((unsigned)__builtin_rintf(b[3] * 255.f) << 24);
    return w;
}
__device__ __forceinline__ void unpk8u(u32x2 w, float (&f)[8]) {
    const unsigned x = w.x, y = w.y; const float k = 1.0f / 255.0f;
    f[0] = (float)(x & 255u) * k; f[1] = (float)((x >> 8) & 255u) * k; f[2] = (float)((x >> 16) & 255u) * k; f[3] = (float)(x >> 24) * k;
    f[4] = (float)(y & 255u) * k; f[5] = (float)((y >> 8) & 255u) * k; f[6] = (float)((y >> 16) & 255u) * k; f[7] = (float)(y >> 24) * k;
}
__device__ __forceinline__ f32x4 sig4(f32x4 v) { return (f32x4){sigmoidf_(v[0]), sigmoidf_(v[1]), sigmoidf_(v[2]), sigmoidf_(v[3])}; }
struct EpiG1 {
    static constexpr bool PERM = true; __device__ __forceinline__ bool keeps(const Unit&) const { return false; } unsigned char* ws;
    __device__ __forceinline__ void operator()(const f32x4 (&acc)[2][2][4][2], const Unit& u, int wr, int wc, int fr, int fq) const {
        const int rl = wr * 64 + fr, cl = wc * 32 + 8 * fq; const int row0 = u.pm * BM + rl;
        const int kvb = (u.pm < 128 ? (u.pm >> 3) * KV + (u.pm & 7) * 256 : (u.pm - 128) * KV + SEQ) + rl;
#pragma unroll
        for (int ai = 0; ai < 2; ++ai)
#pragma unroll
            for (int m = 0; m < 4; ++m) { const int ro = ai * HALF + m * 16;
#pragma unroll
                for (int bj = 0; bj < 2; ++bj) { const f32x4 v0 = acc[ai][bj][m][0], v1 = acc[ai][bj][m][1];
                    if (u.pn == 0) *(u32x4*)((bf16_t*)(ws + OFF_PP) + (size_t)(row0 + ro) * 256 + bj * HALF + cl) = pack8(v0, v1);
                    else if (u.pn < 3) *(u32x4*)((bf16_t*)(ws + OFF_QR) + (size_t)(row0 + ro) * 512 + (u.pn - 1) * 256 + bj * HALF + cl) = pack8(v0, v1);
                    else if (u.pn == 3) *(u32x4*)((bf16_t*)(ws + (bj ? OFF_VALL : OFF_KALL)) + (size_t)(kvb + ro) * 128 + cl) = pack8(v0, v1);
                    else *(u32x2*)(ws + OFF_GT + (size_t)(row0 + ro) * 3072 + (u.pn - 4) * 256 + bj * HALF + cl) = pack8u(sig4(v0), sig4(v1)); } }
    }
};
struct EpiG8 {
    static constexpr bool PERM = true; __device__ __forceinline__ bool keeps(const Unit&) const { return false; } unsigned char* ws; const PG8_LAS unsigned char* lut;
    __device__ __forceinline__ unsigned g4(const f32x4 v) const {
        const unsigned i0 = min((unsigned)(v[0] + 512.5f), 1023u), i1 = min((unsigned)(v[1] + 512.5f), 1023u), i2 = min((unsigned)(v[2] + 512.5f), 1023u), i3 = min((unsigned)(v[3] + 512.5f), 1023u);
        return (unsigned)lut[i0] | ((unsigned)lut[i1] << 8) | ((unsigned)lut[i2] << 16) | ((unsigned)lut[i3] << 24);
    }
    __device__ __forceinline__ void operator()(const f32x4 (&acc)[2][2][4][2], const Unit& u, int wr, int wc, int fr, int fq) const {
        const int row0 = u.pm * BM + wr * 64 + fr, cl = wc * 32 + 8 * (fq & ~1); const int odd = fq & 1;
#pragma unroll
        for (int ai = 0; ai < 2; ++ai)
#pragma unroll
            for (int bj = 0; bj < 2; ++bj)
#pragma unroll
                for (int mp = 0; mp < 2; ++mp) {
                    const unsigned a0 = g4(acc[ai][bj][2 * mp][0]), a1 = g4(acc[ai][bj][2 * mp][1]), b0 = g4(acc[ai][bj][2 * mp + 1][0]), b1 = g4(acc[ai][bj][2 * mp + 1][1]);
                    auto s0 = __builtin_amdgcn_permlane16_swap(a0, b0, false, false); auto s1 = __builtin_amdgcn_permlane16_swap(a1, b1, false, false);
                    u32x4 o; o.x = (unsigned)s0[0]; o.y = (unsigned)s1[0]; o.z = (unsigned)s0[1]; o.w = (unsigned)s1[1];
                    *(u32x4*)(ws + OFF_GT + (size_t)(row0 + ai * HALF + (2 * mp + odd) * 16) * 3072 + u.pn * 256 + bj * HALF + cl) = o; }
    }
};
struct EpiGZ {
    static constexpr bool PERM = true; __device__ __forceinline__ bool keeps(const Unit&) const { return false; } unsigned char* ws;
    __device__ __forceinline__ void operator()(const f32x4 (&acc)[2][2][4][2], const Unit& u, int wr, int wc, int fr, int fq) const {
        const int ch0 = wr * 64 + fr, tl = wc * 32 + 8 * fq;
        bf16_t* base; int pitch;
        if (u.pn < 128) { base = (bf16_t*)(ws + OFF_ZTL) + (size_t)((u.pn >> 3) * 256) * 4096 + u.pm * 2048 + (u.pn & 7) * 256; pitch = 4096; }
        else { base = (bf16_t*)(ws + OFF_ZTC) + (size_t)((u.pn - 128) * 256) * 512 + u.pm * 256; pitch = 512; }
#pragma unroll
        for (int ai = 0; ai < 2; ++ai)
#pragma unroll
            for (int m = 0; m < 4; ++m) { const int ch = ch0 + ai * HALF + m * 16;
#pragma unroll
                for (int bj = 0; bj < 2; ++bj) *(u32x4*)(base + (size_t)ch * pitch + bj * HALF + tl) = pack8(acc[ai][bj][m][0], acc[ai][bj][m][1]); }
    }
};
struct EpiRe8 {
    static constexpr bool PERM = true; __device__ __forceinline__ bool keeps(const Unit&) const { return false; } bf16_t* mix; int ctx;
    __device__ __forceinline__ void operator()(const f32x4 (&acc)[2][2][4][2], const Unit& u, int wr, int wc, int fr, int fq) const {
        const int rb = (ctx ? NL + u.tag * CTX : u.tag * SEQ + (u.pm & 7) * 256) + wr * 64 + fr, cl = wc * 32 + 8 * fq;
        const float sc = ctx ? 1.0f / 128.0f : 0.0027621358640099515f;
#pragma unroll
        for (int ai = 0; ai < 2; ++ai)
#pragma unroll
            for (int m = 0; m < 4; ++m)
#pragma unroll
                for (int bj = 0; bj < 2; ++bj) *(u32x4*)(mix + (size_t)(rb + ai * HALF + m * 16) * D + bj * HALF + cl) = pack8(acc[ai][bj][m][0] * sc, acc[ai][bj][m][1] * sc);
    }
};
struct EpiMg {
    static constexpr bool PERM = true; unsigned char* ws;
    __device__ __forceinline__ bool keeps(const Unit& u) const { return u.tag != 2; }
    __device__ __forceinline__ void operator()(f32x4 (&acc)[2][2][4][2], const Unit& u, int wr, int wc, int fr, int fq) const {
        const int row0 = u.pm * BM + wr * 64 + fr, col0 = u.pn * BM + wc * 32 + 8 * fq;
        const unsigned char* gt = ws + OFF_GT + u.tag * 1024; bf16_t* U = (bf16_t*)(ws + OFF_HB);
        const unsigned go = (unsigned)row0 * 3072u + (unsigned)col0, dofs = u.tag != 2 ? 1024u : 0u; const bool ratio = u.tag != 2;
#pragma unroll
        for (int g = 0; g < 4; ++g) {
            u32x2 gn[2][2], gd[2][2];
#pragma unroll
            for (int mm = 0; mm < 2; ++mm)
#pragma unroll
                for (int bj = 0; bj < 2; ++bj) { const unsigned o = go + (unsigned)((g >> 1) * HALF + ((g & 1) * 2 + mm) * 16) * 3072u + (unsigned)(bj * HALF);
                    gn[mm][bj] = *(const u32x2*)(gt + o); gd[mm][bj] = *(const u32x2*)(gt + (o + dofs)); }
#pragma unroll
            for (int mm = 0; mm < 2; ++mm)
#pragma unroll
                for (int bj = 0; bj < 2; ++bj) { const int ai = g >> 1, m = (g & 1) * 2 + mm; float f[8], d[8];
                    u32x2 dd = gd[mm][bj]; dd.x = ratio ? dd.x : 0xFFFFFFFFu; dd.y = ratio ? dd.y : 0xFFFFFFFFu;
                    unpk8u(gn[mm][bj], f); unpk8u(dd, d);
#pragma unroll
                    for (int i = 0; i < 8; ++i) f[i] = fmaxf(f[i], 1e-20f) * __builtin_amdgcn_rcpf(fmaxf(d[i], 1e-20f));
                    f32x4 v0 = acc[ai][bj][m][0], v1 = acc[ai][bj][m][1];
                    v0[0] *= f[0]; v0[1] *= f[1]; v0[2] *= f[2]; v0[3] *= f[3]; v1[0] *= f[4]; v1[1] *= f[5]; v1[2] *= f[6]; v1[3] *= f[7];
                    acc[ai][bj][m][0] = v0; acc[ai][bj][m][1] = v1; }
        }
        if (u.tag == 2) {
#pragma unroll
            for (int ai = 0; ai < 2; ++ai)
#pragma unroll
                for (int m = 0; m < 4; ++m)
#pragma unroll
                    for (int bj = 0; bj < 2; ++bj) *(u32x4*)(U + (size_t)(row0 + ai * HALF + m * 16) * D + col0 + bj * HALF) = pack8(acc[ai][bj][m][0], acc[ai][bj][m][1]);
        }
    }
};
struct EpiO {
    static constexpr bool PERM = false; __device__ __forceinline__ bool keeps(const Unit&) const { return false; } float* out; unsigned char* ws; int l; const float* xin; const float* cin;
    __device__ __forceinline__ void operator()(const f32x4 (&acc)[2][2][4][2], const Unit& u, int wr, int wc, int fr, int fq) const {
        const int rl = wr * 64 + fr, col0 = u.pn * BM + wc * 32 + 4 * fq;
        float* xb = (u.pm < 128 ? out + (size_t)u.pm * BM * D : (float*)(ws + OFF_XC) + (size_t)(u.pm - 128) * BM * D) + (size_t)rl * D + col0;
        const float* xr = (u.pm < 128 ? xin + (size_t)u.pm * BM * D : cin + (size_t)(u.pm - 128) * BM * D) + (size_t)rl * D + col0;
        const float* m2 = (const float*)(ws + OFF_MOD) + ((size_t)(l * 17 + (u.pm < 128 ? (u.pm >> 3) : 16)) * 6 + 2) * D + col0;
        f32x4 gv[2][2];
#pragma unroll
        for (int bj = 0; bj < 2; ++bj)
#pragma unroll
            for (int n = 0; n < 2; ++n) gv[bj][n] = *(const f32x4*)(m2 + bj * HALF + n * 16);
        f32x4 xv[2][2][2][2];
#define EO_LOAD(G, BUF) do { _Pragma("unroll") for (int mm = 0; mm < 2; ++mm) { const int ai_ = (G) >> 1, m_ = ((G) & 1) * 2 + mm; const size_t ro_ = (size_t)(ai_ * HALF + m_ * 16) * D; \
            _Pragma("unroll") for (int bj = 0; bj < 2; ++bj) _Pragma("unroll") for (int n = 0; n < 2; ++n) xv[BUF][mm][bj][n] = *(const f32x4*)(xr + ro_ + bj * HALF + n * 16); } } while (0)
        EO_LOAD(0, 0);
#pragma unroll
        for (int g = 0; g < 4; ++g) { const int cb = g & 1;
            if (g < 3) EO_LOAD(g + 1, cb ^ 1);
            asm volatile("" : "+v"(xv[cb][0][0][0]), "+v"(xv[cb][0][0][1]), "+v"(xv[cb][0][1][0]), "+v"(xv[cb][0][1][1]), "+v"(xv[cb][1][0][0]), "+v"(xv[cb][1][0][1]), "+v"(xv[cb][1][1][0]), "+v"(xv[cb][1][1][1]));
#pragma unroll
            for (int mm = 0; mm < 2; ++mm) { const int ai = g >> 1, m = (g & 1) * 2 + mm; const size_t ro = (size_t)(ai * HALF + m * 16) * D;
#pragma unroll
                for (int bj = 0; bj < 2; ++bj)
#pragma unroll
                    for (int n = 0; n < 2; ++n) *(f32x4*)(xb + ro + bj * HALF + n * 16) = xv[cb][mm][bj][n] + gv[bj][n] * acc[ai][bj][m][n]; }
        }
#undef EO_LOAD
    }
};
struct EpiS {
    static constexpr bool PERM = true; __device__ __forceinline__ bool keeps(const Unit&) const { return false; } bf16_t* st;
    __device__ __forceinline__ void operator()(const f32x4 (&acc)[2][2][4][2], const Unit& u, int wr, int wc, int fr, int fq) const {
        bf16_t* base = st + (size_t)(u.pm * BM + wr * 64 + fr) * NT + u.pn * BM + wc * 32 + 8 * fq;
#pragma unroll
        for (int ai = 0; ai < 2; ++ai)
#pragma unroll
            for (int m = 0; m < 4; ++m)
#pragma unroll
                for (int bj = 0; bj < 2; ++bj) { u32x4 p = pack8(acc[ai][bj][m][0], acc[ai][bj][m][1]);
                    p.x ^= ((p.x >> 15) & 0x00010001u) * 0x7fffu; p.y ^= ((p.y >> 15) & 0x00010001u) * 0x7fffu; p.z ^= ((p.z >> 15) & 0x00010001u) * 0x7fffu; p.w ^= ((p.w >> 15) & 0x00010001u) * 0x7fffu;
                    *(u32x4*)(base + (size_t)(ai * HALF + m * 16) * NT + bj * HALF) = p; }
    }
};
struct DftSched { int G, c, ctx;
    __device__ __forceinline__ bool next(int i, Unit& u) const { const int L = i * G + c; const int n = ctx ? NB : NB * 8; if (L >= n) return false;
        if (ctx) { u.pm = 0; u.pn = L; u.tag = L; u.nt = 8; } else { u.pm = L & 7; u.pn = L >> 3; u.tag = L >> 3; u.nt = 64; }
        u.kofs = 0; return true; } };
}


__device__ __forceinline__ void ph_gemm1_pg(const Params& P, int l, int bid, int nblk, unsigned char* smem) {
    PG8_LAS unsigned char* lds = (PG8_LAS unsigned char*)smem; const bf16_t* HB = (const bf16_t*)(P.ws + OFF_HB);
    { pg8::Gemm g{(const bf16_t*)(P.ws + OFF_HB8), (const bf16_t*)(P.ws + OFF_WG8 + (size_t)l * 3072 * D), D / 2, D / 2}; pg8::PlainSched S; S.T.init(NT / 256, 12, nblk, bid); S.nt = 8; pg8::EpiG8 E{P.ws, (const PG8_LAS unsigned char*)(lds + SIGLUT_OFF)};
      pg8::gemm_phase<pg8::EpiG8, pg8::PlainSched, true>(lds, g, S, E); }
    { pg8::Gemm g{HB, (const bf16_t*)(P.ws + OFF_W1T) + (size_t)l * 4096 * D, D, D}; pg8::PlainSched S; S.T.init(NT / 256, 4, nblk, nblk == 256 ? (bid + 64) & 255 : bid); S.nt = 16; pg8::EpiG1 E{P.ws}; pg8::gemm_phase(lds, g, S, E); }
    { pg8::Gemm g{(const bf16_t*)(P.ws + OFF_WFT) + (size_t)l * 512 * D, HB, D, D}; pg8::PlainSched S; S.T.init(2, NL / 256, nblk, bid); S.nt = 16; pg8::EpiGZ E{P.ws}; pg8::gemm_phase(lds, g, S, E); }
}
__device__ __forceinline__ void ph_gemm1_ctxz(const Params& P, int l, int c, int G, unsigned char* smem) {
    PG8_LAS unsigned char* lds = (PG8_LAS unsigned char*)smem;
    pg8::Gemm g{(const bf16_t*)(P.ws + OFF_WFT) + (size_t)l * 512 * D, (const bf16_t*)(P.ws + OFF_HB), D, D}; pg8::CtxZSched S{c, G, 16}; pg8::EpiGZ E{P.ws}; pg8::gemm_phase(lds, g, S, E);
}
__device__ __forceinline__ void ph_merge_pg(const Params& P, int l, int ntok, int bid, int nblk, unsigned char* smem) {
    PG8_LAS unsigned char* lds = (PG8_LAS unsigned char*)smem;
    pg8::Gemm g{(const bf16_t*)(P.ws + OFF_MIX), (const bf16_t*)(P.ws + OFF_WMT) + (size_t)l * D * D, D, D}; pg8::MergeSched S; S.T.init(ntok / 256, 4, nblk, bid); pg8::EpiMg E{P.ws}; pg8::gemm_phase(lds, g, S, E);
}
__device__ __forceinline__ void ph_out_pg(const Params& P, int l, int ntok, int bid, int nblk, unsigned char* smem) {
    PG8_LAS unsigned char* lds = (PG8_LAS unsigned char*)smem;
    pg8::Gemm g{(const bf16_t*)(P.ws + OFF_HB), (const bf16_t*)(P.ws + OFF_WOT) + (size_t)l * D * D, D, D}; pg8::PlainSched S; S.T.init(ntok / 256, 4, nblk, bid); S.nt = 16; pg8::EpiO E{P.out, P.ws, l, l == 0 ? P.x : (const float*)P.out, l == 0 ? P.ctx : (const float*)(P.ws + OFF_XC)}; pg8::gemm_phase(lds, g, S, E);
}
__device__ __forceinline__ void ph_score_pg(const Params& P, int l, int ntok, int bid, int nblk, unsigned char* smem) {
    PG8_LAS unsigned char* lds = (PG8_LAS unsigned char*)smem;
    pg8::Gemm g{(const bf16_t*)(P.ws + OFF_WST) + (size_t)l * 2048 * D, (const bf16_t*)(P.ws + OFF_HB), D, D}; pg8::PlainSched S; S.T.init(8, ntok / 256, nblk, bid); S.nt = 16; pg8::EpiS E{(bf16_t*)(P.ws + OFF_ST)}; pg8::gemm_phase(lds, g, S, E);
}


namespace attn_body {
using bf16=__hip_bfloat16;
using bf16x8=__attribute__((ext_vector_type(8)))short;
using s16x4=__attribute__((ext_vector_type(4)))short;
using f32x16=__attribute__((ext_vector_type(16)))float;
using u32x4=__attribute__((ext_vector_type(4)))unsigned;
constexpr int D=64,QP=512,KP=128,OP=1024;
constexpr int NW=8,QBLK=32,QB=QBLK*NW,KVBLK=64;
__device__ __forceinline__ int crow(int r,int hi){return (r&3)+8*(r>>2)+4*hi;}
#define SBAR() __builtin_amdgcn_sched_barrier(0)
constexpr int NSLOT=3, SLOTB=8192;
constexpr int LDS_K=0, LDS_V=NSLOT*SLOTB, LDS_WS=2*NSLOT*SLOTB, LDS_OST=LDS_WS+NW*64*4, LDS_BYTES=LDS_OST+NW*4096;
constexpr float C2=0.125f*1.4426950408889634f;
__device__ __forceinline__ void glds16(const void*gsrc,unsigned lds_dst){unsigned keep;
  asm volatile("s_mov_b32 %0, m0\n\ts_mov_b32 m0, %2\n\ts_nop 0\n\tglobal_load_lds_dwordx4 %1, off\n\ts_mov_b32 m0, %0":"=&s"(keep):"v"(gsrc),"s"(lds_dst):"memory");}
__device__ __forceinline__ float max3f(float a,float b,float c){float r;asm("v_max3_f32 %0, %1, %2, %3":"=v"(r):"v"(a),"v"(b),"v"(c));return r;}
__device__ __forceinline__ float max2f(float a,float b){float r;asm("v_max_f32_e32 %0, %1, %2":"=v"(r):"v"(a),"v"(b));return r;}
__device__ __forceinline__ float fadd_s(float a,float b){float r;asm("v_add_f32_e32 %0, %1, %2":"=v"(r):"v"(a),"v"(b));return r;}
__device__ __forceinline__ float fsub_s(float a,float b){float r;asm("v_sub_f32_e32 %0, %1, %2":"=v"(r):"v"(a),"v"(b));return r;}
typedef float f32x2_t __attribute__((ext_vector_type(2))); typedef __bf16 bf16x2_t __attribute__((ext_vector_type(2)));
__device__ __forceinline__ unsigned cvtpk_s(float lo,float hi){f32x2_t v={lo,hi};bf16x2_t b=__builtin_convertvector(v,bf16x2_t);return __builtin_bit_cast(unsigned,b);}
#define WAIT_BAR(N) asm volatile("s_waitcnt vmcnt(" #N ") lgkmcnt(0)\n\ts_barrier":::"memory")

__device__ __forceinline__ void qkt(f32x16&p0,f32x16&p1,const char*Kslot,const bf16x8*qr,const f32x16&negm,int r32,int hi){
  const char*kb=Kslot+hi*1024+r32*16;
  #pragma unroll
  for(int d0=0;d0<4;++d0){
    const bf16x8 b0=*reinterpret_cast<const bf16x8*>(kb+d0*2048);
    const bf16x8 b1=*reinterpret_cast<const bf16x8*>(kb+d0*2048+512);
    if(d0==0){p0=__builtin_amdgcn_mfma_f32_32x32x16_bf16(b0,qr[0],negm,0,0,0);p1=__builtin_amdgcn_mfma_f32_32x32x16_bf16(b1,qr[0],negm,0,0,0);}
    else{p0=__builtin_amdgcn_mfma_f32_32x32x16_bf16(b0,qr[d0],p0,0,0,0);p1=__builtin_amdgcn_mfma_f32_32x32x16_bf16(b1,qr[d0],p1,0,0,0);}}
}
typedef __attribute__((address_space(3))) const char* lds_cptr;
typedef short v4i16_t __attribute__((ext_vector_type(4)));
__device__ __forceinline__ void kload8(bf16x8*kf,lds_cptr kp){
  kf[0]=*(const __attribute__((address_space(3))) bf16x8*)(kp);      kf[1]=*(const __attribute__((address_space(3))) bf16x8*)(kp+512);
  kf[2]=*(const __attribute__((address_space(3))) bf16x8*)(kp+2048); kf[3]=*(const __attribute__((address_space(3))) bf16x8*)(kp+2560);
  kf[4]=*(const __attribute__((address_space(3))) bf16x8*)(kp+4096); kf[5]=*(const __attribute__((address_space(3))) bf16x8*)(kp+4608);
  kf[6]=*(const __attribute__((address_space(3))) bf16x8*)(kp+6144); kf[7]=*(const __attribute__((address_space(3))) bf16x8*)(kp+6656);
}
__device__ __forceinline__ void kload2(bf16x8*kf,lds_cptr kp,int j){ kf[2*j]=*(const __attribute__((address_space(3))) bf16x8*)(kp+j*2048); kf[2*j+1]=*(const __attribute__((address_space(3))) bf16x8*)(kp+j*2048+512); }
__device__ __forceinline__ s16x4 vtr(lds_cptr p){ return __builtin_bit_cast(s16x4,__builtin_amdgcn_ds_read_tr16_b64_v4i16((__attribute__((address_space(3))) v4i16_t*)p)); }
__device__ __forceinline__ float rowmax(const f32x16&p0,const f32x16&p1){
  float a=max3f(p0[0],p0[1],p1[0]),b=max3f(p0[2],p0[3],p1[1]);a=max3f(a,p1[2],p1[3]);
  #pragma unroll
  for(int r=4;r<16;r+=4){a=max3f(a,p0[r],p0[r+1]);b=max3f(b,p0[r+2],p0[r+3]);a=max3f(a,p1[r],p1[r+1]);b=max3f(b,p1[r+2],p1[r+3]);}
  const float m=max2f(a,b);
  auto rr=__builtin_amdgcn_permlane32_swap(__float_as_uint(m),__float_as_uint(m),false,false);
  return max2f(__uint_as_float(rr[0]),__uint_as_float(rr[1]));
}
__device__ __forceinline__ void pv(f32x16*o,int vb,bf16x8 pa0,bf16x8 pa1,bf16x8 pa2,bf16x8 pa3){
  #pragma unroll
  for(int d0=0;d0<2;++d0){s16x4 lo[4],hi[4];
    #pragma unroll
    for(int ks=0;ks<4;++ks){
      asm volatile("ds_read_b64_tr_b16 %0,%1 offset:%c2":"=&v"(lo[ks]):"v"(vb),"i"(d0*4096+ks*1024):"memory");
      asm volatile("ds_read_b64_tr_b16 %0,%1 offset:%c2":"=&v"(hi[ks]):"v"(vb),"i"(d0*4096+ks*1024+512):"memory");}
    asm volatile("s_waitcnt lgkmcnt(0)":::"memory");SBAR();
    #define PK(k) (bf16x8){lo[k][0],lo[k][1],lo[k][2],lo[k][3],hi[k][0],hi[k][1],hi[k][2],hi[k][3]}
    o[d0]=__builtin_amdgcn_mfma_f32_32x32x16_bf16(pa0,PK(0),o[d0],0,0,0);
    o[d0]=__builtin_amdgcn_mfma_f32_32x32x16_bf16(pa1,PK(1),o[d0],0,0,0);
    o[d0]=__builtin_amdgcn_mfma_f32_32x32x16_bf16(pa2,PK(2),o[d0],0,0,0);
    o[d0]=__builtin_amdgcn_mfma_f32_32x32x16_bf16(pa3,PK(3),o[d0],0,0,0);
    #undef PK
  }
}

#ifndef ATTN_STORE16
#define ATTN_STORE16(p,v) (*(u32x4*)(p)=(v))
#endif
template<int THRL> __device__ __forceinline__ void attn_unit(const bf16*Qu,const bf16*__restrict__ Kh,const bf16*__restrict__ Vh,bf16*Ou,const int NT,char*shm){
  const int tid=tidx(),lane=tid&63,r32=lane&31,hi=lane>>5; const int wid=__builtin_amdgcn_readfirstlane(tid>>6);
  const bf16*Qw=Qu+(long)(wid*QBLK)*QP;
  const unsigned lds0=(unsigned)(uintptr_t)shm;
  float*wsf=(float*)(shm+LDS_WS)+wid*64;
  const bf16*ksrc=Kh+(long)lane*KP+wid*8;
  const bf16*vsrc=Vh+(long)(16*(wid&3)+(lane>>2))*KP+(wid>>2)*32+(lane&3)*8;
  const unsigned kdst=lds0+LDS_K+wid*1024, vdst=lds0+LDS_V+wid*1024;
  #define DMA_K(t,slot) glds16(ksrc+(long)(t)*KVBLK*KP,(unsigned)__builtin_amdgcn_readfirstlane(kdst+(slot)))
  #define DMA_V(t,slot) glds16(vsrc+(long)(t)*KVBLK*KP,(unsigned)__builtin_amdgcn_readfirstlane(vdst+(slot)))
  const int vb0=(int)(lds0+LDS_V)+((lane>>4)&1)*32+(lane&3)*8+(4*hi+((lane&15)>>2))*64;
  const char*Kbase=shm+LDS_K; bf16x8 kf[8];
  const lds_cptr shm3=(lds_cptr)shm; const lds_cptr kp0=shm3+LDS_K+hi*1024+r32*16; const lds_cptr vp0=shm3+LDS_V+((lane>>4)&1)*32+(lane&3)*8+(4*hi+((lane&15)>>2))*64;
  DMA_K(0,0);DMA_V(0,0);DMA_K(1,SLOTB);
  bf16x8 qr[4];
  #pragma unroll
  for(int d0=0;d0<4;++d0)qr[d0]=*reinterpret_cast<const bf16x8*>(&Qw[(long)r32*QP+d0*16+hi*8]);
  float mhat=0.f,l_reg=0.f;f32x16 o[2];o[0]=f32x16{};o[1]=f32x16{};f32x16 negm=f32x16{};asm volatile("":"+v"(negm));
  #define CMASK(P0,P1,t) do{}while(0)
  bool resc=false;
  #define START(P0,P1) do{ const float rm=rowmax(P0,P1); resc=false; \
    { const float dl=rm; mhat=fadd_s(mhat,dl); \
      _Pragma("unroll") for(int r=0;r<16;++r){P0[r]=fsub_s(P0[r],dl);P1[r]=fsub_s(P1[r],dl);} \
      _Pragma("unroll") for(int r=0;r<16;++r)negm[r]=-mhat; asm volatile("":"+v"(negm)); } \
    _Pragma("unroll") for(int r=0;r<16;++r)P0[r]=__builtin_amdgcn_exp2f(P0[r]); }while(0)
  #define RESC() do{ if(resc){ asm volatile("s_waitcnt lgkmcnt(0)":::"memory"); \
      _Pragma("unroll") for(int d_=0;d_<2;++d_) _Pragma("unroll") for(int r=0;r<16;++r)o[d_][r]*=wsf[crow(r,hi)]; } }while(0)
  f32x16 pA0,pA1,pB0,pB1;
  int sl_prev=0,sl_cur=0,sl_next=SLOTB;
  #define ROT() do{sl_prev=sl_cur;sl_cur=sl_next;sl_next=(sl_next==(NSLOT-1)*SLOTB)?0:sl_next+SLOTB;}while(0)
  DMA_K(2,2*SLOTB);
  WAIT_BAR(3);
  qkt(pA0,pA1,Kbase,qr,negm,r32,hi);asm volatile("s_nop 15\n\ts_nop 7":"+v"(pA0),"+v"(pA1));CMASK(pA0,pA1,0);
  START(pA0,pA1);
  _Pragma("unroll") for(int r=0;r<16;++r)pA1[r]=__builtin_amdgcn_exp2f(pA1[r]);
  WAIT_BAR(0);
  DMA_K(3,0);DMA_V(1,SLOTB);
  ROT();
  kload8(kf,kp0+sl_cur);
  WAIT_BAR(2);
  s16x4 vlo[8],vhi[8]; u32x4 pw0,pw1,pw2,pw3;
  #define PKW(P,B) cvtpk_s(P[B],P[B+1])
  #define PAF(k) __builtin_bit_cast(bf16x8,pw##k)
  #define VFR(i) (bf16x8){vlo[i][0],vlo[i][1],vlo[i][2],vlo[i][3],vhi[i][0],vhi[i][1],vhi[i][2],vhi[i][3]}
  #define PIN(x) asm volatile("":"+v"(x))
  #define MX3(a,b,c) __builtin_fmaxf(__builtin_fmaxf((a),(b)),(c))
  #define GAPA(MF,A0,A1,A2,A3,W0,W1,PW) do{ MF; sacc+=A0; sacc+=A1; sacc+=A2; sacc+=A3; PIN(sacc); W0; W1; PIN(PW); SBAR(); }while(0)
  #define EX(v) __builtin_amdgcn_exp2f(v)
  #define GAPB(MF,X,B) do{ MF; X[B]=EX(X[B]); X[B+1]=EX(X[B+1]); X[B+2]=EX(X[B+2]); X[B+3]=EX(X[B+3]); PIN(X); SBAR(); }while(0)
  #define VRD(i) do{ vlo[i]=vtr(vp_+(((i)>>2)*4096+((i)&3)*1024)); vhi[i]=vtr(vp_+(((i)>>2)*4096+((i)&3)*1024+512)); }while(0)
  #define KRD(G,j) do{ if(G){ kload2(kf,kp0+sl_next,j); SBAR(); } }while(0)
  #define STEP(C0,C1,P0,P1,t,GK,GV,GL) do{ SBAR(); \
    const lds_cptr vp_=vp0+sl_prev; \
    VRD(0); SBAR(); float sacc=(P0[0]+P0[1]); \
    GAPA(C0=__builtin_amdgcn_mfma_f32_32x32x16_bf16(kf[0],qr[0],negm,0,0,0), P0[2],P0[3],P0[4],P0[5],     pw0[0]=PKW(P0,0), pw0[1]=PKW(P0,2), pw0); \
    VRD(4); SBAR(); GAPA(C1=__builtin_amdgcn_mfma_f32_32x32x16_bf16(kf[1],qr[0],negm,0,0,0), P0[6],P0[7],P0[8],P0[9],     pw0[2]=PKW(P0,4), pw0[3]=PKW(P0,6), pw0); \
    VRD(1); SBAR(); GAPA(C0=__builtin_amdgcn_mfma_f32_32x32x16_bf16(kf[2],qr[1],C0,0,0,0),   P0[10],P0[11],P0[12],P0[13], pw1[0]=PKW(P0,8), pw1[1]=PKW(P0,10), pw1); \
    VRD(5); SBAR(); GAPA(C1=__builtin_amdgcn_mfma_f32_32x32x16_bf16(kf[3],qr[1],C1,0,0,0),   P0[14],P0[15],P1[0],P1[1],   pw1[2]=PKW(P0,12),pw1[3]=PKW(P0,14), pw1); \
    VRD(2); SBAR(); GAPA(C0=__builtin_amdgcn_mfma_f32_32x32x16_bf16(kf[4],qr[2],C0,0,0,0),   P1[2],P1[3],P1[4],P1[5],     pw2[0]=PKW(P1,0), pw2[1]=PKW(P1,2), pw2); \
    VRD(6); SBAR(); GAPA(C1=__builtin_amdgcn_mfma_f32_32x32x16_bf16(kf[5],qr[2],C1,0,0,0),   P1[6],P1[7],P1[8],P1[9],     pw2[2]=PKW(P1,4), pw2[3]=PKW(P1,6), pw2); \
    VRD(3); SBAR(); GAPA(C0=__builtin_amdgcn_mfma_f32_32x32x16_bf16(kf[6],qr[3],C0,0,0,0),   P1[10],P1[11],P1[12],P1[13], pw3[0]=PKW(P1,8), pw3[1]=PKW(P1,10), pw3); \
    VRD(7); SBAR(); GAPA(C1=__builtin_amdgcn_mfma_f32_32x32x16_bf16(kf[7],qr[3],C1,0,0,0),   P1[14],P1[15],0.f,0.f,       pw3[2]=PKW(P1,12),pw3[3]=PKW(P1,14), pw3); \
    l_reg+=sacc; \
    if(GK){DMA_K((t)+3,sl_cur);} if(GV){DMA_V((t)+1,sl_next);} \
    CMASK(C0,C1,t); \
    { float a=MX3(C0[0],C0[1],C1[0]),b=MX3(C0[2],C0[3],C1[1]); a=MX3(a,C1[2],C1[3]); \
      _Pragma("unroll") for(int r=4;r<16;r+=4){a=MX3(a,C0[r],C0[r+1]);b=MX3(b,C0[r+2],C0[r+3]);a=MX3(a,C1[r],C1[r+1]);b=MX3(b,C1[r+2],C1[r+3]);} \
      float rm=__builtin_fmaxf(a,b); { auto rr=__builtin_amdgcn_permlane32_swap(__float_as_uint(rm),__float_as_uint(rm),false,false); rm=__builtin_fmaxf(__uint_as_float(rr[0]),__uint_as_float(rr[1])); } \
      resc=false; \
      if(__builtin_expect(__any(rm>(float)THRL),0)){ const float dl=__builtin_fmaxf(rm,0.f); mhat+=dl; \
        _Pragma("unroll") for(int r=0;r<16;++r){C0[r]-=dl;C1[r]-=dl;} \
        _Pragma("unroll") for(int r=0;r<16;++r)negm[r]=-mhat; asm volatile("":"+v"(negm)); \
        const float f=__builtin_amdgcn_exp2f(-dl); l_reg*=f; if(hi==0)wsf[r32]=f; resc=true; } } \
    SBAR(); \
    GAPB(o[0]=__builtin_amdgcn_mfma_f32_32x32x16_bf16(PAF(0),VFR(0),o[0],0,0,0), C0,0); \
    GAPB(o[1]=__builtin_amdgcn_mfma_f32_32x32x16_bf16(PAF(0),VFR(4),o[1],0,0,0), C0,4); \
    KRD(GL,0); GAPB(o[0]=__builtin_amdgcn_mfma_f32_32x32x16_bf16(PAF(1),VFR(1),o[0],0,0,0), C0,8); \
    KRD(GL,1); GAPB(o[1]=__builtin_amdgcn_mfma_f32_32x32x16_bf16(PAF(1),VFR(5),o[1],0,0,0), C0,12); \
    KRD(GL,2); GAPB(o[0]=__builtin_amdgcn_mfma_f32_32x32x16_bf16(PAF(2),VFR(2),o[0],0,0,0), C1,0); \
    KRD(GL,3); GAPB(o[1]=__builtin_amdgcn_mfma_f32_32x32x16_bf16(PAF(2),VFR(6),o[1],0,0,0), C1,4); \
    GAPB(o[0]=__builtin_amdgcn_mfma_f32_32x32x16_bf16(PAF(3),VFR(3),o[0],0,0,0), C1,8); \
    GAPB(o[1]=__builtin_amdgcn_mfma_f32_32x32x16_bf16(PAF(3),VFR(7),o[1],0,0,0), C1,12); \
    }while(0)
  int t=1;
  #undef CMASK
  #define CMASK(P0,P1,t) do{}while(0)
  for(;t+5<NT;t+=2){
    STEP(pB0,pB1,pA0,pA1,t,true,true,true);     WAIT_BAR(2); RESC(); ROT();
    STEP(pA0,pA1,pB0,pB1,t+1,true,true,true);   WAIT_BAR(2); RESC(); ROT();
  }
  #undef CMASK
  #define CMASK(P0,P1,t) do{}while(0)
  #define ENDW(tt) do{ if((tt)+3<NT){WAIT_BAR(2);} else if((tt)+2<NT){WAIT_BAR(1);} else {WAIT_BAR(0);} }while(0)
  for(;t+1<NT;t+=2){
    STEP(pB0,pB1,pA0,pA1,t,(t+3<NT),(t+1<NT),(t+1<NT));       ENDW(t);   RESC(); ROT();
    STEP(pA0,pA1,pB0,pB1,t+1,(t+4<NT),(t+2<NT),(t+2<NT));     ENDW(t+1); RESC(); ROT();
  }
  STEP(pB0,pB1,pA0,pA1,NT-1,false,false,false); RESC();
  { float sacc=pB0[0]+pB0[1]; _Pragma("unroll") for(int r=2;r<16;++r)sacc+=pB0[r]; _Pragma("unroll") for(int r=0;r<16;++r)sacc+=pB1[r]; l_reg+=sacc;
    pw0=(u32x4){PKW(pB0,0),PKW(pB0,2),PKW(pB0,4),PKW(pB0,6)};pw1=(u32x4){PKW(pB0,8),PKW(pB0,10),PKW(pB0,12),PKW(pB0,14)};pw2=(u32x4){PKW(pB1,0),PKW(pB1,2),PKW(pB1,4),PKW(pB1,6)};pw3=(u32x4){PKW(pB1,8),PKW(pB1,10),PKW(pB1,12),PKW(pB1,14)};
    SBAR(); pv(o,vb0+sl_cur,PAF(0),PAF(1),PAF(2),PAF(3)); }
  #undef PKW
  #undef PAF
  #undef VFR
  #undef PIN
  #undef MX3
  #undef GAPA
  #undef GAPB
  #undef EX
  #undef VRD
  #undef KRD
  #undef STEP
  #undef ENDW
  {auto rr=__builtin_amdgcn_permlane32_swap(__float_as_uint(l_reg),__float_as_uint(l_reg),false,false);l_reg=__uint_as_float(rr[0])+__uint_as_float(rr[1]);}
  if(hi==0)wsf[32+r32]=l_reg;asm volatile("s_waitcnt lgkmcnt(0)":::"memory");
  float rli[16];
  #pragma unroll
  for(int r=0;r<16;++r)rli[r]=__builtin_amdgcn_rcpf(wsf[32+crow(r,hi)]);
  bf16*Ow=Ou+(long)(wid*QBLK)*OP;
  { bf16*stg=(bf16*)(shm+LDS_OST)+wid*2048;
    #pragma unroll
    for(int r=0;r<16;++r){const int orow=crow(r,hi);
      #pragma unroll
      for(int d0=0;d0<2;++d0)stg[orow*64+d0*32+r32]=__float2bfloat16(o[d0][r]*rli[r]);}
    asm volatile("s_waitcnt lgkmcnt(0)":::"memory");
    #pragma unroll
    for(int i=0;i<4;++i){const int row=i*8+(lane>>3),ch=lane&7; const u32x4 v=*(const u32x4*)(stg+row*64+ch*8); ATTN_STORE16(Ow+(long)row*OP+ch*8,v);} }
  asm volatile("s_waitcnt lgkmcnt(0)\n\ts_barrier":::"memory");
  #undef DMA_K
  #undef DMA_V
  #undef CMASK
  #undef START
  #undef RESC
  #undef ROT
}
constexpr int ATTN_LDS_BYTES=LDS_BYTES;
#undef SBAR
#undef WAIT_BAR
}

__device__ __forceinline__ void ph_attn_dft(const Params& P, int bid, int nblk, unsigned char* smem, int with_ctx) {
    PG8_LAS unsigned char* lds = (PG8_LAS unsigned char*)smem; bf16_t* MIXb = (bf16_t*)(P.ws + OFF_MIX);
    const bool bal = (nblk == 256);
    { pg8::Gemm g{(const bf16_t*)(P.ws + OFF_ADFT), (const bf16_t*)(P.ws + OFF_ZTL), 4096, 4096}; pg8::DftSched S{nblk, bid, 0}; pg8::EpiRe8 E{MIXb, 0}; pg8::gemm_phase(lds, g, S, E); }
    if (with_ctx) { pg8::Gemm g{(const bf16_t*)(P.ws + OFF_ADFTC), (const bf16_t*)(P.ws + OFF_ZTC), 512, 512}; pg8::DftSched S{nblk, bal ? (bid >= 128 ? bid - 128 : 1 << 20) : bid, 1}; pg8::EpiRe8 E{MIXb, 1}; pg8::gemm_phase(lds, g, S, E); }
    __syncthreads();
    const attn_body::bf16* QR = (const attn_body::bf16*)(P.ws + OFF_QR); const attn_body::bf16* KA = (const attn_body::bf16*)(P.ws + OFF_KALL); const attn_body::bf16* VA = (const attn_body::bf16*)(P.ws + OFF_VALL);
    attn_body::bf16* MIX = (attn_body::bf16*)(P.ws + OFF_MIX);
    int start, cnt, stride, shortU;
    if (bal) { if (bid < 128) { start = 3 * ((bid & 7) * 16 + (bid >> 3)); cnt = 3; stride = 1; shortU = -1; }
               else { const int vj = (bid & 7) * 16 + ((bid - 128) >> 3); start = 384 + 5 * vj; cnt = 5; stride = 1; shortU = with_ctx ? 1024 + vj : -1; } }
    else { const int vcu = (nblk % 8 == 0) ? (bid % 8) * (nblk / 8) + bid / 8 : bid; const int nU = with_ctx ? 1152 : 1024; start = vcu; stride = nblk; cnt = vcu < nU ? (nU - 1 - vcu) / nblk + 1 : 0; shortU = -1; }
    for (int k = 0; k <= cnt; ++k) {
        const int U = k < cnt ? start + k * stride : shortU; if (U < 0) break;
        int b, h, qrow, krow, NTl;
        if (U < 1024) { b = U >> 6; h = (U >> 3) & 7; qrow = b * SEQ + (U & 7) * 256; krow = b * KV; NTl = KV / 64; }
        else { const int j = U - 1024; b = j >> 3; h = j & 7; qrow = NL + b * CTX; krow = b * KV + SEQ; NTl = CTX / 64; }
        attn_body::attn_unit<8>(QR + (size_t)qrow * 512 + h * 64, KA + (size_t)krow * 128 + (h >> 2) * 64, VA + (size_t)krow * 128 + (h >> 2) * 64, MIX + (size_t)qrow * D + 512 + h * 64, NTl, (char*)smem);
    }
}

#define XB_TMO      128
#define XB_XCNT(j)  (256  + 64 * (j))
#define XB_XSUB(j)  (1280 + 64 * (j))
#define XB_XGEN(j)  (2304 + 64 * (j))
#define XB_TOP      3328
#define XB_TOPGEN   3392
#define XCD_BAR_WORDS 3456
#define XB_SPIN_CAP (1u << 18)
#define LAS __attribute__((address_space(3)))

__device__ __forceinline__ unsigned xb_ld(unsigned* p)              { return __hip_atomic_load(p, __ATOMIC_RELAXED, __HIP_MEMORY_SCOPE_AGENT); }
__device__ __forceinline__ unsigned xb_add(unsigned* p, unsigned v) { return __hip_atomic_fetch_add(p, v, __ATOMIC_RELAXED, __HIP_MEMORY_SCOPE_AGENT); }
__device__ __forceinline__ unsigned xb_xcc_id() { return (unsigned)__builtin_amdgcn_s_getreg((3 << 11) | 20) & 0xFu; }
#define XB_SPIN(cond, bar) do { unsigned _sp = 0; while (cond) { __builtin_amdgcn_s_sleep(1); \
    if ((++_sp & 255u) == 0u) { if (xb_ld(&(bar)[XB_TMO])) break; if (_sp > XB_SPIN_CAP) { atomicAdd(&(bar)[XB_TMO], 1u); break; } } } } while (0)

struct XcdBarrier {
    unsigned* bar; unsigned x;
    volatile LAS unsigned* st;
};
__device__ __forceinline__ XcdBarrier xcd_barrier_post(unsigned* bar, volatile LAS unsigned* st) {
    XcdBarrier b; b.bar = bar; b.x = xb_xcc_id(); b.st = st;
    if (threadIdx.x == 0) (void)xb_add(&bar[XB_XCNT(b.x)], 1u);
    return b;
}
__device__ __forceinline__ void xcd_barrier_complete(unsigned* bar, unsigned x, unsigned& nloc, unsigned& nx) {
    const unsigned G = gridDim.x * gridDim.y * gridDim.z;
    unsigned sum, cnt, mine, sp = 0u;
    for (;;) {
        sum = 0u; cnt = 0u; mine = 0u;
#pragma unroll
        for (unsigned j = 0; j < 16; ++j) { const unsigned c = xb_ld(&bar[XB_XCNT(j)]); sum += c; cnt += (c > 0u) ? 1u : 0u; mine = (j == x) ? c : mine; }
        if (sum == G) break;
        __builtin_amdgcn_s_sleep(1);
        if ((++sp & 255u) == 0u) { if (xb_ld(&bar[XB_TMO])) break; if (sp > XB_SPIN_CAP) { atomicAdd(&bar[XB_TMO], 1u); break; } }
    }
    nloc = mine > 0u ? mine : 1u; nx = cnt > 0u ? cnt : 1u;
}
__device__ __forceinline__ void xcd_barrier(const XcdBarrier& b) {
    asm volatile("s_waitcnt vmcnt(0)" ::: "memory");
    __syncthreads();
    if (threadIdx.x == 0) {
        unsigned* bar = b.bar; const unsigned bx = xb_xcc_id();
        __builtin_amdgcn_s_waitcnt(0);
        unsigned nloc = b.st[0], nx = b.st[1];
        if (nloc == 0u) { xcd_barrier_complete(bar, bx, nloc, nx); b.st[0] = nloc; b.st[1] = nx; }
        const unsigned old = xb_add(&bar[XB_XSUB(bx)], 1u);
        const unsigned gen = old / nloc;
        if (old + 1u == (gen + 1u) * nloc) {
            __builtin_amdgcn_fence(__ATOMIC_RELEASE, "agent");
            asm volatile("s_waitcnt vmcnt(0)" ::: "memory");
            const unsigned og = xb_add(&bar[XB_TOP], 1u);
            const unsigned tg = og / nx;
            if (og + 1u == (tg + 1u) * nx) xb_add(&bar[XB_TOPGEN], 1u);
            else XB_SPIN(xb_ld(&bar[XB_TOPGEN]) == tg, bar);
            __builtin_amdgcn_fence(__ATOMIC_ACQUIRE, "agent");
            xb_add(&bar[XB_XGEN(bx)], 1u);
            asm volatile("s_waitcnt vmcnt(0)" ::: "memory");
        } else {
            XB_SPIN(xb_ld(&bar[XB_XGEN(bx)]) == gen, bar);
            __builtin_amdgcn_fence(__ATOMIC_ACQUIRE, "agent");
            asm volatile("s_waitcnt vmcnt(0)" ::: "memory");
        }
    }
    __syncthreads();
}

constexpr int LDS_BYTES = 147456;
constexpr int MISC_OFF = 131072 + 320;

__global__ void __launch_bounds__(512, 2) mega_fwd(Params P) {
    extern __shared__ __attribute__((aligned(16))) unsigned char smem[];
    const int bid = blockIdx.x, nblk = gridDim.x;
    for (int u = threadIdx.x; u < (LDS_BYTES - 131072) / 4; u += 512) ((LAS unsigned*)((LAS unsigned char*)smem + 131072))[u] = 0u;
    __syncthreads();
    for (int u = threadIdx.x; u < 1024; u += 512) ((LAS unsigned char*)smem)[SIGLUT_OFF + u] = (unsigned char)__builtin_rintf(255.0f * sigmoidf_((float)(u - 512) * (1.0f / 64.0f)));
    __syncthreads();
    XcdBarrier bar = xcd_barrier_post((unsigned*)(P.ws + OFF_CTL), (volatile LAS unsigned*)((LAS unsigned char*)smem + MISC_OFF) + 8);
    float* ldsf = (float*)smem;
#define GASQ __attribute__((address_space(1)))
#define LND(m) Q.m = (decltype(Q.m))((const char*)Q.m + z_)
#ifndef DUPM
#define DUPM 0
#endif
#define DUP(bit, call) do { call; if (DUPM & (1 << (bit))) { call; } } while (0)
#define PH(call) do { Params Q = P; long z_ = 0; asm volatile("" : "+s"(z_)); LND(ws); LND(out); LND(x); LND(c); LND(ctx); LND(c_ctx); LND(ada_w); LND(ada_b); LND(norm_mix); LND(w_in); LND(fourier_w); LND(pool_w); LND(pool_scale); LND(pool_proj); \
        LND(q_norm); LND(k_norm); LND(attn_proj); LND(w_out); LND(norm_ffn); LND(peer_wq); LND(peer_keys); LND(peer_u); LND(peer_v); call; } while (0)
    for (int rep = 0; rep < ((DUPM & (1 << 11)) ? 2 : 1); ++rep) {
    PH(ph_mod(Q, bid, nblk, ldsf)); PH(ph_tables(Q, bid, nblk)); PH(ph_wtrans(Q, bid, nblk, ldsf)); PH(ph_wft(Q, bid, nblk, ldsf)); PH(ph_wg8(Q, bid, nblk, ldsf)); PH(ph_wpool(Q, bid, nblk, ldsf)); PH(ph_wst(Q, bid, nblk, 0, 1)); PH(ph_peer_cvt(Q, bid, nblk, 0, 1));
    }
    xcd_barrier(bar);
#pragma unroll 1
    for (int l = 0; l < DEPTH; ++l) {
        const int ntok = (l == DEPTH - 1) ? NL : NT;
        DUP(0, PH(ph_norm(Q, l, 0, NT, bid, nblk, l == 0)));      xcd_barrier(bar);
        DUP(1, PH(ph_gemm1_pg(Q, l, bid, nblk, smem)));        xcd_barrier(bar);
        {
            const bool withz = l < DEPTH - 1, split = withz && nblk > 64;
            const int zc = split ? bid : bid, zG = split ? (1 << 20) : nblk;
            if (withz && (split ? bid < 32 : true)) { PH(ph_gemm1_ctxz(Q, l, zc, zG, smem)); }
            if (!split || bid >= 32) { PH(ph_l3(Q, l, split ? bid - 32 : bid, split ? nblk - 32 : nblk)); }
        }
        xcd_barrier(bar);
        DUP(3, PH(ph_attn_dft(Q, bid, nblk, smem, l < DEPTH - 1)));      xcd_barrier(bar);
        DUP(4, PH(ph_merge_pg(Q, l, ntok, bid, nblk, smem)));
        if (l < DEPTH - 1) {
            if (nblk == 256) { if (bid >= 64) { PH(ph_peer_cvt(Q, bid - 64, 192, l + 1, l + 2, 0, 1)); PH(ph_wst(Q, bid - 64, 192, l + 1, l + 2)); } }
            else { PH(ph_peer_cvt(Q, bid, nblk, l + 1, l + 2)); PH(ph_wst(Q, bid, nblk, l + 1, l + 2)); }
        }
        xcd_barrier(bar);
        PH(ph_out_pg(Q, l, ntok, bid, nblk, smem));          xcd_barrier(bar);
        DUP(5, PH(ph_norm(Q, l, 1, ntok, bid, nblk)));      xcd_barrier(bar);
        DUP(6, PH(ph_score_pg(Q, l, ntok, bid, nblk, smem)));        xcd_barrier(bar);
        DUP(7, PH(ph_topk(Q, ntok, bid, nblk, smem)));
        if (l < DEPTH - 1 && nblk == 256 && bid >= 64) { PH(ph_peer_cvt(Q, bid - 64, 192, l + 1, l + 2, 1, 2)); }
        xcd_barrier(bar);
        DUP(8, PH(ph_peer_u(Q, l, ntok, bid, nblk)));    xcd_barrier(bar);
        DUP(9, PH(ph_peer_a(Q, ntok, bid, nblk)));       xcd_barrier(bar);
        PH(ph_peer_v(Q, l, ntok, bid, nblk)); if (DUPM & (1 << 10)) { PH(ph_peer_v(Q, l, ntok, bid, nblk, true)); }   xcd_barrier(bar);
    }
#undef PH
#undef DUP
#undef LND
#undef GASQ
}

extern "C" void kernel_launch(void* const* d_in, const int* in_sizes, int n_in, void* d_out, int out_size, void* d_ws, size_t ws_size, hipStream_t stream) {
    static int grid = 0;
    if (grid == 0) {
        if (n_in != 21 || ws_size < WS_END) { grid = -1; return; }
        int dev = 0, cus = 0, per_cu = 0;
        if (hipGetDevice(&dev) != hipSuccess || hipDeviceGetAttribute(&cus, hipDeviceAttributeMultiprocessorCount, dev) != hipSuccess) { grid = -1; return; }
        if (hipFuncSetAttribute((const void*)mega_fwd, hipFuncAttributeMaxDynamicSharedMemorySize, LDS_BYTES) != hipSuccess) { grid = -1; return; }
        if (hipOccupancyMaxActiveBlocksPerMultiprocessor(&per_cu, (const void*)mega_fwd, 512, LDS_BYTES) != hipSuccess || per_cu < 1) { (void)hipGetLastError(); }
        grid = (cus / 8) * 8;
    }
    if (grid < 0) return;
    (void)hipMemsetAsync((char*)d_ws + OFF_CTL, 0, 65536, stream);
    Params P{};
    const float** f = (const float**)&P;
    for (int i = 0; i < 21; ++i) f[i] = (const float*)d_in[i];
    P.out = (float*)d_out; P.ws = (unsigned char*)d_ws;
    hipLaunchKernelGGL(mega_fwd, dim3(grid), dim3(512), LDS_BYTES, stream, P);
}
```

```cpp
#include <hip/hip_runtime.h>
#include <stdint.h>
#include <hip/hip_bf16.h>
#include <cmath>

typedef unsigned short bf16_t;
typedef short bf16x8 __attribute__((ext_vector_type(8)));
typedef float f32x4 __attribute__((ext_vector_type(4)));
typedef float f32x16 __attribute__((ext_vector_type(16)));
typedef unsigned u32x4 __attribute__((ext_vector_type(4)));
typedef unsigned u32x2 __attribute__((ext_vector_type(2)));
typedef float f32x2_t __attribute__((ext_vector_type(2)));
typedef __bf16 bf16x2_t __attribute__((ext_vector_type(2)));
typedef int i32x8 __attribute__((ext_vector_type(8)));
typedef int i32x4_ __attribute__((ext_vector_type(4)));
constexpr int SIGLUT_OFF = 131072 + 1024;
constexpr float G8_SCALE = 64.0f;

constexpr int D = 1024, NB = 16, SEQ = 2048, DEPTH = 4, CTX = 256;
constexpr int NL = NB * SEQ, NC = NB * CTX, NT = NL + NC;
constexpr int INC = 4352;
constexpr int KV = SEQ + CTX;
constexpr int NEXP = 16384;
constexpr float C2 = 0.125f * 1.4426950408889634f;
constexpr float EPS = 1e-6f;

constexpr size_t MiB = 1u << 20;
constexpr size_t OFF_CTL = 0;
constexpr size_t OFF_MOD = 1 * MiB;
constexpr size_t OFF_SC = 3 * MiB + 512 * 1024;
constexpr size_t OFF_ROPE = 3 * MiB;
constexpr size_t OFF_XC = 4 * MiB;
constexpr size_t OFF_HB = 20 * MiB;
constexpr size_t OFF_MIX = 92 * MiB;
constexpr size_t OFF_KALL = 164 * MiB;
constexpr size_t OFF_VALL = 173 * MiB;
constexpr size_t OFF_EID = 182 * MiB;
constexpr size_t OFF_GW = 200 * MiB;
constexpr size_t OFF_GT = 218 * MiB;
constexpr size_t OFF_QR = 434 * MiB;
constexpr size_t OFF_ZTL = 470 * MiB;
constexpr size_t OFF_ZTC = 502 * MiB;
constexpr size_t OFF_PP = 506 * MiB;
constexpr size_t OFF_ST = 218 * MiB;
constexpr size_t OFF_W1T = 524 * MiB;
constexpr size_t OFF_WFT = 556 * MiB;
constexpr size_t OFF_WMT = 560 * MiB;
constexpr size_t OFF_WOT = 568 * MiB;
constexpr size_t OFF_WST = 576 * MiB;
constexpr size_t OFF_ADFT = 592 * MiB;
constexpr size_t OFF_ADFTC = 608 * MiB;
constexpr size_t OFF_PU = 609 * MiB;
constexpr size_t OFF_PV = 737 * MiB;
constexpr size_t OFF_WG8 = 866 * MiB;
constexpr size_t OFF_HB8 = 880 * MiB;
constexpr size_t WS_END = 916 * MiB;

struct Params {
    const float *x, *c, *ctx, *c_ctx, *ada_w, *ada_b, *norm_mix, *w_in, *fourier_w, *pool_w, *pool_scale, *pool_proj, *q_norm, *k_norm,
        *attn_proj, *w_out, *norm_ffn, *peer_wq, *peer_keys, *peer_u, *peer_v;
    float* out;
    unsigned char* ws;
};

__device__ __forceinline__ unsigned pk_bf16(float lo, float hi) { f32x2_t v = {lo, hi}; bf16x2_t b = __builtin_convertvector(v, bf16x2_t); return __builtin_bit_cast(unsigned, b); }
__device__ __forceinline__ float bf_lo(unsigned u) { return __uint_as_float(u << 16); }
__device__ __forceinline__ float bf_hi(unsigned u) { return __uint_as_float(u & 0xffff0000u); }
__device__ __forceinline__ float sigmoidf_(float x) { return __builtin_amdgcn_rcpf(1.0f + __expf(-x)); }
__device__ __forceinline__ float gelu_tanh(float x) { const float y = 0.7978845608028654f * (x + 0.044715f * x * x * x); const float t = 1.0f - 2.0f * __builtin_amdgcn_rcpf(1.0f + __expf(2.0f * y)); return 0.5f * x * (1.0f + t); }
template <int CTRL> __device__ __forceinline__ float dpp_f(float v) { return __builtin_bit_cast(float, __builtin_amdgcn_update_dpp(0, __builtin_bit_cast(int, v), CTRL, 0xF, 0xF, true)); }
#define DPP_F(v, ctrl) dpp_f<(ctrl)>(v)
__device__ __forceinline__ float xsum16(float v) { const unsigned u = __builtin_bit_cast(unsigned, v); auto r = __builtin_amdgcn_permlane16_swap(u, u, false, false); return __builtin_bit_cast(float, (unsigned)r[0]) + __builtin_bit_cast(float, (unsigned)r[1]); }
__device__ __forceinline__ float xsum32(float v) { const unsigned u = __builtin_bit_cast(unsigned, v); auto r = __builtin_amdgcn_permlane32_swap(u, u, false, false); return __builtin_bit_cast(float, (unsigned)r[0]) + __builtin_bit_cast(float, (unsigned)r[1]); }
__device__ __forceinline__ float sum8(float v) { v += DPP_F(v, 0xB1); v += DPP_F(v, 0x4E); v += DPP_F(v, 0x141); return v; }
__device__ __forceinline__ float wave_sum(float v) { v = sum8(v); v += DPP_F(v, 0x140); v = xsum16(v); return xsum32(v); }
__device__ __forceinline__ int tidx() { int t = threadIdx.x; asm volatile("" : "+v"(t)); return t; }
__device__ __forceinline__ float dot2bf(unsigned a, unsigned b, float acc) { return __builtin_amdgcn_fdot2_f32_bf16(__builtin_bit_cast(bf16x2_t, a), __builtin_bit_cast(bf16x2_t, b), acc, false); }
__device__ __forceinline__ float dot8(u32x4 a, u32x4 b, float acc) {
    const unsigned a0 = a.x, a1 = a.y, a2 = a.z, a3 = a.w, b0 = b.x, b1 = b.y, b2 = b.z, b3 = b.w;
    acc = dot2bf(a0, b0, acc); acc = dot2bf(a1, b1, acc); acc = dot2bf(a2, b2, acc); acc = dot2bf(a3, b3, acc);
    return acc;
}
__device__ __forceinline__ float* xrow_ptr(const Params& P, int row) { return row < NL ? P.out + (size_t)row * D : (float*)(P.ws + OFF_XC) + (size_t)(row - NL) * D; }
__device__ __forceinline__ int mod_r(int row) { return row < NL ? (row >> 11) : 16; }
__device__ __forceinline__ const float* mod_ptr(const Params& P, int l, int r, int j) { return (const float*)(P.ws + OFF_MOD) + ((size_t)(l * 17 + r) * 6 + j) * D; }
__device__ __forceinline__ int kv_row(int row) { return row < NL ? (row >> 11) * KV + (row & 2047) : ((row - NL) >> 8) * KV + SEQ + ((row - NL) & 255); }

__device__ __forceinline__ void ph_tables(const Params& P, int bid, int nblk) {
    const int TID = tidx();
    float* rc = (float*)(P.ws + OFF_ROPE); float* rs = rc + SEQ * 32;
    for (int i = bid * 512 + TID; i < SEQ * 32; i += nblk * 512) {
        const int t = i >> 5, f = i & 31; const float pos = (float)(f < 16 ? (t >> 6) : (t & 63));
        const float inv = powf(10000.0f, -(float)(f & 15) / 16.0f); const float ang = pos * inv;
        float s, c; sincosf(ang, &s, &c); rc[i] = c; rs[i] = s;
    }
    bf16_t* A = (bf16_t*)(P.ws + OFF_ADFT);
    for (size_t i = (size_t)bid * 512 + TID; i < (size_t)2048 * 2048; i += (size_t)nblk * 512) {
        const int kp = (int)(i >> 11), t = (int)(i & 2047); const int m = (kp * t) & 2047;
        float s, c; sincospif((float)m * (1.0f / 1024.0f), &s, &c);
        A[(size_t)kp * 4096 + t] = (bf16_t)(pk_bf16(c, 0.f) & 0xffff); A[(size_t)kp * 4096 + 2048 + t] = (bf16_t)(pk_bf16(-s, 0.f) & 0xffff);
    }
    bf16_t* Ac = (bf16_t*)(P.ws + OFF_ADFTC);
    for (int i = bid * 512 + TID; i < 256 * 256; i += nblk * 512) {
        const int kp = i >> 8, t = i & 255; const int m = (kp * t) & 255;
        float s, c; sincospif((float)m * (1.0f / 128.0f), &s, &c);
        Ac[kp * 512 + t] = (bf16_t)(pk_bf16(c, 0.f) & 0xffff); Ac[kp * 512 + 256 + t] = (bf16_t)(pk_bf16(-s, 0.f) & 0xffff);
    }
}
__device__ __forceinline__ void ph_mod(const Params& P, int bid, int nblk, float* lds) {
    const int TID = tidx();
    const int tid = TID, c4 = tid & 7, ks = tid >> 3, lane = tid & 63, wid = tid >> 6;
    float* mod = (float*)(P.ws + OFF_MOD);
    float* lsc = lds;
    float* red = lds + 17 * D;
    __syncthreads();
    for (int i = tid; i < 17 * D; i += 512) { const float v = i < 16 * D ? P.c[i] : P.c_ctx[i - 16 * D]; lsc[i] = v * sigmoidf_(v); }
    __syncthreads();
    for (int u = bid; u < DEPTH * 192; u += nblk) {
        const int l = u / 192;
        f32x4 acc[17];
#pragma unroll
        for (int r = 0; r < 17; ++r) acc[r] = (f32x4){0.f, 0.f, 0.f, 0.f};
        const float* w = P.ada_w + ((size_t)l * D + ks * 16) * 6144 + (u % 192) * 32 + c4 * 4;
        f32x4 wv[16];
#pragma unroll
        for (int q = 0; q < 16; ++q) wv[q] = *(const f32x4*)(w + (size_t)q * 6144);
#pragma unroll
        for (int q4 = 0; q4 < 4; ++q4)
#pragma unroll
            for (int r = 0; r < 17; ++r) { const f32x4 cc = *(const f32x4*)(lsc + r * D + ks * 16 + 4 * q4);
                acc[r] += cc.x * wv[4 * q4] + cc.y * wv[4 * q4 + 1] + cc.z * wv[4 * q4 + 2] + cc.w * wv[4 * q4 + 3]; }
#pragma unroll
        for (int r = 0; r < 17; ++r)
#pragma unroll
            for (int e = 0; e < 4; ++e) { float v = acc[r][e]; v += dpp_f<0x128>(v);
                auto sw = __builtin_amdgcn_permlane16_swap(__builtin_bit_cast(unsigned, v), __builtin_bit_cast(unsigned, v), false, false);
                acc[r][e] = __builtin_bit_cast(float, (unsigned)sw[0]) + __builtin_bit_cast(float, (unsigned)sw[1]); }
        __syncthreads();
        if ((lane & 24) == 0) { const int g = wid * 2 + (lane >> 5);
#pragma unroll
            for (int r = 0; r < 17; ++r) *(f32x4*)(red + (g * 17 + r) * 32 + c4 * 4) = acc[r]; }
        __syncthreads();
        for (int i = tid; i < 17 * 32; i += 512) { const int r = i >> 5, c = i & 31; float sum = 0.f;
#pragma unroll
            for (int q = 0; q < 16; ++q) sum += red[(q * 17 + r) * 32 + c];
            const int jj = (u % 192) * 32 + c; mod[(size_t)(l * 17 + r) * 6144 + jj] = sum + P.ada_b[l * 6144 + jj]; }
    }
}
__device__ __forceinline__ void tr_cvt_tile_w(const float* src, int ldn, bf16_t* dst, int ldk, int N, int tile, float* lw, int lane) {
    const int tn = N / 64; const int k0 = (tile / tn) * 32, n0 = (tile % tn) * 64;
    float v[32];
#pragma unroll
    for (int kk = 0; kk < 32; ++kk) v[kk] = src[(size_t)(k0 + kk) * ldn + n0 + lane];
#pragma unroll
    for (int kk = 0; kk < 32; ++kk) lw[kk * 65 + lane] = v[kk];
    asm volatile("s_waitcnt lgkmcnt(0)" ::: "memory");
#pragma unroll
    for (int it = 0; it < 4; ++it) { const int row = it * 16 + (lane >> 2), ch = (lane & 3) * 8; u32x4 o;
        o.x = pk_bf16(lw[(ch + 0) * 65 + row], lw[(ch + 1) * 65 + row]); o.y = pk_bf16(lw[(ch + 2) * 65 + row], lw[(ch + 3) * 65 + row]);
        o.z = pk_bf16(lw[(ch + 4) * 65 + row], lw[(ch + 5) * 65 + row]); o.w = pk_bf16(lw[(ch + 6) * 65 + row], lw[(ch + 7) * 65 + row]);
        *(u32x4*)(dst + (size_t)(n0 + row) * ldk + k0 + ch) = o; }
    asm volatile("s_waitcnt lgkmcnt(0)" ::: "memory");
}
__device__ __forceinline__ void ph_wtrans(const Params& P, int bid, int nblk, float* lds) {
    const int TID = tidx(); const int wid = __builtin_amdgcn_readfirstlane(TID >> 6), lane = TID & 63;
    float* lw = lds + wid * (32 * 65);
    __syncthreads();
    for (int u = bid * 8 + wid; u < DEPTH * 2944; u += nblk * 8) {
        const int l = u / 2944; int t = u % 2944;
        if (t < 2048) tr_cvt_tile_w(P.w_in + (size_t)l * D * INC + 256, INC, (bf16_t*)(P.ws + OFF_W1T) + (size_t)l * 4096 * D, D, 4096, t, lw, lane);
        else if (t < 2560) tr_cvt_tile_w(P.w_out + (size_t)l * D * D, D, (bf16_t*)(P.ws + OFF_WOT) + (size_t)l * D * D, D, D, t - 2048, lw, lane);
        else if (t < 2688) tr_cvt_tile_w(P.fourier_w + (size_t)l * 256 * D, D, (bf16_t*)(P.ws + OFF_WMT) + (size_t)l * D * D, D, D, t - 2560, lw, lane);
        else tr_cvt_tile_w(P.attn_proj + (size_t)l * 512 * D, D, (bf16_t*)(P.ws + OFF_WMT) + (size_t)l * D * D + 512, D, D, t - 2688, lw, lane);
    }
    __syncthreads();
}
__device__ __forceinline__ void ph_wft(const Params& P, int bid, int nblk, float* lds) {
    const int TID = tidx();
    const int tid = TID, lane = TID & 63, r = lane & 31, hi = lane >> 5; const int wid = __builtin_amdgcn_readfirstlane(TID >> 6);
    __syncthreads();
    if (tid < 64) { float s, c; sincospif((float)tid * (1.0f / 32.0f), &s, &c); lds[tid] = c; lds[64 + tid] = s; }
    __syncthreads();
    bf16_t* W = (bf16_t*)(P.ws + OFF_WFT);
    for (int u = bid * 8 + wid; u < DEPTH * 512; u += nblk * 8) {
        const int kt = u & 31, jt = (u >> 5) & 1, part = (u >> 6) & 1, g = (u >> 7) & 3, l = u >> 9;
        const float* tab = lds + part * 64; const int j = jt * 32 + r;
        const float* bp = P.w_in + ((size_t)l * D + kt * 32 + r) * INC + g * 64;
        f32x4 bv[16];
#pragma unroll
        for (int q = 0; q < 16; ++q) bv[q] = *(const f32x4*)(bp + 4 * q);
        f32x16 acc;
#pragma unroll
        for (int q = 0; q < 16; ++q) acc[q] = 0.f;
#pragma unroll
        for (int s2 = 0; s2 < 32; ++s2) { const float a = tab[((2 * s2 + hi) * j) & 63]; const f32x4 b4 = bv[s2 >> 1];
            const float bb = (s2 & 1) ? (hi ? b4.w : b4.z) : (hi ? b4.y : b4.x);
            acc = __builtin_amdgcn_mfma_f32_32x32x2f32(a, bb, acc, 0, 0, 0); }
#pragma unroll
        for (int q = 0; q < 16; ++q) { const int jj = jt * 32 + 8 * (q >> 2) + 4 * hi + (q & 3);
            W[((size_t)l * 512 + part * 256 + g * 64 + jj) * D + kt * 32 + r] = (bf16_t)(pk_bf16(acc[q], 0.f) & 0xffff); }
    }
    __syncthreads();
}
__device__ __forceinline__ unsigned pk_fp8x4(float a, float b, float c, float d) { int w = __builtin_amdgcn_cvt_pk_fp8_f32(a, b, 0, false); w = __builtin_amdgcn_cvt_pk_fp8_f32(c, d, w, true); return (unsigned)w; }
__device__ __forceinline__ void ph_wg8(const Params& P, int bid, int nblk, float* lds) {
    const int TID = tidx(); const int wid = __builtin_amdgcn_readfirstlane(TID >> 6), lane = TID & 63;
    float* lw = lds + wid * (32 * 65);
    __syncthreads();
    for (int u = bid * 8 + wid; u < DEPTH * 1536; u += nblk * 8) {
        const int l = u / 1536, t = u % 1536; const int k0 = (t / 48) * 32, n0 = (t % 48) * 64;
        const float* src = P.w_in + (size_t)l * D * INC + 1280; unsigned char* dst = P.ws + OFF_WG8 + (size_t)l * 3072 * D;
        float v[32];
#pragma unroll
        for (int kk = 0; kk < 32; ++kk) v[kk] = src[(size_t)(k0 + kk) * INC + n0 + lane];
#pragma unroll
        for (int kk = 0; kk < 32; ++kk) lw[kk * 65 + lane] = v[kk] * G8_SCALE;
        asm volatile("s_waitcnt lgkmcnt(0)" ::: "memory");
#pragma unroll
        for (int it = 0; it < 2; ++it) { const int row = it * 32 + (lane >> 1), ch = (lane & 1) * 16; u32x4 o;
            o.x = pk_fp8x4(lw[(ch + 0) * 65 + row], lw[(ch + 1) * 65 + row], lw[(ch + 2) * 65 + row], lw[(ch + 3) * 65 + row]);
            o.y = pk_fp8x4(lw[(ch + 4) * 65 + row], lw[(ch + 5) * 65 + row], lw[(ch + 6) * 65 + row], lw[(ch + 7) * 65 + row]);
            o.z = pk_fp8x4(lw[(ch + 8) * 65 + row], lw[(ch + 9) * 65 + row], lw[(ch + 10) * 65 + row], lw[(ch + 11) * 65 + row]);
            o.w = pk_fp8x4(lw[(ch + 12) * 65 + row], lw[(ch + 13) * 65 + row], lw[(ch + 14) * 65 + row], lw[(ch + 15) * 65 + row]);
            *(u32x4*)(dst + (size_t)(n0 + row) * D + k0 + ch) = o; }
        asm volatile("s_waitcnt lgkmcnt(0)" ::: "memory");
    }
    __syncthreads();
}
__device__ __forceinline__ void ph_wpool(const Params& P, int bid, int nblk, float* lds) {
    const int TID = tidx();
    bf16_t* W = (bf16_t*)(P.ws + OFF_WMT);
    for (int u = bid; u < DEPTH * 4 * 16; u += nblk) {
        const int nc = u & 15, g = (u >> 4) & 3, l = u >> 6; const int n = nc * 64 + (TID & 63), c0 = (TID >> 6) * 8;
        __syncthreads();
        for (int i = TID; i < 64 * 64; i += 512) lds[i] = P.pool_w[(size_t)(l * 4 + g) * 4096 + i];
        __syncthreads();
        float pr[64];
#pragma unroll
        for (int e = 0; e < 64; ++e) pr[e] = P.pool_proj[((size_t)l * 256 + g * 64 + e) * D + n] * P.pool_scale[l * 256 + g * 64 + e];
        float a[8];
#pragma unroll
        for (int c = 0; c < 8; ++c) { a[c] = 0.f;
#pragma unroll
            for (int e = 0; e < 64; ++e) a[c] += lds[(c0 + c) * 64 + e] * pr[e]; }
        u32x4 o; o.x = pk_bf16(a[0], a[1]); o.y = pk_bf16(a[2], a[3]); o.z = pk_bf16(a[4], a[5]); o.w = pk_bf16(a[6], a[7]);
        *(u32x4*)(W + ((size_t)l * D + n) * D + 256 + g * 64 + c0) = o;
    }
}
__device__ __forceinline__ void ph_wst(const Params& P, int bid, int nblk, int l0, int l1) {
    const int TID = tidx();
    bf16_t* W = (bf16_t*)(P.ws + OFF_WST);
    const int wid = __builtin_amdgcn_readfirstlane(TID >> 6), lane = TID & 63, r = lane & 31, hi = lane >> 5;
    for (int u = l0 * 2048 + bid * 8 + wid; u < l1 * 2048; u += nblk * 8) {
        const int kt = u & 31, jt = (u >> 5) & 3, hp = (u >> 7) & 15, l = u >> 11;
        const float* ap = P.peer_keys + ((size_t)(l * 16 + hp) * 128 + jt * 32 + r) * 128;
        const float* bp = P.peer_wq + ((size_t)l * D + kt * 32 + r) * 2048 + hp * 128;
        f32x16 acc;
#pragma unroll
        for (int q = 0; q < 16; ++q) acc[q] = 0.f;
#pragma unroll 1
        for (int q0 = 0; q0 < 32; q0 += 8) { f32x4 av[8], bv[8];
#pragma unroll
            for (int q = 0; q < 8; ++q) { av[q] = *(const f32x4*)(ap + 4 * (q0 + q)); bv[q] = *(const f32x4*)(bp + 4 * (q0 + q)); }
#pragma unroll
            for (int q = 0; q < 8; ++q) {
                acc = __builtin_amdgcn_mfma_f32_32x32x2f32(hi ? av[q].y : av[q].x, hi ? bv[q].y : bv[q].x, acc, 0, 0, 0);
                acc = __builtin_amdgcn_mfma_f32_32x32x2f32(hi ? av[q].w : av[q].z, hi ? bv[q].w : bv[q].z, acc, 0, 0, 0); } }
#pragma unroll
        for (int q = 0; q < 16; ++q) { const int j = jt * 32 + 8 * (q >> 2) + 4 * hi + (q & 3);
            W[((size_t)l * 2048 + hp * 128 + j) * D + kt * 32 + r] = (bf16_t)(pk_bf16(acc[q], 0.f) & 0xffff); }
    }
}
constexpr float U_SCALE = 64.0f, V_SCALE = 8.0f;
__device__ __forceinline__ void ph_peer_cvt(const Params& P, int bid, int nblk, int l0, int l1, int w0 = 0, int w1 = 2) {
    const int TID = tidx();
    const size_t per = (size_t)NEXP * D / 16, nbeg = (size_t)l0 * per, n16 = (size_t)l1 * per;
    for (int w = w0; w < w1; ++w) {
        const f32x4* s = (const f32x4*)(w ? P.peer_v : P.peer_u); unsigned char* d = P.ws + (w ? OFF_PV : OFF_PU); const float sc = w ? V_SCALE : U_SCALE;
        for (size_t i = nbeg + (size_t)bid * 512 + TID; i < n16; i += (size_t)nblk * 512) {
            const f32x4 a = __builtin_nontemporal_load(s + 4 * i), b = __builtin_nontemporal_load(s + 4 * i + 1), c = __builtin_nontemporal_load(s + 4 * i + 2), e4 = __builtin_nontemporal_load(s + 4 * i + 3);
            u32x4 o; o.x = pk_fp8x4(a.x * sc, a.y * sc, a.z * sc, a.w * sc); o.y = pk_fp8x4(b.x * sc, b.y * sc, b.z * sc, b.w * sc); o.z = pk_fp8x4(c.x * sc, c.y * sc, c.z * sc, c.w * sc); o.w = pk_fp8x4(e4.x * sc, e4.y * sc, e4.z * sc, e4.w * sc);
            const size_t row = i >> 6; const int c16 = (int)(i & 63);
            const size_t l = row >> 14, e = row & (NEXP - 1);
            *(u32x4*)(d + (((l * 8 + (c16 >> 3)) * NEXP + e) * 128 + (c16 & 7) * 16)) = o; }
    }
}

__device__ __forceinline__ void ph_norm(const Params& P, int l, int which, int nrows, int bid, int nblk, const bool from_input = false) {
    const int TID = tidx();
    const int wid = __builtin_amdgcn_readfirstlane(TID >> 6), lane = TID & 63;
    const float* gain = (which ? P.norm_ffn : P.norm_mix) + l * D;
    bf16_t* HB = (bf16_t*)(P.ws + OFF_HB);
    f32x4 gg[4];
#pragma unroll
    for (int i = 0; i < 4; ++i) gg[i] = *(const f32x4*)(gain + i * 256 + lane * 4);
    const int stride = nblk * 8;
    for (int row0 = bid * 8 + wid; row0 < nrows; row0 += 2 * stride) {
        f32x4 v[2][4], sa[2][4], sb[2][4];
#pragma unroll
        for (int h = 0; h < 2; ++h) { const int row = min(row0 + h * stride, nrows - 1);
            const float* xr = from_input ? (row < NL ? P.x + (size_t)row * D : P.ctx + (size_t)(row - NL) * D) : xrow_ptr(P, row); const int r = mod_r(row);
            const float* sh = mod_ptr(P, l, r, which ? 3 : 0); const float* sc = mod_ptr(P, l, r, which ? 4 : 1);
#pragma unroll
            for (int i = 0; i < 4; ++i) { v[h][i] = *(const f32x4*)(xr + i * 256 + lane * 4); sa[h][i] = *(const f32x4*)(sc + i * 256 + lane * 4); sb[h][i] = *(const f32x4*)(sh + i * 256 + lane * 4); } }
        asm volatile("" : "+v"(v[0][0]), "+v"(v[0][1]), "+v"(v[0][2]), "+v"(v[0][3]), "+v"(v[1][0]), "+v"(v[1][1]), "+v"(v[1][2]), "+v"(v[1][3]));
#pragma unroll
        for (int h = 0; h < 2; ++h) { const int row = row0 + h * stride;
            float ss = 0.f;
#pragma unroll
            for (int i = 0; i < 4; ++i) ss += v[h][i].x * v[h][i].x + v[h][i].y * v[h][i].y + v[h][i].z * v[h][i].z + v[h][i].w * v[h][i].w;
            ss = wave_sum(ss); const float rstd = rsqrtf(ss * (1.0f / D) + EPS);
            if (row < nrows) {
#pragma unroll
                for (int i = 0; i < 4; ++i) { const int c = i * 256 + lane * 4; const f32x4 g = gg[i], a = sa[h][i], b = sb[h][i];
                    const float o0 = v[h][i].x * rstd * g.x * (1.f + a.x) + b.x, o1 = v[h][i].y * rstd * g.y * (1.f + a.y) + b.y, o2 = v[h][i].z * rstd * g.z * (1.f + a.z) + b.z, o3 = v[h][i].w * rstd * g.w * (1.f + a.w) + b.w;
                    u32x2 o; o.x = pk_bf16(o0, o1); o.y = pk_bf16(o2, o3); *(u32x2*)(HB + (size_t)row * D + c) = o;
                    if (!which) *(unsigned*)(P.ws + OFF_HB8 + (size_t)row * D + c) = pk_fp8x4(o0, o1, o2, o3); }
            }
        }
    }
}

__device__ __forceinline__ void ph_l3(const Params& P, int l, int bid, int nblk) {
    const int TID = tidx();
    const float* rc = (const float*)(P.ws + OFF_ROPE); const float* rs = rc + SEQ * 32;
    {
        const int sub = TID & 7; const bool hi_half = (sub & 2) != 0;
        const f32x4 gq0 = *(const f32x4*)(P.q_norm + l * 64 + sub * 8), gq1 = *(const f32x4*)(P.q_norm + l * 64 + sub * 8 + 4), gk0 = *(const f32x4*)(P.k_norm + l * 64 + sub * 8), gk1 = *(const f32x4*)(P.k_norm + l * 64 + sub * 8 + 4);
        const int stride = nblk * 64, NI = NT * 10;
        for (int i0 = (bid * 512 + TID) >> 3; i0 < NI; i0 += 4 * stride) {
            u32x4 vv[4]; f32x4 rc0[4], rc1[4], rs0[4], rs1[4]; bf16_t* pp[4];
#pragma unroll
            for (int b4 = 0; b4 < 4; ++b4) { const int i = min(i0 + b4 * stride, NI - 1); const int row = i / 10, slot = i - row * 10; const bool isq = slot < 8;
                pp[b4] = (isq ? (bf16_t*)(P.ws + OFF_QR) + (size_t)row * 512 + slot * 64 : (bf16_t*)(P.ws + OFF_KALL) + (size_t)kv_row(row) * 128 + (slot - 8) * 64) + sub * 8;
                vv[b4] = *(const u32x4*)pp[b4];
                const int tix = (row & 2047) * 32 + (sub >> 2) * 16 + (sub & 1) * 8;
                rc0[b4] = *(const f32x4*)(rc + tix); rc1[b4] = *(const f32x4*)(rc + tix + 4); rs0[b4] = *(const f32x4*)(rs + tix); rs1[b4] = *(const f32x4*)(rs + tix + 4); }
            asm volatile("" : "+v"(vv[0]), "+v"(vv[1]), "+v"(vv[2]), "+v"(vv[3]));
#pragma unroll
            for (int b4 = 0; b4 < 4; ++b4) { const int i = i0 + b4 * stride; const int ic = min(i, NI - 1); const int row = ic / 10, slot = ic - row * 10; const bool isq = slot < 8;
                const unsigned v0 = vv[b4].x, v1 = vv[b4].y, v2 = vv[b4].z, v3 = vv[b4].w;
                float x[8] = {bf_lo(v0), bf_hi(v0), bf_lo(v1), bf_hi(v1), bf_lo(v2), bf_hi(v2), bf_lo(v3), bf_hi(v3)};
                float ss = 0.f;
#pragma unroll
                for (int d = 0; d < 8; ++d) ss += x[d] * x[d];
                ss = sum8(ss);
                const float rstd = rsqrtf(ss * (1.0f / 64.0f) + EPS) * (isq ? C2 : 1.0f);
                const f32x4 g0 = isq ? gq0 : gk0, g1 = isq ? gq1 : gk1;
                x[0] *= rstd * g0.x; x[1] *= rstd * g0.y; x[2] *= rstd * g0.z; x[3] *= rstd * g0.w; x[4] *= rstd * g1.x; x[5] *= rstd * g1.y; x[6] *= rstd * g1.z; x[7] *= rstd * g1.w;
                {
                    const f32x4 c0 = rc0[b4], c1 = rc1[b4], s0 = rs0[b4], s1 = rs1[b4]; const bool lat = row < NL;
                    const float cc[8] = {c0.x, c0.y, c0.z, c0.w, c1.x, c1.y, c1.z, c1.w}, sn[8] = {s0.x, s0.y, s0.z, s0.w, s1.x, s1.y, s1.z, s1.w};
#pragma unroll
                    for (int d = 0; d < 8; ++d) { const float other = DPP_F(x[d], 0x4E);
                        const float r = hi_half ? (x[d] * cc[d] + other * sn[d]) : (x[d] * cc[d] - other * sn[d]); x[d] = lat ? r : x[d]; }
                }
                u32x4 o; o.x = pk_bf16(x[0], x[1]); o.y = pk_bf16(x[2], x[3]); o.z = pk_bf16(x[4], x[5]); o.w = pk_bf16(x[6], x[7]);
                if (i < NI) *(u32x4*)pp[b4] = o;
            }
        }
    }
    const bf16_t* PP = (const bf16_t*)(P.ws + OFF_PP); bf16_t* MIX = (bf16_t*)(P.ws + OFF_MIX);
    for (int i = bid * 512 + TID; i < NT * 32; i += nblk * 512) {
        const int row = i >> 5, ch = (i & 31) * 8, g = ch >> 6, win = 2 << g;
        int base, t, L; if (row < NL) { base = row & ~2047; t = row & 2047; L = SEQ; } else { base = NL + ((row - NL) & ~255); t = (row - NL) & 255; L = CTX; }
        const int lo = max(t - win / 2, 0), hi = min(t + win - win / 2, L);
        float s[8];
#pragma unroll
        for (int q = 0; q < 8; ++q) s[q] = 0.f;
        u32x4 wv[16];
#pragma unroll
        for (int k = 0; k < 16; ++k) wv[k] = *(const u32x4*)(PP + (size_t)(base + min(lo + k, hi - 1)) * 256 + ch);
#pragma unroll
        for (int k = 0; k < 16; ++k) { const float w = lo + k < hi ? 1.0f : 0.0f; const unsigned a0 = wv[k].x, a1 = wv[k].y, a2 = wv[k].z, a3 = wv[k].w;
            s[0] += w * bf_lo(a0); s[1] += w * bf_hi(a0); s[2] += w * bf_lo(a1); s[3] += w * bf_hi(a1); s[4] += w * bf_lo(a2); s[5] += w * bf_hi(a2); s[6] += w * bf_lo(a3); s[7] += w * bf_hi(a3); }
        const float inv = 1.0f / (float)(hi - lo); const u32x4 me = *(const u32x4*)(PP + (size_t)row * 256 + ch);
        u32x4 o; o.x = pk_bf16(s[0] * inv - bf_lo(me.x), s[1] * inv - bf_hi(me.x)); o.y = pk_bf16(s[2] * inv - bf_lo(me.y), s[3] * inv - bf_hi(me.y));
        o.z = pk_bf16(s[4] * inv - bf_lo(me.z), s[5] * inv - bf_hi(me.z)); o.w = pk_bf16(s[6] * inv - bf_lo(me.w), s[7] * inv - bf_hi(me.w));
        *(u32x4*)(MIX + (size_t)row * D + 256 + ch) = o;
    }
}

__device__ __forceinline__ int fkey(float v) { const int b = __float_as_int(v); return b ^ ((b >> 31) & 0x7fffffff); }
__device__ __forceinline__ float kval(int k) { return __int_as_float(k ^ ((k >> 31) & 0x7fffffff)); }
__device__ __forceinline__ float kval16(int k) { const int s = k >> 16; return __int_as_float((s ^ ((s >> 31) & 0x7fff)) << 16); }
#define CE_DESC(a, b) do { const int hi_ = max(a, b), lo_ = min(a, b); a = hi_; b = lo_; } while (0)
__device__ __forceinline__ void bitonic_merge16(int (&a)[16]) {
#pragma unroll
    for (int j = 8; j > 0; j >>= 1)
#pragma unroll
        for (int i = 0; i < 16; ++i) { const int l = i ^ j; if (l > i) CE_DESC(a[i], a[l]); }
}
__device__ __forceinline__ void bitonic_sort16(int (&a)[16]) {
#pragma unroll
    for (int k = 2; k <= 16; k <<= 1)
#pragma unroll
        for (int j = k >> 1; j > 0; j >>= 1)
#pragma unroll
            for (int i = 0; i < 16; ++i) { const int l = i ^ j; if (l > i) { if ((i & k) == 0 || k == 16) CE_DESC(a[i], a[l]); else CE_DESC(a[l], a[i]); } }
}
__device__ __forceinline__ void top16_merge(int (&run)[16], int (&c)[16]) {
    bitonic_sort16(c);
#pragma unroll
    for (int i = 0; i < 16; ++i) run[i] = max(run[i], c[15 - i]);
    bitonic_merge16(run);
}
__device__ __forceinline__ void ph_topk(const Params& P, int ntok, int bid, int nblk, unsigned char* lds) {
    const int TID = tidx();
    const int wid = __builtin_amdgcn_readfirstlane(TID >> 6), lane = TID & 63;
    const bf16_t* ST = (const bf16_t*)(P.ws + OFF_ST); unsigned* EID = (unsigned*)(P.ws + OFF_EID); float* GW = (float*)(P.ws + OFF_GW);
    unsigned char* myl = lds + TID * 36;
    for (int u = bid * 8 + wid; u < (ntok / 64) * 8; u += nblk * 8) {
        const int h = u & 7, tok = (u >> 3) * 64 + lane;
        int l1[16], l2[16];
        const bf16_t* s1 = ST + (size_t)(h * 256) * NT + tok; const bf16_t* s2 = s1 + (size_t)128 * NT;
        unsigned fa[16], fb[16];
#pragma unroll
        for (int q = 0; q < 16; ++q) { fa[q] = s1[(size_t)q * NT]; fb[q] = s2[(size_t)q * NT]; }
#pragma unroll 1
        for (int j0 = 0; j0 < 128; j0 += 16) {
            int a[16], b[16];
#pragma unroll
            for (int q = 0; q < 16; ++q) { a[q] = (int)((fa[q] << 16) | (unsigned)(127 - (j0 + q))); b[q] = (int)((fb[q] << 16) | (unsigned)(127 - (j0 + q))); }
            const int jn = j0 + 16 < 128 ? j0 + 16 : j0;
#pragma unroll
            for (int q = 0; q < 16; ++q) { fa[q] = s1[(size_t)(jn + q) * NT]; fb[q] = s2[(size_t)(jn + q) * NT]; }
            if (j0 == 0) { bitonic_sort16(a); bitonic_sort16(b);
#pragma unroll
                for (int i = 0; i < 16; ++i) { l1[i] = a[i]; l2[i] = b[i]; } }
            else { top16_merge(l1, a); top16_merge(l2, b); }
        }
        float v1[16], v2[16];
#pragma unroll
        for (int i = 0; i < 16; ++i) { v1[i] = kval16(l1[i]); v2[i] = kval16(l2[i]); myl[i] = (unsigned char)(127 - (l1[i] & 127)); myl[16 + i] = (unsigned char)(127 - (l2[i] & 127)); }
        int cd[64];
        { int n = 0;
#pragma unroll
          for (int i = 0; i < 16; ++i)
#pragma unroll
              for (int j = 0; j < 16; ++j) if ((i + 1) * (j + 1) <= 16) { cd[n] = (fkey(v1[i] + v2[j]) & ~255) | (255 - (i * 16 + j)); ++n; }
#pragma unroll
          for (int q = 50; q < 64; ++q) cd[q] = INT_MIN; }
        int l3[16], c[16];
#pragma unroll
        for (int q = 0; q < 16; ++q) l3[q] = cd[q];
#pragma unroll
        for (int q = 0; q < 8; ++q) c[q] = cd[16 + q];
        c[8] = INT_MIN; c[9] = INT_MIN; c[10] = INT_MIN; c[11] = cd[28]; c[12] = cd[27]; c[13] = cd[26]; c[14] = cd[25]; c[15] = cd[24];
        bitonic_merge16(c);
#pragma unroll
        for (int i = 0; i < 16; ++i) l3[i] = max(l3[i], c[15 - i]);
        bitonic_merge16(l3);
#pragma unroll
        for (int q = 0; q < 13; ++q) c[q] = cd[29 + q];
        c[13] = INT_MIN; c[14] = INT_MIN; c[15] = INT_MIN;
        top16_merge(l3, c);
#pragma unroll
        for (int i = 0; i < 8; ++i) l3[8 + i] = max(l3[8 + i], cd[49 - i]);
        bitonic_merge16(l3);
        float t[16]; float sum = 0.f; const float t0 = kval((l3[0] & ~255) | 128);
#pragma unroll
        for (int k = 0; k < 16; ++k) { t[k] = __expf(kval((l3[k] & ~255) | 128) - t0); sum += t[k]; }
        const float inv = 1.0f / sum;
        int e[16];
#pragma unroll
        for (int k = 0; k < 16; ++k) { const int pos = 255 - (l3[k] & 255); e[k] = (int)myl[pos >> 4] * 128 + (int)myl[16 + (pos & 15)]; t[k] *= inv; }
#pragma unroll
        for (int k = 0; k < 16; k += 4) *(f32x4*)(GW + (size_t)tok * 128 + h * 16 + k) = (f32x4){t[k], t[k + 1], t[k + 2], t[k + 3]};
#pragma unroll
        for (int k = 0; k < 16; k += 4) *(u32x4*)(EID + (size_t)tok * 128 + h * 16 + k) = (u32x4){(unsigned)e[k] * 128u, (unsigned)e[k + 1] * 128u, (unsigned)e[k + 2] * 128u, (unsigned)e[k + 3] * 128u};
    }
}

constexpr size_t OFF_PB = OFF_ST;
constexpr size_t OFF_CV = OFF_ST + 144 * MiB;
__device__ __forceinline__ int id16(const u32x4& a, const u32x4& b, int it) {
    const unsigned w = it < 8 ? (it < 4 ? (it < 2 ? a.x : a.y) : (it < 6 ? a.z : a.w)) : (it < 12 ? (it < 10 ? b.x : b.y) : (it < 14 ? b.z : b.w));
    return (it & 1) ? (int)(w >> 16) : (int)(w & 0xffffu);
}
__device__ __forceinline__ void unpk_fp8x16p(const u32x4& w, f32x2_t (&f)[8]) {
    const unsigned d0 = w.x, d1 = w.y, d2 = w.z, d3 = w.w;
    f[0] = __builtin_amdgcn_cvt_pk_f32_fp8((int)d0, false); f[1] = __builtin_amdgcn_cvt_pk_f32_fp8((int)d0, true); f[2] = __builtin_amdgcn_cvt_pk_f32_fp8((int)d1, false); f[3] = __builtin_amdgcn_cvt_pk_f32_fp8((int)d1, true);
    f[4] = __builtin_amdgcn_cvt_pk_f32_fp8((int)d2, false); f[5] = __builtin_amdgcn_cvt_pk_f32_fp8((int)d2, true); f[6] = __builtin_amdgcn_cvt_pk_f32_fp8((int)d3, false); f[7] = __builtin_amdgcn_cvt_pk_f32_fp8((int)d3, true);
}
__device__ __forceinline__ void unpk_fp8x16(const u32x4& w, float (&f)[16]) {
    const unsigned d0 = w.x, d1 = w.y, d2 = w.z, d3 = w.w;
    f32x2_t t;
    t = __builtin_amdgcn_cvt_pk_f32_fp8((int)d0, false); f[0] = t.x; f[1] = t.y; t = __builtin_amdgcn_cvt_pk_f32_fp8((int)d0, true); f[2] = t.x; f[3] = t.y;
    t = __builtin_amdgcn_cvt_pk_f32_fp8((int)d1, false); f[4] = t.x; f[5] = t.y; t = __builtin_amdgcn_cvt_pk_f32_fp8((int)d1, true); f[6] = t.x; f[7] = t.y;
    t = __builtin_amdgcn_cvt_pk_f32_fp8((int)d2, false); f[8] = t.x; f[9] = t.y; t = __builtin_amdgcn_cvt_pk_f32_fp8((int)d2, true); f[10] = t.x; f[11] = t.y;
    t = __builtin_amdgcn_cvt_pk_f32_fp8((int)d3, false); f[12] = t.x; f[13] = t.y; t = __builtin_amdgcn_cvt_pk_f32_fp8((int)d3, true); f[14] = t.x; f[15] = t.y;
}
__device__ __forceinline__ void ph_peer_u(const Params& P, int l, int ntok, int bid, int nblk) {
    const int TID = tidx(); const int wid = __builtin_amdgcn_readfirstlane(TID >> 6), lane = TID & 63, c8 = lane & 7, q = lane >> 3;
    const int grp = bid & 7, nw = (nblk >> 3) * 8, w0 = (bid >> 3) * 8 + wid;
    if (w0 >= ntok) return;
    const int tl = w0 + ((ntok - 1 - w0) / nw) * nw;
    const bf16_t* HB = (const bf16_t*)(P.ws + OFF_HB) + grp * 128 + c8 * 16; const unsigned* EID = (const unsigned*)(P.ws + OFF_EID) + q * 16;
    float* PB = (float*)(P.ws + OFF_PB) + (size_t)grp * NT * 128 + lane;
    const unsigned char* Tu = P.ws + OFF_PU + ((size_t)(l * 8 + grp) * NEXP) * 128;
    const unsigned lo16 = (unsigned)c8 * 16u;
    u32x4 buf[16], idN[4], idNN[4], xaC, xbC, xaN, xbN, xaNN, xbNN;
#define PU_LOADI(T, ID, XA, XB) do { const int T_ = min((T), tl); _Pragma("unroll") for (int i_ = 0; i_ < 4; ++i_) ID[i_] = *(const u32x4*)(EID + (size_t)T_ * 128 + i_ * 4); XA = *(const u32x4*)(HB + (size_t)T_ * D); XB = *(const u32x4*)(HB + (size_t)T_ * D + 8); } while (0)
    { u32x4 id0[4]; PU_LOADI(w0, id0, xaC, xbC);
#pragma unroll
      for (int it = 0; it < 16; ++it) buf[it] = *(const u32x4*)(Tu + (id0[it >> 2][it & 3] + lo16)); }
    PU_LOADI(w0 + nw, idN, xaN, xbN);
    for (int t0 = w0; t0 < ntok; t0 += nw) {
        PU_LOADI(t0 + 2 * nw, idNN, xaNN, xbNN);
        const unsigned x0 = xaC.x, x1 = xaC.y, x2 = xaC.z, x3 = xaC.w, x4 = xbC.x, x5 = xbC.y, x6 = xbC.z, x7 = xbC.w;
        const f32x2_t xv[8] = {{bf_lo(x0), bf_hi(x0)}, {bf_lo(x1), bf_hi(x1)}, {bf_lo(x2), bf_hi(x2)}, {bf_lo(x3), bf_hi(x3)}, {bf_lo(x4), bf_hi(x4)}, {bf_lo(x5), bf_hi(x5)}, {bf_lo(x6), bf_hi(x6)}, {bf_lo(x7), bf_hi(x7)}};
        float r0 = 0.f, r1 = 0.f;
#pragma unroll
        for (int it = 0; it < 16; ++it) { f32x2_t uf[8]; unpk_fp8x16p(buf[it], uf);
            buf[it] = *(const u32x4*)(Tu + (idN[it >> 2][it & 3] + lo16));
            f32x2_t d = uf[0] * xv[0];
#pragma unroll
            for (int i = 1; i < 8; ++i) d = __builtin_elementwise_fma(uf[i], xv[i], d);
            const float p = sum8(d.x + d.y); if (c8 == (it & 7)) { if (it < 8) r0 = p; else r1 = p; } }
        float* pb = PB + (size_t)t0 * 128; pb[0] = r0; pb[64] = r1;
        xaC = xaN; xbC = xbN; xaN = xaNN; xbN = xbNN;
#pragma unroll
        for (int i = 0; i < 4; ++i) idN[i] = idNN[i];
    }
#undef PU_LOADI
}
__device__ __forceinline__ void ph_peer_a(const Params& P, int ntok, int bid, int nblk) {
    const int TID = tidx(); const int wid = __builtin_amdgcn_readfirstlane(TID >> 6), lane = TID & 63;
    const float* PB = (const float*)(P.ws + OFF_PB); const float* GW = (const float*)(P.ws + OFF_GW); float* CV = (float*)(P.ws + OFF_CV);
    constexpr int TB = 4;
    const int stride = nblk * 8;
    for (int t0 = bid * 8 + wid; t0 < ntok; t0 += TB * stride) {
        float pb[TB][2][8], gw[TB][2];
#pragma unroll
        for (int h = 0; h < TB; ++h) { const int t = min(t0 + h * stride, ntok - 1);
#pragma unroll
            for (int k = 0; k < 2; ++k) {
#pragma unroll
                for (int j = 0; j < 8; ++j) pb[h][k][j] = PB[((size_t)j * NT + t) * 128 + k * 64 + lane];
                gw[h][k] = GW[(size_t)t * 128 + (lane >> 3) * 16 + k * 8 + (lane & 7)]; } }
        asm volatile("" : "+v"(gw[0][0]), "+v"(gw[1][0]), "+v"(gw[2][0]), "+v"(gw[3][0]), "+v"(gw[0][1]), "+v"(gw[1][1]), "+v"(gw[2][1]), "+v"(gw[3][1]));
#pragma unroll
        for (int h = 0; h < TB; ++h) { const int t = t0 + h * stride;
            if (t < ntok) {
#pragma unroll
                for (int k = 0; k < 2; ++k) { float a = 0.f;
#pragma unroll
                    for (int j = 0; j < 8; ++j) a += pb[h][k][j];
                    const int p = (lane >> 3) * 16 + k * 8 + (lane & 7);
                    CV[(size_t)t * 128 + p] = gw[h][k] * gelu_tanh(a * (1.0f / U_SCALE)) * (1.0f / V_SCALE); } } }
    }
}
__device__ __forceinline__ float red16(float a, float b) { auto r = __builtin_amdgcn_permlane16_swap(__builtin_bit_cast(unsigned, a), __builtin_bit_cast(unsigned, b), false, false); return __builtin_bit_cast(float, (unsigned)r[0]) + __builtin_bit_cast(float, (unsigned)r[1]); }
__device__ __forceinline__ float red32(float a, float b) { auto r = __builtin_amdgcn_permlane32_swap(__builtin_bit_cast(unsigned, a), __builtin_bit_cast(unsigned, b), false, false); return __builtin_bit_cast(float, (unsigned)r[0]) + __builtin_bit_cast(float, (unsigned)r[1]); }
__device__ __forceinline__ void ph_peer_v(const Params& P, int l, int ntok, int bid, int nblk, const bool dry = false) {
    const int TID = tidx(); const int wid = __builtin_amdgcn_readfirstlane(TID >> 6), lane = TID & 63, c8 = lane & 7, q = lane >> 3;
    const int grp = bid & 7, nw = (nblk >> 3) * 8, w0 = (bid >> 3) * 8 + wid;
    if (w0 >= ntok) return;
    const int tl = w0 + ((ntok - 1 - w0) / nw) * nw;
    const unsigned* EID = (const unsigned*)(P.ws + OFF_EID) + q * 16; const float* CV = (const float*)(P.ws + OFF_CV) + q * 16;
    const unsigned char* Tv = P.ws + OFF_PV + ((size_t)(l * 8 + grp) * NEXP) * 128;
    const unsigned lo16 = (unsigned)c8 * 16u;
    const int xcol = grp * 128 + c8 * 16 + 4 * (lane >> 4);
    const bool writer = (lane & 8) == 0;
    u32x4 buf[16], idN[4], idNN[4]; f32x2_t cvC[8], cvN[8];
#define PV_LOADI(T, ID) do { const int T_ = min((T), tl); _Pragma("unroll") for (int i_ = 0; i_ < 4; ++i_) ID[i_] = *(const u32x4*)(EID + (size_t)T_ * 128 + i_ * 4); } while (0)
#define PV_LOADC(T, CVX) do { const int T_ = min((T), tl); _Pragma("unroll") for (int i_ = 0; i_ < 4; ++i_) { const f32x4 c4_ = *(const f32x4*)(CV + (size_t)T_ * 128 + i_ * 4); CVX[2 * i_] = (f32x2_t){c4_.x, c4_.y}; CVX[2 * i_ + 1] = (f32x2_t){c4_.z, c4_.w}; } } while (0)
    { u32x4 id0[4]; PV_LOADI(w0, id0); PV_LOADC(w0, cvC);
#pragma unroll
      for (int it = 0; it < 16; ++it) buf[it] = *(const u32x4*)(Tv + (id0[it >> 2][it & 3] + lo16)); }
    PV_LOADI(w0 + nw, idN);
    f32x4 gpre = {0.f, 0.f, 0.f, 0.f}; int rcur = -1;
    for (int t0 = w0; t0 < ntok; t0 += nw) {
        PV_LOADI(t0 + 2 * nw, idNN); PV_LOADC(t0 + nw, cvN);
        float* xp = xrow_ptr(P, t0) + xcol; const float* m5 = mod_ptr(P, l, mod_r(t0), 5) + xcol;
        f32x4 xpre;
        if (!dry && writer) { xpre = *(const f32x4*)xp; const int rr_ = mod_r(t0); if (rr_ != rcur) { gpre = *(const f32x4*)m5; rcur = rr_; } }
        f32x2_t o2[8];
#pragma unroll
        for (int i = 0; i < 8; ++i) o2[i] = (f32x2_t){0.f, 0.f};
#pragma unroll
        for (int it = 0; it < 16; ++it) { f32x2_t vf[8]; unpk_fp8x16p(buf[it], vf);
            buf[it] = *(const u32x4*)(Tv + (idN[it >> 2][it & 3] + lo16));
#pragma unroll
            for (int i = 0; i < 8; ++i) { if (it & 1) asm("v_pk_fma_f32 %0, %1, %2, %0 op_sel:[0,1,0] op_sel_hi:[1,1,1]" : "+v"(o2[i]) : "v"(vf[i]), "v"(cvC[it >> 1]));
                                          else        asm("v_pk_fma_f32 %0, %1, %2, %0 op_sel_hi:[1,0,1]" : "+v"(o2[i]) : "v"(vf[i]), "v"(cvC[it >> 1])); } }
        float w[16];
#pragma unroll
        for (int i = 0; i < 8; ++i) { const float ox = o2[i].x, oy = o2[i].y; w[2 * i] = ox + DPP_F(ox, 0x128); w[2 * i + 1] = oy + DPP_F(oy, 0x128); }
        float z[4];
#pragma unroll
        for (int j = 0; j < 4; ++j) z[j] = red32(red16(w[j], w[4 + j]), red16(w[8 + j], w[12 + j]));
        if (dry) {
#pragma unroll
            for (int j = 0; j < 4; ++j) asm volatile("" :: "v"(z[j]));
        } else if (writer) {
            f32x4 x = xpre; x.x += gpre.x * z[0]; x.y += gpre.y * z[1]; x.z += gpre.z * z[2]; x.w += gpre.w * z[3]; *(f32x4*)xp = x;
        }
#pragma unroll
        for (int i = 0; i < 8; ++i) cvC[i] = cvN[i];
#pragma unroll
        for (int i = 0; i < 4; ++i) idN[i] = idNN[i];
    }
#undef PV_LOADI
#undef PV_LOADC
}

namespace pg8 {
#define PG8_LAS __attribute__((address_space(3)))
constexpr int BM = 256, BK = 64, HALF = 128, HTB = HALF * BK * 2, STAGE_BYTES = 8 * HTB, NXCD = 8, WGM = 4;
__host__ __device__ __forceinline__ int lds_byte(int r, int c) { const int ch = (c >> 3) ^ ((r >> 1) & 7); return r * 128 + ch * 16 + (c & 7) * 2; }
__host__ __device__ __forceinline__ void stage_rc(int b, int& R, int& C) { R = b >> 7; C = ((((b >> 4) & 7) ^ ((R >> 1) & 7)) << 3) + ((b & 15) >> 1); }
__host__ __device__ __forceinline__ int perm32(int rho) { const int n = rho >> 4, i = rho & 15; return 8 * (i >> 2) + 4 * n + (i & 3); }
struct Unit { int pm, pn, nt, kofs, tag; };
struct Gemm { const bf16_t* A; const bf16_t* Bt; int lda, ldb; };
struct TileOrder {
    int nM, nN, nwg, G, c;
    __device__ __forceinline__ void init(int nM_, int nN_, int G_, int c_) { nM = nM_; nN = nN_; nwg = nM * nN; G = G_; c = c_; }
    __device__ __forceinline__ bool tile(int i, int& pm, int& pn) const {
        const long L = (long)i * G + c; if (L >= nwg) return false;
        int wgid = (int)L; { const int q = nwg / NXCD, r = nwg % NXCD, xcd = wgid % NXCD, off = wgid / NXCD; wgid = (xcd < r ? xcd * (q + 1) : r * (q + 1) + (xcd - r) * q) + off; }
        const int nig = WGM * nN, gid = wgid / nig, fm = gid * WGM, gsz = (nM - fm) < WGM ? (nM - fm) : WGM;
        pm = fm + ((wgid % nig) % gsz); pn = (wgid % nig) / gsz; return true;
    }
};
struct PlainSched { TileOrder T; int nt;
    __device__ __forceinline__ bool next(int i, Unit& u) const { if (!T.tile(i, u.pm, u.pn)) return false; u.nt = nt; u.kofs = 0; u.tag = 0; return true; } };
struct CtxZSched { int c, G, nt;
    __device__ __forceinline__ bool next(int i, Unit& u) const { const int L = i * G + c; if (L >= 32) return false; u.pm = L & 1; u.pn = 128 + (L >> 1); u.nt = nt; u.kofs = 0; u.tag = 0; return true; } };
struct MergeSched { TileOrder T;
    __device__ __forceinline__ bool next(int i, Unit& u) const { const int ti = i / 3, br = i - 3 * ti; if (!T.tile(ti, u.pm, u.pn)) return false;
        u.tag = br; u.nt = br == 2 ? 8 : 4; u.kofs = br == 0 ? 0 : br == 1 ? 512 : 1024; return true; } };

template <class Epi, class Sched, bool FP8 = false>
__device__ __forceinline__ void gemm_phase(PG8_LAS unsigned char* lds, const Gemm g, const Sched& S, const Epi& E) {
    const int TID = tidx();
    const int tid = TID, wid = __builtin_amdgcn_readfirstlane(tid >> 6), lane = tid & 63, wr = wid >> 2, wc = wid & 3, fr = lane & 15, fq = lane >> 4;
    unsigned voffA[2], voffB[2];
#pragma unroll
    for (int i = 0; i < 2; ++i) { int R, C; stage_rc(tid * 16 + i * 8192, R, C); const int Rb = Epi::PERM ? ((R & ~31) + perm32(R & 31)) : R;
        voffA[i] = (unsigned)(R * g.lda + C) * 2u; voffB[i] = (unsigned)(Rb * g.ldb + C) * 2u; }
    const size_t kstep = (size_t)(BK * 2);
    const size_t hstepA = (size_t)HALF * g.lda * 2, hstepB = (size_t)HALF * g.ldb * 2;
    const size_t tstepA = 2 * hstepA, tstepB = 2 * hstepB;
    const unsigned ldsw = (unsigned)wid * 1024u;
    const int aoffk[2] = {lds_byte(wr * 64 + fr, fq * 8), lds_byte(wr * 64 + fr, fq * 8 + 32)}, boffk[2] = {lds_byte(wc * 32 + fr, fq * 8), lds_byte(wc * 32 + fr, fq * 8 + 32)};
#define PG8_SA(b, h) (((b) * 2 + (h)) * HTB)
#define PG8_SB(b, h) ((4 + (b) * 2 + (h)) * HTB)
#define PG8_STAGE(bufoff, gbase, voff) do { _Pragma("unroll") for (int _i = 0; _i < 2; ++_i) \
        __builtin_amdgcn_global_load_lds((const unsigned*)((const char*)(gbase) + (voff)[_i]), (PG8_LAS unsigned*)(lds + (bufoff) + ldsw + _i * 8192), 16, 0, 0); } while (0)
#define PG8_LDA(dst, b, h) do { _Pragma("unroll") for (int m = 0; m < 4; ++m) { if constexpr (FP8) { const i32x4_ lo_ = *(const PG8_LAS i32x4_*)(lds + PG8_SA(b, h) + aoffk[0] + m * 2048), hi_ = *(const PG8_LAS i32x4_*)(lds + PG8_SA(b, h) + aoffk[1] + m * 2048); dst##8[m] = __builtin_shufflevector(lo_, hi_, 0, 1, 2, 3, 4, 5, 6, 7); } \
        else { _Pragma("unroll") for (int k = 0; k < 2; ++k) dst[m][k] = *(const PG8_LAS bf16x8*)(lds + PG8_SA(b, h) + aoffk[k] + m * 2048); } } } while (0)
#define PG8_LDB(dst, b, h) do { _Pragma("unroll") for (int n = 0; n < 2; ++n) { if constexpr (FP8) { const i32x4_ lo_ = *(const PG8_LAS i32x4_*)(lds + PG8_SB(b, h) + boffk[0] + n * 2048), hi_ = *(const PG8_LAS i32x4_*)(lds + PG8_SB(b, h) + boffk[1] + n * 2048); dst##8[n] = __builtin_shufflevector(lo_, hi_, 0, 1, 2, 3, 4, 5, 6, 7); } \
        else { _Pragma("unroll") for (int k = 0; k < 2; ++k) dst[n][k] = *(const PG8_LAS bf16x8*)(lds + PG8_SB(b, h) + boffk[k] + n * 2048); } } } while (0)
#define PG8_MMA(ai, bj, At, Bt) do { __builtin_amdgcn_s_setprio(1); _Pragma("unroll") for (int m = 0; m < 4; ++m) _Pragma("unroll") for (int n = 0; n < 2; ++n) { \
        if constexpr (FP8) asm volatile("v_mfma_scale_f32_16x16x128_f8f6f4 %0, %1, %2, %0, %3, %3 op_sel_hi:[0,0,0]" : "+v"(acc[ai][bj][m][n]) : "v"(Bt##8[n]), "v"(At##8[m]), "v"(scale1));   \
        else { _Pragma("unroll") for (int k = 0; k < 2; ++k) acc[ai][bj][m][n] = __builtin_amdgcn_mfma_f32_16x16x32_bf16(Bt[n][k], At[m][k], acc[ai][bj][m][n], 0, 0, 0); } } \
        __builtin_amdgcn_s_setprio(0); } while (0)
#define PG8_WAIT_V(n) asm volatile("s_waitcnt vmcnt(" #n ")" ::: "memory")
#define PG8_WAIT_L(n) asm volatile("s_waitcnt lgkmcnt(" #n ")" ::: "memory")
#define PG8_BAR __builtin_amdgcn_s_barrier()
#define PG8_SCHED __builtin_amdgcn_sched_barrier(0)
    Unit cur, nxt; int ui = 0;
    if (!S.next(0, cur)) return;
    int scale1 = 0x7F7F7F7F; asm volatile("" : "+v"(scale1));
    f32x4 acc[2][2][4][2];
#pragma unroll
    for (int a = 0; a < 2; ++a)
#pragma unroll
        for (int b = 0; b < 2; ++b)
#pragma unroll
            for (int m = 0; m < 4; ++m)
#pragma unroll
                for (int n = 0; n < 2; ++n) acc[a][b][m][n] = (f32x4){0.f, 0.f, 0.f, 0.f};
    bf16x8 At[4][2], B0[2][2], B1[2][2];
    i32x8 At8[4], B08[2], B18[2];
    const char* cA = (const char*)g.A + (size_t)cur.pm * tstepA + cur.kofs; const char* cB = (const char*)g.Bt + (size_t)cur.pn * tstepB + cur.kofs;
    PG8_STAGE(PG8_SB(0, 0), cB, voffB); PG8_STAGE(PG8_SB(0, 1), cB + hstepB, voffB); PG8_STAGE(PG8_SA(0, 0), cA, voffA); PG8_STAGE(PG8_SA(0, 1), cA + hstepA, voffA);
    if (wr == 1) PG8_BAR;
    PG8_WAIT_V(2); PG8_BAR;
    PG8_STAGE(PG8_SB(1, 0), cB + kstep, voffB); PG8_STAGE(PG8_SA(1, 0), cA + kstep, voffA); PG8_STAGE(PG8_SB(1, 1), cB + hstepB + kstep, voffB);
    PG8_WAIT_V(6); PG8_BAR;
    for (;;) {
        const bool has_next = S.next(ui + 1, nxt);
        const char* nA = has_next ? (const char*)g.A + (size_t)nxt.pm * tstepA + nxt.kofs : cA; const char* nB = has_next ? (const char*)g.Bt + (size_t)nxt.pn * tstepB + nxt.kofs : cB;
        const int nt = cur.nt;
        for (int t = 0; t < nt; t += 2) {
            const bool last = (t == nt - 2);
            const char* a1 = cA + (size_t)(t + 1) * kstep;
            const char* a2 = last ? nA : cA + (size_t)(t + 2) * kstep; const char* b2 = last ? nB : cB + (size_t)(t + 2) * kstep;
            const char* a3 = a2 + kstep; const char* b3 = b2 + kstep;
            PG8_LDB(B0, 0, 0); PG8_LDB(B1, 0, 1); PG8_SCHED; PG8_LDA(At, 0, 0); PG8_STAGE(PG8_SA(1, 1), a1 + hstepA, voffA);
            PG8_WAIT_V(8); PG8_WAIT_L(0); PG8_BAR; PG8_MMA(0, 0, At, B0); PG8_MMA(0, 1, At, B1); PG8_BAR; PG8_SCHED;
            PG8_LDA(At, 0, 1); PG8_STAGE(PG8_SB(0, 0), b2, voffB); PG8_STAGE(PG8_SB(0, 1), b2 + hstepB, voffB); PG8_STAGE(PG8_SA(0, 0), a2, voffA);
            PG8_WAIT_V(8); PG8_WAIT_L(0); PG8_BAR; PG8_MMA(1, 0, At, B0); PG8_MMA(1, 1, At, B1); PG8_BAR; PG8_SCHED;
            PG8_LDB(B0, 1, 0); PG8_LDB(B1, 1, 1); PG8_SCHED; PG8_LDA(At, 1, 0); PG8_STAGE(PG8_SA(0, 1), a2 + hstepA, voffA);
            PG8_WAIT_V(8); PG8_WAIT_L(0); PG8_BAR; PG8_MMA(0, 0, At, B0); PG8_MMA(0, 1, At, B1); PG8_BAR; PG8_SCHED;
            PG8_LDA(At, 1, 1); PG8_STAGE(PG8_SB(1, 0), b3, voffB); PG8_STAGE(PG8_SB(1, 1), b3 + hstepB, voffB); PG8_STAGE(PG8_SA(1, 0), a3, voffA);
            PG8_WAIT_V(8); PG8_WAIT_L(0); PG8_BAR; PG8_MMA(1, 0, At, B0); PG8_MMA(1, 1, At, B1); PG8_BAR; PG8_SCHED;
        }
        if (wr == 0) PG8_BAR;
        if constexpr (FP8) asm volatile("s_nop 15\n\ts_nop 15" ::: "memory");
        E(acc, cur, wr, wc, fr, fq);
        if (!has_next) break;
        if (!E.keeps(cur)) {
#pragma unroll
        for (int a = 0; a < 2; ++a)
#pragma unroll
            for (int b = 0; b < 2; ++b)
#pragma unroll
                for (int m = 0; m < 4; ++m)
#pragma unroll
                    for (int n = 0; n < 2; ++n) acc[a][b][m][n] = (f32x4){0.f, 0.f, 0.f, 0.f};
        }
        cur = nxt; cA = nA; cB = nB; ++ui;
        if (wr == 1) PG8_BAR;
    }
    PG8_WAIT_V(0);
    PG8_BAR;
#undef PG8_SA
#undef PG8_SB
#undef PG8_STAGE
#undef PG8_LDA
#undef PG8_LDB
#undef PG8_MMA
#undef PG8_WAIT_V
#undef PG8_WAIT_L
#undef PG8_BAR
#undef PG8_SCHED
}
__device__ __forceinline__ u32x4 pack8(f32x4 v0, f32x4 v1) { u32x4 w; w.x = pk_bf16(v0[0], v0[1]); w.y = pk_bf16(v0[2], v0[3]); w.z = pk_bf16(v1[0], v1[1]); w.w = pk_bf16(v1[2], v1[3]); return w; }
__device__ __forceinline__ u32x2 pack8u(f32x4 a, f32x4 b) {
    u32x2 w;
    w.x = (unsigned)__builtin_rintf(a[0] * 255.f) | ((unsigned)__builtin_rintf(a[1] * 255.f) << 8) | ((unsigned)__builtin_rintf(a[2] * 255.f) << 16) | ((unsigned)__builtin_rintf(a[3] * 255.f) << 24);
    w.y = (unsigned)__builtin_rintf(b[0] * 255.f) | ((unsigned)__builtin_rintf(b[1] * 255.f) << 8) | ((unsigned)__builtin_rintf(b[2] * 255.f) << 16) | ((unsigned)__builtin_rintf(b[3] * 255.f) << 24);
    return w;
}
__device__ __forceinline__ void unpk8u(u32x2 w, float (&f)[8]) {
    const unsigned x = w.x, y = w.y; const float k = 1.0f / 255.0f;
    f[0] = (float)(x & 255u) * k; f[1] = (float)((x >> 8) & 255u) * k; f[2] = (float)((x >> 16) & 255u) * k; f[3] = (float)(x >> 24) * k;
    f[4] = (float)(y & 255u) * k; f[5] = (float)((y >> 8) & 255u) * k; f[6] = (float)((y >> 16) & 255u) * k; f[7] = (float)(y >> 24) * k;
}
__device__ __forceinline__ f32x4 sig4(f32x4 v) { return (f32x4){sigmoidf_(v[0]), sigmoidf_(v[1]), sigmoidf_(v[2]), sigmoidf_(v[3])}; }
struct EpiG1 {
    static constexpr bool PERM = true; __device__ __forceinline__ bool keeps(const Unit&) const { return false; } unsigned char* ws;
    __device__ __forceinline__ void operator()(const f32x4 (&acc)[2][2][4][2], const Unit& u, int wr, int wc, int fr, int fq) const {
        const int rl = wr * 64 + fr, cl = wc * 32 + 8 * fq; const int row0 = u.pm * BM + rl;
        const int kvb = (u.pm < 128 ? (u.pm >> 3) * KV + (u.pm & 7) * 256 : (u.pm - 128) * KV + SEQ) + rl;
#pragma unroll
        for (int ai = 0; ai < 2; ++ai)
#pragma unroll
            for (int m = 0; m < 4; ++m) { const int ro = ai * HALF + m * 16;
#pragma unroll
                for (int bj = 0; bj < 2; ++bj) { const f32x4 v0 = acc[ai][bj][m][0], v1 = acc[ai][bj][m][1];
                    if (u.pn == 0) *(u32x4*)((bf16_t*)(ws + OFF_PP) + (size_t)(row0 + ro) * 256 + bj * HALF + cl) = pack8(v0, v1);
                    else if (u.pn < 3) *(u32x4*)((bf16_t*)(ws + OFF_QR) + (size_t)(row0 + ro) * 512 + (u.pn - 1) * 256 + bj * HALF + cl) = pack8(v0, v1);
                    else if (u.pn == 3) *(u32x4*)((bf16_t*)(ws + (bj ? OFF_VALL : OFF_KALL)) + (size_t)(kvb + ro) * 128 + cl) = pack8(v0, v1);
                    else *(u32x2*)(ws + OFF_GT + (size_t)(row0 + ro) * 3072 + (u.pn - 4) * 256 + bj * HALF + cl) = pack8u(sig4(v0), sig4(v1)); } }
    }
};
struct EpiG8 {
    static constexpr bool PERM = true; __device__ __forceinline__ bool keeps(const Unit&) const { return false; } unsigned char* ws; const PG8_LAS unsigned char* lut;
    __device__ __forceinline__ unsigned g4(const f32x4 v) const {
        const unsigned i0 = min((unsigned)(v[0] + 512.5f), 1023u), i1 = min((unsigned)(v[1] + 512.5f), 1023u), i2 = min((unsigned)(v[2] + 512.5f), 1023u), i3 = min((unsigned)(v[3] + 512.5f), 1023u);
        return (unsigned)lut[i0] | ((unsigned)lut[i1] << 8) | ((unsigned)lut[i2] << 16) | ((unsigned)lut[i3] << 24);
    }
    __device__ __forceinline__ void operator()(const f32x4 (&acc)[2][2][4][2], const Unit& u, int wr, int wc, int fr, int fq) const {
        const int row0 = u.pm * BM + wr * 64 + fr, cl = wc * 32 + 8 * (fq & ~1); const int odd = fq & 1;
#pragma unroll
        for (int ai = 0; ai < 2; ++ai)
#pragma unroll
            for (int bj = 0; bj < 2; ++bj)
#pragma unroll
                for (int mp = 0; mp < 2; ++mp) {
                    const unsigned a0 = g4(acc[ai][bj][2 * mp][0]), a1 = g4(acc[ai][bj][2 * mp][1]), b0 = g4(acc[ai][bj][2 * mp + 1][0]), b1 = g4(acc[ai][bj][2 * mp + 1][1]);
                    auto s0 = __builtin_amdgcn_permlane16_swap(a0, b0, false, false); auto s1 = __builtin_amdgcn_permlane16_swap(a1, b1, false, false);
                    u32x4 o; o.x = (unsigned)s0[0]; o.y = (unsigned)s1[0]; o.z = (unsigned)s0[1]; o.w = (unsigned)s1[1];
                    *(u32x4*)(ws + OFF_GT + (size_t)(row0 + ai * HALF + (2 * mp + odd) * 16) * 3072 + u.pn * 256 + bj * HALF + cl) = o; }
    }
};
struct EpiGZ {
    static constexpr bool PERM = true; __device__ __forceinline__ bool keeps(const Unit&) const { return false; } unsigned char* ws;
    __device__ __forceinline__ void operator()(const f32x4 (&acc)[2][2][4][2], const Unit& u, int wr, int wc, int fr, int fq) const {
        const int ch0 = wr * 64 + fr, tl = wc * 32 + 8 * fq;
        bf16_t* base; int pitch;
        if (u.pn < 128) { base = (bf16_t*)(ws + OFF_ZTL) + (size_t)((u.pn >> 3) * 256) * 4096 + u.pm * 2048 + (u.pn & 7) * 256; pitch = 4096; }
        else { base = (bf16_t*)(ws + OFF_ZTC) + (size_t)((u.pn - 128) * 256) * 512 + u.pm * 256; pitch = 512; }
#pragma unroll
        for (int ai = 0; ai < 2; ++ai)
#pragma unroll
            for (int m = 0; m < 4; ++m) { const int ch = ch0 + ai * HALF + m * 16;
#pragma unroll
                for (int bj = 0; bj < 2; ++bj) *(u32x4*)(base + (size_t)ch * pitch + bj * HALF + tl) = pack8(acc[ai][bj][m][0], acc[ai][bj][m][1]); }
    }
};
struct EpiRe8 {
    static constexpr bool PERM = true; __device__ __forceinline__ bool keeps(const Unit&) const { return false; } bf16_t* mix; int ctx;
    __device__ __forceinline__ void operator()(const f32x4 (&acc)[2][2][4][2], const Unit& u, int wr, int wc, int fr, int fq) const {
        const int rb = (ctx ? NL + u.tag * CTX : u.tag * SEQ + (u.pm & 7) * 256) + wr * 64 + fr, cl = wc * 32 + 8 * fq;
        const float sc = ctx ? 1.0f / 128.0f : 0.0027621358640099515f;
#pragma unroll
        for (int ai = 0; ai < 2; ++ai)
#pragma unroll
            for (int m = 0; m < 4; ++m)
#pragma unroll
                for (int bj = 0; bj < 2; ++bj) *(u32x4*)(mix + (size_t)(rb + ai * HALF + m * 16) * D + bj * HALF + cl) = pack8(acc[ai][bj][m][0] * sc, acc[ai][bj][m][1] * sc);
    }
};
struct EpiMg {
    static constexpr bool PERM = true; unsigned char* ws;
    __device__ __forceinline__ bool keeps(const Unit& u) const { return u.tag != 2; }
    __device__ __forceinline__ void operator()(f32x4 (&acc)[2][2][4][2], const Unit& u, int wr, int wc, int fr, int fq) const {
        const int row0 = u.pm * BM + wr * 64 + fr, col0 = u.pn * BM + wc * 32 + 8 * fq;
        const unsigned char* gt = ws + OFF_GT + u.tag * 1024; bf16_t* U = (bf16_t*)(ws + OFF_HB);
        const unsigned go = (unsigned)row0 * 3072u + (unsigned)col0, dofs = u.tag != 2 ? 1024u : 0u; const bool ratio = u.tag != 2;
#pragma unroll
        for (int g = 0; g < 4; ++g) {
            u32x2 gn[2][2], gd[2][2];
#pragma unroll
            for (int mm = 0; mm < 2; ++mm)
#pragma unroll
                for (int bj = 0; bj < 2; ++bj) { const unsigned o = go + (unsigned)((g >> 1) * HALF + ((g & 1) * 2 + mm) * 16) * 3072u + (unsigned)(bj * HALF);
                    gn[mm][bj] = *(const u32x2*)(gt + o); gd[mm][bj] = *(const u32x2*)(gt + (o + dofs)); }
#pragma unroll
            for (int mm = 0; mm < 2; ++mm)
#pragma unroll
                for (int bj = 0; bj < 2; ++bj) { const int ai = g >> 1, m = (g & 1) * 2 + mm; float f[8], d[8];
                    u32x2 dd = gd[mm][bj]; dd.x = ratio ? dd.x : 0xFFFFFFFFu; dd.y = ratio ? dd.y : 0xFFFFFFFFu;
                    unpk8u(gn[mm][bj], f); unpk8u(dd, d);
#pragma unroll
                    for (int i = 0; i < 8; ++i) f[i] = fmaxf(f[i], 1e-20f) * __builtin_amdgcn_rcpf(fmaxf(d[i], 1e-20f));
                    f32x4 v0 = acc[ai][bj][m][0], v1 = acc[ai][bj][m][1];
                    v0[0] *= f[0]; v0[1] *= f[1]; v0[2] *= f[2]; v0[3] *= f[3]; v1[0] *= f[4]; v1[1] *= f[5]; v1[2] *= f[6]; v1[3] *= f[7];
                    acc[ai][bj][m][0] = v0; acc[ai][bj][m][1] = v1; }
        }
        if (u.tag == 2) {
#pragma unroll
            for (int ai = 0; ai < 2; ++ai)
#pragma unroll
                for (int m = 0; m < 4; ++m)
#pragma unroll
                    for (int bj = 0; bj < 2; ++bj) *(u32x4*)(U + (size_t)(row0 + ai * HALF + m * 16) * D + col0 + bj * HALF) = pack8(acc[ai][bj][m][0], acc[ai][bj][m][1]);
        }
    }
};
struct EpiO {
    static constexpr bool PERM = false; __device__ __forceinline__ bool keeps(const Unit&) const { return false; } float* out; unsigned char* ws; int l; const float* xin; const float* cin;
    __device__ __forceinline__ void operator()(const f32x4 (&acc)[2][2][4][2], const Unit& u, int wr, int wc, int fr, int fq) const {
        const int rl = wr * 64 + fr, col0 = u.pn * BM + wc * 32 + 4 * fq;
        float* xb = (u.pm < 128 ? out + (size_t)u.pm * BM * D : (float*)(ws + OFF_XC) + (size_t)(u.pm - 128) * BM * D) + (size_t)rl * D + col0;
        const float* xr = (u.pm < 128 ? xin + (size_t)u.pm * BM * D : cin + (size_t)(u.pm - 128) * BM * D) + (size_t)rl * D + col0;
        const float* m2 = (const float*)(ws + OFF_MOD) + ((size_t)(l * 17 + (u.pm < 128 ? (u.pm >> 3) : 16)) * 6 + 2) * D + col0;
        f32x4 gv[2][2];
#pragma unroll
        for (int bj = 0; bj < 2; ++bj)
#pragma unroll
            for (int n = 0; n < 2; ++n) gv[bj][n] = *(const f32x4*)(m2 + bj * HALF + n * 16);
        f32x4 xv[2][2][2][2];
#define EO_LOAD(G, BUF) do { _Pragma("unroll") for (int mm = 0; mm < 2; ++mm) { const int ai_ = (G) >> 1, m_ = ((G) & 1) * 2 + mm; const size_t ro_ = (size_t)(ai_ * HALF + m_ * 16) * D; \
            _Pragma("unroll") for (int bj = 0; bj < 2; ++bj) _Pragma("unroll") for (int n = 0; n < 2; ++n) xv[BUF][mm][bj][n] = *(const f32x4*)(xr + ro_ + bj * HALF + n * 16); } } while (0)
        EO_LOAD(0, 0);
#pragma unroll
        for (int g = 0; g < 4; ++g) { const int cb = g & 1;
            if (g < 3) EO_LOAD(g + 1, cb ^ 1);
            asm volatile("" : "+v"(xv[cb][0][0][0]), "+v"(xv[cb][0][0][1]), "+v"(xv[cb][0][1][0]), "+v"(xv[cb][0][1][1]), "+v"(xv[cb][1][0][0]), "+v"(xv[cb][1][0][1]), "+v"(xv[cb][1][1][0]), "+v"(xv[cb][1][1][1]));
#pragma unroll
            for (int mm = 0; mm < 2; ++mm) { const int ai = g >> 1, m = (g & 1) * 2 + mm; const size_t ro = (size_t)(ai * HALF + m * 16) * D;
#pragma unroll
                for (int bj = 0; bj < 2; ++bj)
#pragma unroll
                    for (int n = 0; n < 2; ++n) *(f32x4*)(xb + ro + bj * HALF + n * 16) = xv[cb][mm][bj][n] + gv[bj][n] * acc[ai][bj][m][n]; }
        }
#undef EO_LOAD
    }
};
struct EpiS {
    static constexpr bool PERM = true; __device__ __forceinline__ bool keeps(const Unit&) const { return false; } bf16_t* st;
    __device__ __forceinline__ void operator()(const f32x4 (&acc)[2][2][4][2], const Unit& u, int wr, int wc, int fr, int fq) const {
        bf16_t* base = st + (size_t)(u.pm * BM + wr * 64 + fr) * NT + u.pn * BM + wc * 32 + 8 * fq;
#pragma unroll
        for (int ai = 0; ai < 2; ++ai)
#pragma unroll
            for (int m = 0; m < 4; ++m)
#pragma unroll
                for (int bj = 0; bj < 2; ++bj) { u32x4 p = pack8(acc[ai][bj][m][0], acc[ai][bj][m][1]);
                    p.x ^= ((p.x >> 15) & 0x00010001u) * 0x7fffu; p.y ^= ((p.y >> 15) & 0x00010001u) * 0x7fffu; p.z ^= ((p.z >> 15) & 0x00010001u) * 0x7fffu; p.w ^= ((p.w >> 15) & 0x00010001u) * 0x7fffu;
                    *(u32x4*)(base + (size_t)(ai * HALF + m * 16) * NT + bj * HALF) = p; }
    }
};
struct DftSched { int G, c, ctx;
    __device__ __forceinline__ bool next(int i, Unit& u) const { const int L = i * G + c; const int n = ctx ? NB : NB * 8; if (L >= n) return false;
        if (ctx) { u.pm = 0; u.pn = L; u.tag = L; u.nt = 8; } else { u.pm = L & 7; u.pn = L >> 3; u.tag = L >> 3; u.nt = 64; }
        u.kofs = 0; return true; } };
}


__device__ __forceinline__ void ph_gemm1_pg(const Params& P, int l, int bid, int nblk, unsigned char* smem) {
    PG8_LAS unsigned char* lds = (PG8_LAS unsigned char*)smem; const bf16_t* HB = (const bf16_t*)(P.ws + OFF_HB);
    { pg8::Gemm g{(const bf16_t*)(P.ws + OFF_HB8), (const bf16_t*)(P.ws + OFF_WG8 + (size_t)l * 3072 * D), D / 2, D / 2}; pg8::PlainSched S; S.T.init(NT / 256, 12, nblk, bid); S.nt = 8; pg8::EpiG8 E{P.ws, (const PG8_LAS unsigned char*)(lds + SIGLUT_OFF)};
      pg8::gemm_phase<pg8::EpiG8, pg8::PlainSched, true>(lds, g, S, E); }
    { pg8::Gemm g{HB, (const bf16_t*)(P.ws + OFF_W1T) + (size_t)l * 4096 * D, D, D}; pg8::PlainSched S; S.T.init(NT / 256, 4, nblk, nblk == 256 ? (bid + 64) & 255 : bid); S.nt = 16; pg8::EpiG1 E{P.ws}; pg8::gemm_phase(lds, g, S, E); }
    { pg8::Gemm g{(const bf16_t*)(P.ws + OFF_WFT) + (size_t)l * 512 * D, HB, D, D}; pg8::PlainSched S; S.T.init(2, NL / 256, nblk, bid); S.nt = 16; pg8::EpiGZ E{P.ws}; pg8::gemm_phase(lds, g, S, E); }
}
__device__ __forceinline__ void ph_gemm1_ctxz(const Params& P, int l, int c, int G, unsigned char* smem) {
    PG8_LAS unsigned char* lds = (PG8_LAS unsigned char*)smem;
    pg8::Gemm g{(const bf16_t*)(P.ws + OFF_WFT) + (size_t)l * 512 * D, (const bf16_t*)(P.ws + OFF_HB), D, D}; pg8::CtxZSched S{c, G, 16}; pg8::EpiGZ E{P.ws}; pg8::gemm_phase(lds, g, S, E);
}
__device__ __forceinline__ void ph_merge_pg(const Params& P, int l, int ntok, int bid, int nblk, unsigned char* smem) {
    PG8_LAS unsigned char* lds = (PG8_LAS unsigned char*)smem;
    pg8::Gemm g{(const bf16_t*)(P.ws + OFF_MIX), (const bf16_t*)(P.ws + OFF_WMT) + (size_t)l * D * D, D, D}; pg8::MergeSched S; S.T.init(ntok / 256, 4, nblk, bid); pg8::EpiMg E{P.ws}; pg8::gemm_phase(lds, g, S, E);
}
__device__ __forceinline__ void ph_out_pg(const Params& P, int l, int ntok, int bid, int nblk, unsigned char* smem) {
    PG8_LAS unsigned char* lds = (PG8_LAS unsigned char*)smem;
    pg8::Gemm g{(const bf16_t*)(P.ws + OFF_HB), (const bf16_t*)(P.ws + OFF_WOT) + (size_t)l * D * D, D, D}; pg8::PlainSched S; S.T.init(ntok / 256, 4, nblk, bid); S.nt = 16; pg8::EpiO E{P.out, P.ws, l, l == 0 ? P.x : (const float*)P.out, l == 0 ? P.ctx : (const float*)(P.ws + OFF_XC)}; pg8::gemm_phase(lds, g, S, E);
}
__device__ __forceinline__ void ph_score_pg(const Params& P, int l, int ntok, int bid, int nblk, unsigned char* smem) {
    PG8_LAS unsigned char* lds = (PG8_LAS unsigned char*)smem;
    pg8::Gemm g{(const bf16_t*)(P.ws + OFF_WST) + (size_t)l * 2048 * D, (const bf16_t*)(P.ws + OFF_HB), D, D}; pg8::PlainSched S; S.T.init(8, ntok / 256, nblk, bid); S.nt = 16; pg8::EpiS E{(bf16_t*)(P.ws + OFF_ST)}; pg8::gemm_phase(lds, g, S, E);
}


namespace attn_body {
using bf16=__hip_bfloat16;
using bf16x8=__attribute__((ext_vector_type(8)))short;
using s16x4=__attribute__((ext_vector_type(4)))short;
using f32x16=__attribute__((ext_vector_type(16)))float;
using u32x4=__attribute__((ext_vector_type(4)))unsigned;
constexpr int D=64,QP=512,KP=128,OP=1024;
constexpr int NW=8,QBLK=32,QB=QBLK*NW,KVBLK=64;
__device__ __forceinline__ int crow(int r,int hi){return (r&3)+8*(r>>2)+4*hi;}
#define SBAR() __builtin_amdgcn_sched_barrier(0)
constexpr int NSLOT=3, SLOTB=8192;
constexpr int LDS_K=0, LDS_V=NSLOT*SLOTB, LDS_WS=2*NSLOT*SLOTB, LDS_OST=LDS_WS+NW*64*4, LDS_BYTES=LDS_OST+NW*4096;
constexpr float C2=0.125f*1.4426950408889634f;
__device__ __forceinline__ void glds16(const void*gsrc,unsigned lds_dst){unsigned keep;
  asm volatile("s_mov_b32 %0, m0\n\ts_mov_b32 m0, %2\n\ts_nop 0\n\tglobal_load_lds_dwordx4 %1, off\n\ts_mov_b32 m0, %0":"=&s"(keep):"v"(gsrc),"s"(lds_dst):"memory");}
__device__ __forceinline__ float max3f(float a,float b,float c){float r;asm("v_max3_f32 %0, %1, %2, %3":"=v"(r):"v"(a),"v"(b),"v"(c));return r;}
__device__ __forceinline__ float max2f(float a,float b){float r;asm("v_max_f32_e32 %0, %1, %2":"=v"(r):"v"(a),"v"(b));return r;}
__device__ __forceinline__ float fadd_s(float a,float b){float r;asm("v_add_f32_e32 %0, %1, %2":"=v"(r):"v"(a),"v"(b));return r;}
__device__ __forceinline__ float fsub_s(float a,float b){float r;asm("v_sub_f32_e32 %0, %1, %2":"=v"(r):"v"(a),"v"(b));return r;}
typedef float f32x2_t __attribute__((ext_vector_type(2))); typedef __bf16 bf16x2_t __attribute__((ext_vector_type(2)));
__device__ __forceinline__ unsigned cvtpk_s(float lo,float hi){f32x2_t v={lo,hi};bf16x2_t b=__builtin_convertvector(v,bf16x2_t);return __builtin_bit_cast(unsigned,b);}
#define WAIT_BAR(N) asm volatile("s_waitcnt vmcnt(" #N ") lgkmcnt(0)\n\ts_barrier":::"memory")

__device__ __forceinline__ void qkt(f32x16&p0,f32x16&p1,const char*Kslot,const bf16x8*qr,const f32x16&negm,int r32,int hi){
  const char*kb=Kslot+hi*1024+r32*16;
  #pragma unroll
  for(int d0=0;d0<4;++d0){
    const bf16x8 b0=*reinterpret_cast<const bf16x8*>(kb+d0*2048);
    const bf16x8 b1=*reinterpret_cast<const bf16x8*>(kb+d0*2048+512);
    if(d0==0){p0=__builtin_amdgcn_mfma_f32_32x32x16_bf16(b0,qr[0],negm,0,0,0);p1=__builtin_amdgcn_mfma_f32_32x32x16_bf16(b1,qr[0],negm,0,0,0);}
    else{p0=__builtin_amdgcn_mfma_f32_32x32x16_bf16(b0,qr[d0],p0,0,0,0);p1=__builtin_amdgcn_mfma_f32_32x32x16_bf16(b1,qr[d0],p1,0,0,0);}}
}
typedef __attribute__((address_space(3))) const char* lds_cptr;
typedef short v4i16_t __attribute__((ext_vector_type(4)));
__device__ __forceinline__ void kload8(bf16x8*kf,lds_cptr kp){
  kf[0]=*(const __attribute__((address_space(3))) bf16x8*)(kp);      kf[1]=*(const __attribute__((address_space(3))) bf16x8*)(kp+512);
  kf[2]=*(const __attribute__((address_space(3))) bf16x8*)(kp+2048); kf[3]=*(const __attribute__((address_space(3))) bf16x8*)(kp+2560);
  kf[4]=*(const __attribute__((address_space(3))) bf16x8*)(kp+4096); kf[5]=*(const __attribute__((address_space(3))) bf16x8*)(kp+4608);
  kf[6]=*(const __attribute__((address_space(3))) bf16x8*)(kp+6144); kf[7]=*(const __attribute__((address_space(3))) bf16x8*)(kp+6656);
}
__device__ __forceinline__ void kload2(bf16x8*kf,lds_cptr kp,int j){ kf[2*j]=*(const __attribute__((address_space(3))) bf16x8*)(kp+j*2048); kf[2*j+1]=*(const __attribute__((address_space(3))) bf16x8*)(kp+j*2048+512); }
__device__ __forceinline__ s16x4 vtr(lds_cptr p){ return __builtin_bit_cast(s16x4,__builtin_amdgcn_ds_read_tr16_b64_v4i16((__attribute__((address_space(3))) v4i16_t*)p)); }
__device__ __forceinline__ float rowmax(const f32x16&p0,const f32x16&p1){
  float a=max3f(p0[0],p0[1],p1[0]),b=max3f(p0[2],p0[3],p1[1]);a=max3f(a,p1[2],p1[3]);
  #pragma unroll
  for(int r=4;r<16;r+=4){a=max3f(a,p0[r],p0[r+1]);b=max3f(b,p0[r+2],p0[r+3]);a=max3f(a,p1[r],p1[r+1]);b=max3f(b,p1[r+2],p1[r+3]);}
  const float m=max2f(a,b);
  auto rr=__builtin_amdgcn_permlane32_swap(__float_as_uint(m),__float_as_uint(m),false,false);
  return max2f(__uint_as_float(rr[0]),__uint_as_float(rr[1]));
}
__device__ __forceinline__ void pv(f32x16*o,int vb,bf16x8 pa0,bf16x8 pa1,bf16x8 pa2,bf16x8 pa3){
  #pragma unroll
  for(int d0=0;d0<2;++d0){s16x4 lo[4],hi[4];
    #pragma unroll
    for(int ks=0;ks<4;++ks){
      asm volatile("ds_read_b64_tr_b16 %0,%1 offset:%c2":"=&v"(lo[ks]):"v"(vb),"i"(d0*4096+ks*1024):"memory");
      asm volatile("ds_read_b64_tr_b16 %0,%1 offset:%c2":"=&v"(hi[ks]):"v"(vb),"i"(d0*4096+ks*1024+512):"memory");}
    asm volatile("s_waitcnt lgkmcnt(0)":::"memory");SBAR();
    #define PK(k) (bf16x8){lo[k][0],lo[k][1],lo[k][2],lo[k][3],hi[k][0],hi[k][1],hi[k][2],hi[k][3]}
    o[d0]=__builtin_amdgcn_mfma_f32_32x32x16_bf16(pa0,PK(0),o[d0],0,0,0);
    o[d0]=__builtin_amdgcn_mfma_f32_32x32x16_bf16(pa1,PK(1),o[d0],0,0,0);
    o[d0]=__builtin_amdgcn_mfma_f32_32x32x16_bf16(pa2,PK(2),o[d0],0,0,0);
    o[d0]=__builtin_amdgcn_mfma_f32_32x32x16_bf16(pa3,PK(3),o[d0],0,0,0);
    #undef PK
  }
}

#ifndef ATTN_STORE16
#define ATTN_STORE16(p,v) (*(u32x4*)(p)=(v))
#endif
template<int THRL> __device__ __forceinline__ void attn_unit(const bf16*Qu,const bf16*__restrict__ Kh,const bf16*__restrict__ Vh,bf16*Ou,const int NT,char*shm){
  const int tid=tidx(),lane=tid&63,r32=lane&31,hi=lane>>5; const int wid=__builtin_amdgcn_readfirstlane(tid>>6);
  const bf16*Qw=Qu+(long)(wid*QBLK)*QP;
  const unsigned lds0=(unsigned)(uintptr_t)shm;
  float*wsf=(float*)(shm+LDS_WS)+wid*64;
  const bf16*ksrc=Kh+(long)lane*KP+wid*8;
  const bf16*vsrc=Vh+(long)(16*(wid&3)+(lane>>2))*KP+(wid>>2)*32+(lane&3)*8;
  const unsigned kdst=lds0+LDS_K+wid*1024, vdst=lds0+LDS_V+wid*1024;
  #define DMA_K(t,slot) glds16(ksrc+(long)(t)*KVBLK*KP,(unsigned)__builtin_amdgcn_readfirstlane(kdst+(slot)))
  #define DMA_V(t,slot) glds16(vsrc+(long)(t)*KVBLK*KP,(unsigned)__builtin_amdgcn_readfirstlane(vdst+(slot)))
  const int vb0=(int)(lds0+LDS_V)+((lane>>4)&1)*32+(lane&3)*8+(4*hi+((lane&15)>>2))*64;
  const char*Kbase=shm+LDS_K; bf16x8 kf[8];
  const lds_cptr shm3=(lds_cptr)shm; const lds_cptr kp0=shm3+LDS_K+hi*1024+r32*16; const lds_cptr vp0=shm3+LDS_V+((lane>>4)&1)*32+(lane&3)*8+(4*hi+((lane&15)>>2))*64;
  DMA_K(0,0);DMA_V(0,0);DMA_K(1,SLOTB);
  bf16x8 qr[4];
  #pragma unroll
  for(int d0=0;d0<4;++d0)qr[d0]=*reinterpret_cast<const bf16x8*>(&Qw[(long)r32*QP+d0*16+hi*8]);
  float mhat=0.f,l_reg=0.f;f32x16 o[2];o[0]=f32x16{};o[1]=f32x16{};f32x16 negm=f32x16{};asm volatile("":"+v"(negm));
  #define CMASK(P0,P1,t) do{}while(0)
  bool resc=false;
  #define START(P0,P1) do{ const float rm=rowmax(P0,P1); resc=false; \
    { const float dl=rm; mhat=fadd_s(mhat,dl); \
      _Pragma("unroll") for(int r=0;r<16;++r){P0[r]=fsub_s(P0[r],dl);P1[r]=fsub_s(P1[r],dl);} \
      _Pragma("unroll") for(int r=0;r<16;++r)negm[r]=-mhat; asm volatile("":"+v"(negm)); } \
    _Pragma("unroll") for(int r=0;r<16;++r)P0[r]=__builtin_amdgcn_exp2f(P0[r]); }while(0)
  #define RESC() do{ if(resc){ asm volatile("s_waitcnt lgkmcnt(0)":::"memory"); \
      _Pragma("unroll") for(int d_=0;d_<2;++d_) _Pragma("unroll") for(int r=0;r<16;++r)o[d_][r]*=wsf[crow(r,hi)]; } }while(0)
  f32x16 pA0,pA1,pB0,pB1;
  int sl_prev=0,sl_cur=0,sl_next=SLOTB;
  #define ROT() do{sl_prev=sl_cur;sl_cur=sl_next;sl_next=(sl_next==(NSLOT-1)*SLOTB)?0:sl_next+SLOTB;}while(0)
  DMA_K(2,2*SLOTB);
  WAIT_BAR(3);
  qkt(pA0,pA1,Kbase,qr,negm,r32,hi);asm volatile("s_nop 15\n\ts_nop 7":"+v"(pA0),"+v"(pA1));CMASK(pA0,pA1,0);
  START(pA0,pA1);
  _Pragma("unroll") for(int r=0;r<16;++r)pA1[r]=__builtin_amdgcn_exp2f(pA1[r]);
  WAIT_BAR(0);
  DMA_K(3,0);DMA_V(1,SLOTB);
  ROT();
  kload8(kf,kp0+sl_cur);
  WAIT_BAR(2);
  s16x4 vlo[8],vhi[8]; u32x4 pw0,pw1,pw2,pw3;
  #define PKW(P,B) cvtpk_s(P[B],P[B+1])
  #define PAF(k) __builtin_bit_cast(bf16x8,pw##k)
  #define VFR(i) (bf16x8){vlo[i][0],vlo[i][1],vlo[i][2],vlo[i][3],vhi[i][0],vhi[i][1],vhi[i][2],vhi[i][3]}
  #define PIN(x) asm volatile("":"+v"(x))
  #define MX3(a,b,c) __builtin_fmaxf(__builtin_fmaxf((a),(b)),(c))
  #define GAPA(MF,A0,A1,A2,A3,W0,W1,PW) do{ MF; sacc+=A0; sacc+=A1; sacc+=A2; sacc+=A3; PIN(sacc); W0; W1; PIN(PW); SBAR(); }while(0)
  #define EX(v) __builtin_amdgcn_exp2f(v)
  #define GAPB(MF,X,B) do{ MF; X[B]=EX(X[B]); X[B+1]=EX(X[B+1]); X[B+2]=EX(X[B+2]); X[B+3]=EX(X[B+3]); PIN(X); SBAR(); }while(0)
  #define VRD(i) do{ vlo[i]=vtr(vp_+(((i)>>2)*4096+((i)&3)*1024)); vhi[i]=vtr(vp_+(((i)>>2)*4096+((i)&3)*1024+512)); }while(0)
  #define KRD(G,j) do{ if(G){ kload2(kf,kp0+sl_next,j); SBAR(); } }while(0)
  #define STEP(C0,C1,P0,P1,t,GK,GV,GL) do{ SBAR(); \
    const lds_cptr vp_=vp0+sl_prev; \
    VRD(0); SBAR(); float sacc=(P0[0]+P0[1]); \
    GAPA(C0=__builtin_amdgcn_mfma_f32_32x32x16_bf16(kf[0],qr[0],negm,0,0,0), P0[2],P0[3],P0[4],P0[5],     pw0[0]=PKW(P0,0), pw0[1]=PKW(P0,2), pw0); \
    VRD(4); SBAR(); GAPA(C1=__builtin_amdgcn_mfma_f32_32x32x16_bf16(kf[1],qr[0],negm,0,0,0), P0[6],P0[7],P0[8],P0[9],     pw0[2]=PKW(P0,4), pw0[3]=PKW(P0,6), pw0); \
    VRD(1); SBAR(); GAPA(C0=__builtin_amdgcn_mfma_f32_32x32x16_bf16(kf[2],qr[1],C0,0,0,0),   P0[10],P0[11],P0[12],P0[13], pw1[0]=PKW(P0,8), pw1[1]=PKW(P0,10), pw1); \
    VRD(5); SBAR(); GAPA(C1=__builtin_amdgcn_mfma_f32_32x32x16_bf16(kf[3],qr[1],C1,0,0,0),   P0[14],P0[15],P1[0],P1[1],   pw1[2]=PKW(P0,12),pw1[3]=PKW(P0,14), pw1); \
    VRD(2); SBAR(); GAPA(C0=__builtin_amdgcn_mfma_f32_32x32x16_bf16(kf[4],qr[2],C0,0,0,0),   P1[2],P1[3],P1[4],P1[5],     pw2[0]=PKW(P1,0), pw2[1]=PKW(P1,2), pw2); \
    VRD(6); SBAR(); GAPA(C1=__builtin_amdgcn_mfma_f32_32x32x16_bf16(kf[5],qr[2],C1,0,0,0),   P1[6],P1[7],P1[8],P1[9],     pw2[2]=PKW(P1,4), pw2[3]=PKW(P1,6), pw2); \
    VRD(3); SBAR(); GAPA(C0=__builtin_amdgcn_mfma_f32_32x32x16_bf16(kf[6],qr[3],C0,0,0,0),   P1[10],P1[11],P1[12],P1[13], pw3[0]=PKW(P1,8), pw3[1]=PKW(P1,10), pw3); \
    VRD(7); SBAR(); GAPA(C1=__builtin_amdgcn_mfma_f32_32x32x16_bf16(kf[7],qr[3],C1,0,0,0),   P1[14],P1[15],0.f,0.f,       pw3[2]=PKW(P1,12),pw3[3]=PKW(P1,14), pw3); \
    l_reg+=sacc; \
    if(GK){DMA_K((t)+3,sl_cur);} if(GV){DMA_V((t)+1,sl_next);} \
    CMASK(C0,C1,t); \
    { float a=MX3(C0[0],C0[1],C1[0]),b=MX3(C0[2],C0[3],C1[1]); a=MX3(a,C1[2],C1[3]); \
      _Pragma("unroll") for(int r=4;r<16;r+=4){a=MX3(a,C0[r],C0[r+1]);b=MX3(b,C0[r+2],C0[r+3]);a=MX3(a,C1[r],C1[r+1]);b=MX3(b,C1[r+2],C1[r+3]);} \
      float rm=__builtin_fmaxf(a,b); { auto rr=__builtin_amdgcn_permlane32_swap(__float_as_uint(rm),__float_as_uint(rm),false,false); rm=__builtin_fmaxf(__uint_as_float(rr[0]),__uint_as_float(rr[1])); } \
      resc=false; \
      if(__builtin_expect(__any(rm>(float)THRL),0)){ const float dl=__builtin_fmaxf(rm,0.f); mhat+=dl; \
        _Pragma("unroll") for(int r=0;r<16;++r){C0[r]-=dl;C1[r]-=dl;} \
        _Pragma("unroll") for(int r=0;r<16;++r)negm[r]=-mhat; asm volatile("":"+v"(negm)); \
        const float f=__builtin_amdgcn_exp2f(-dl); l_reg*=f; if(hi==0)wsf[r32]=f; resc=true; } } \
    SBAR(); \
    GAPB(o[0]=__builtin_amdgcn_mfma_f32_32x32x16_bf16(PAF(0),VFR(0),o[0],0,0,0), C0,0); \
    GAPB(o[1]=__builtin_amdgcn_mfma_f32_32x32x16_bf16(PAF(0),VFR(4),o[1],0,0,0), C0,4); \
    KRD(GL,0); GAPB(o[0]=__builtin_amdgcn_mfma_f32_32x32x16_bf16(PAF(1),VFR(1),o[0],0,0,0), C0,8); \
    KRD(GL,1); GAPB(o[1]=__builtin_amdgcn_mfma_f32_32x32x16_bf16(PAF(1),VFR(5),o[1],0,0,0), C0,12); \
    KRD(GL,2); GAPB(o[0]=__builtin_amdgcn_mfma_f32_32x32x16_bf16(PAF(2),VFR(2),o[0],0,0,0), C1,0); \
    KRD(GL,3); GAPB(o[1]=__builtin_amdgcn_mfma_f32_32x32x16_bf16(PAF(2),VFR(6),o[1],0,0,0), C1,4); \
    GAPB(o[0]=__builtin_amdgcn_mfma_f32_32x32x16_bf16(PAF(3),VFR(3),o[0],0,0,0), C1,8); \
    GAPB(o[1]=__builtin_amdgcn_mfma_f32_32x32x16_bf16(PAF(3),VFR(7),o[1],0,0,0), C1,12); \
    }while(0)
  int t=1;
  #undef CMASK
  #define CMASK(P0,P1,t) do{}while(0)
  for(;t+5<NT;t+=2){
    STEP(pB0,pB1,pA0,pA1,t,true,true,true);     WAIT_BAR(2); RESC(); ROT();
    STEP(pA0,pA1,pB0,pB1,t+1,true,true,true);   WAIT_BAR(2); RESC(); ROT();
  }
  #undef CMASK
  #define CMASK(P0,P1,t) do{}while(0)
  #define ENDW(tt) do{ if((tt)+3<NT){WAIT_BAR(2);} else if((tt)+2<NT){WAIT_BAR(1);} else {WAIT_BAR(0);} }while(0)
  for(;t+1<NT;t+=2){
    STEP(pB0,pB1,pA0,pA1,t,(t+3<NT),(t+1<NT),(t+1<NT));       ENDW(t);   RESC(); ROT();
    STEP(pA0,pA1,pB0,pB1,t+1,(t+4<NT),(t+2<NT),(t+2<NT));     ENDW(t+1); RESC(); ROT();
  }
  STEP(pB0,pB1,pA0,pA1,NT-1,false,false,false); RESC();
  { float sacc=pB0[0]+pB0[1]; _Pragma("unroll") for(int r=2;r<16;++r)sacc+=pB0[r]; _Pragma("unroll") for(int r=0;r<16;++r)sacc+=pB1[r]; l_reg+=sacc;
    pw0=(u32x4){PKW(pB0,0),PKW(pB0,2),PKW(pB0,4),PKW(pB0,6)};pw1=(u32x4){PKW(pB0,8),PKW(pB0,10),PKW(pB0,12),PKW(pB0,14)};pw2=(u32x4){PKW(pB1,0),PKW(pB1,2),PKW(pB1,4),PKW(pB1,6)};pw3=(u32x4){PKW(pB1,8),PKW(pB1,10),PKW(pB1,12),PKW(pB1,14)};
    SBAR(); pv(o,vb0+sl_cur,PAF(0),PAF(1),PAF(2),PAF(3)); }
  #undef PKW
  #undef PAF
  #undef VFR
  #undef PIN
  #undef MX3
  #undef GAPA
  #undef GAPB
  #undef EX
  #undef VRD
  #undef KRD
  #undef STEP
  #undef ENDW
  {auto rr=__builtin_amdgcn_permlane32_swap(__float_as_uint(l_reg),__float_as_uint(l_reg),false,false);l_reg=__uint_as_float(rr[0])+__uint_as_float(rr[1]);}
  if(hi==0)wsf[32+r32]=l_reg;asm volatile("s_waitcnt lgkmcnt(0)":::"memory");
  float rli[16];
  #pragma unroll
  for(int r=0;r<16;++r)rli[r]=__builtin_amdgcn_rcpf(wsf[32+crow(r,hi)]);
  bf16*Ow=Ou+(long)(wid*QBLK)*OP;
  { bf16*stg=(bf16*)(shm+LDS_OST)+wid*2048;
    #pragma unroll
    for(int r=0;r<16;++r){const int orow=crow(r,hi);
      #pragma unroll
      for(int d0=0;d0<2;++d0)stg[orow*64+d0*32+r32]=__float2bfloat16(o[d0][r]*rli[r]);}
    asm volatile("s_waitcnt lgkmcnt(0)":::"memory");
    #pragma unroll
    for(int i=0;i<4;++i){const int row=i*8+(lane>>3),ch=lane&7; const u32x4 v=*(const u32x4*)(stg+row*64+ch*8); ATTN_STORE16(Ow+(long)row*OP+ch*8,v);} }
  asm volatile("s_waitcnt lgkmcnt(0)\n\ts_barrier":::"memory");
  #undef DMA_K
  #undef DMA_V
  #undef CMASK
  #undef START
  #undef RESC
  #undef ROT
}
constexpr int ATTN_LDS_BYTES=LDS_BYTES;
#undef SBAR
#undef WAIT_BAR
}

__device__ __forceinline__ void ph_attn_dft(const Params& P, int bid, int nblk, unsigned char* smem, int with_ctx) {
    PG8_LAS unsigned char* lds = (PG8_LAS unsigned char*)smem; bf16_t* MIXb = (bf16_t*)(P.ws + OFF_MIX);
    const bool bal = (nblk == 256);
    { pg8::Gemm g{(const bf16_t*)(P.ws + OFF_ADFT), (const bf16_t*)(P.ws + OFF_ZTL), 4096, 4096}; pg8::DftSched S{nblk, bid, 0}; pg8::EpiRe8 E{MIXb, 0}; pg8::gemm_phase(lds, g, S, E); }
    if (with_ctx) { pg8::Gemm g{(const bf16_t*)(P.ws + OFF_ADFTC), (const bf16_t*)(P.ws + OFF_ZTC), 512, 512}; pg8::DftSched S{nblk, bal ? (bid >= 128 ? bid - 128 : 1 << 20) : bid, 1}; pg8::EpiRe8 E{MIXb, 1}; pg8::gemm_phase(lds, g, S, E); }
    __syncthreads();
    const attn_body::bf16* QR = (const attn_body::bf16*)(P.ws + OFF_QR); const attn_body::bf16* KA = (const attn_body::bf16*)(P.ws + OFF_KALL); const attn_body::bf16* VA = (const attn_body::bf16*)(P.ws + OFF_VALL);
    attn_body::bf16* MIX = (attn_body::bf16*)(P.ws + OFF_MIX);
    int start, cnt, stride, shortU;
    if (bal) { if (bid < 128) { start = 3 * ((bid & 7) * 16 + (bid >> 3)); cnt = 3; stride = 1; shortU = -1; }
               else { const int vj = (bid & 7) * 16 + ((bid - 128) >> 3); start = 384 + 5 * vj; cnt = 5; stride = 1; shortU = with_ctx ? 1024 + vj : -1; } }
    else { const int vcu = (nblk % 8 == 0) ? (bid % 8) * (nblk / 8) + bid / 8 : bid; const int nU = with_ctx ? 1152 : 1024; start = vcu; stride = nblk; cnt = vcu < nU ? (nU - 1 - vcu) / nblk + 1 : 0; shortU = -1; }
    for (int k = 0; k <= cnt; ++k) {
        const int U = k < cnt ? start + k * stride : shortU; if (U < 0) break;
        int b, h, qrow, krow, NTl;
        if (U < 1024) { b = U >> 6; h = (U >> 3) & 7; qrow = b * SEQ + (U & 7) * 256; krow = b * KV; NTl = KV / 64; }
        else { const int j = U - 1024; b = j >> 3; h = j & 7; qrow = NL + b * CTX; krow = b * KV + SEQ; NTl = CTX / 64; }
        attn_body::attn_unit<8>(QR + (size_t)qrow * 512 + h * 64, KA + (size_t)krow * 128 + (h >> 2) * 64, VA + (size_t)krow * 128 + (h >> 2) * 64, MIX + (size_t)qrow * D + 512 + h * 64, NTl, (char*)smem);
    }
}

#define XB_TMO      128
#define XB_XCNT(j)  (256  + 64 * (j))
#define XB_XSUB(j)  (1280 + 64 * (j))
#define XB_XGEN(j)  (2304 + 64 * (j))
#define XB_TOP      3328
#define XB_TOPGEN   3392
#define XCD_BAR_WORDS 3456
#define XB_SPIN_CAP (1u << 18)
#define LAS __attribute__((address_space(3)))

__device__ __forceinline__ unsigned xb_ld(unsigned* p)              { return __hip_atomic_load(p, __ATOMIC_RELAXED, __HIP_MEMORY_SCOPE_AGENT); }
__device__ __forceinline__ unsigned xb_add(unsigned* p, unsigned v) { return __hip_atomic_fetch_add(p, v, __ATOMIC_RELAXED, __HIP_MEMORY_SCOPE_AGENT); }
__device__ __forceinline__ unsigned xb_xcc_id() { return (unsigned)__builtin_amdgcn_s_getreg((3 << 11) | 20) & 0xFu; }
#define XB_SPIN(cond, bar) do { unsigned _sp = 0; while (cond) { __builtin_amdgcn_s_sleep(1); \
    if ((++_sp & 255u) == 0u) { if (xb_ld(&(bar)[XB_TMO])) break; if (_sp > XB_SPIN_CAP) { atomicAdd(&(bar)[XB_TMO], 1u); break; } } } } while (0)

struct XcdBarrier {
    unsigned* bar; unsigned x;
    volatile LAS unsigned* st;
};
__device__ __forceinline__ XcdBarrier xcd_barrier_post(unsigned* bar, volatile LAS unsigned* st) {
    XcdBarrier b; b.bar = bar; b.x = xb_xcc_id(); b.st = st;
    if (threadIdx.x == 0) (void)xb_add(&bar[XB_XCNT(b.x)], 1u);
    return b;
}
__device__ __forceinline__ void xcd_barrier_complete(unsigned* bar, unsigned x, unsigned& nloc, unsigned& nx) {
    const unsigned G = gridDim.x * gridDim.y * gridDim.z;
    unsigned sum, cnt, mine, sp = 0u;
    for (;;) {
        sum = 0u; cnt = 0u; mine = 0u;
#pragma unroll
        for (unsigned j = 0; j < 16; ++j) { const unsigned c = xb_ld(&bar[XB_XCNT(j)]); sum += c; cnt += (c > 0u) ? 1u : 0u; mine = (j == x) ? c : mine; }
        if (sum == G) break;
        __builtin_amdgcn_s_sleep(1);
        if ((++sp & 255u) == 0u) { if (xb_ld(&bar[XB_TMO])) break; if (sp > XB_SPIN_CAP) { atomicAdd(&bar[XB_TMO], 1u); break; } }
    }
    nloc = mine > 0u ? mine : 1u; nx = cnt > 0u ? cnt : 1u;
}
__device__ __forceinline__ void xcd_barrier(const XcdBarrier& b) {
    asm volatile("s_waitcnt vmcnt(0)" ::: "memory");
    __syncthreads();
    if (threadIdx.x == 0) {
        unsigned* bar = b.bar; const unsigned bx = xb_xcc_id();
        __builtin_amdgcn_s_waitcnt(0);
        unsigned nloc = b.st[0], nx = b.st[1];
        if (nloc == 0u) { xcd_barrier_complete(bar, bx, nloc, nx); b.st[0] = nloc; b.st[1] = nx; }
        const unsigned old = xb_add(&bar[XB_XSUB(bx)], 1u);
        const unsigned gen = old / nloc;
        if (old + 1u == (gen + 1u) * nloc) {
            __builtin_amdgcn_fence(__ATOMIC_RELEASE, "agent");
            asm volatile("s_waitcnt vmcnt(0)" ::: "memory");
            const unsigned og = xb_add(&bar[XB_TOP], 1u);
            const unsigned tg = og / nx;
            if (og + 1u == (tg + 1u) * nx) xb_add(&bar[XB_TOPGEN], 1u);
            else XB_SPIN(xb_ld(&bar[XB_TOPGEN]) == tg, bar);
            __builtin_amdgcn_fence(__ATOMIC_ACQUIRE, "agent");
            xb_add(&bar[XB_XGEN(bx)], 1u);
            asm volatile("s_waitcnt vmcnt(0)" ::: "memory");
        } else {
            XB_SPIN(xb_ld(&bar[XB_XGEN(bx)]) == gen, bar);
            __builtin_amdgcn_fence(__ATOMIC_ACQUIRE, "agent");
            asm volatile("s_waitcnt vmcnt(0)" ::: "memory");
        }
    }
    __syncthreads();
}

constexpr int LDS_BYTES = 147456;
constexpr int MISC_OFF = 131072 + 320;

__global__ void __launch_bounds__(512, 2) mega_fwd(Params P) {
    extern __shared__ __attribute__((aligned(16))) unsigned char smem[];
    const int bid = blockIdx.x, nblk = gridDim.x;
    for (int u = threadIdx.x; u < (LDS_BYTES - 131072) / 4; u += 512) ((LAS unsigned*)((LAS unsigned char*)smem + 131072))[u] = 0u;
    __syncthreads();
    for (int u = threadIdx.x; u < 1024; u += 512) ((LAS unsigned char*)smem)[SIGLUT_OFF + u] = (unsigned char)__builtin_rintf(255.0f * sigmoidf_((float)(u - 512) * (1.0f / 64.0f)));
    __syncthreads();
    XcdBarrier bar = xcd_barrier_post((unsigned*)(P.ws + OFF_CTL), (volatile LAS unsigned*)((LAS unsigned char*)smem + MISC_OFF) + 8);
    float* ldsf = (float*)smem;
#define GASQ __attribute__((address_space(1)))
#define LND(m) Q.m = (decltype(Q.m))((const char*)Q.m + z_)
#ifndef DUPM
#define DUPM 0
#endif
#define DUP(bit, call) do { call; if (DUPM & (1 << (bit))) { call; } } while (0)
#define PH(call) do { Params Q = P; long z_ = 0; asm volatile("" : "+s"(z_)); LND(ws); LND(out); LND(x); LND(c); LND(ctx); LND(c_ctx); LND(ada_w); LND(ada_b); LND(norm_mix); LND(w_in); LND(fourier_w); LND(pool_w); LND(pool_scale); LND(pool_proj); \
        LND(q_norm); LND(k_norm); LND(attn_proj); LND(w_out); LND(norm_ffn); LND(peer_wq); LND(peer_keys); LND(peer_u); LND(peer_v); call; } while (0)
    for (int rep = 0; rep < ((DUPM & (1 << 11)) ? 2 : 1); ++rep) {
    PH(ph_mod(Q, bid, nblk, ldsf)); PH(ph_tables(Q, bid, nblk)); PH(ph_wtrans(Q, bid, nblk, ldsf)); PH(ph_wft(Q, bid, nblk, ldsf)); PH(ph_wg8(Q, bid, nblk, ldsf)); PH(ph_wpool(Q, bid, nblk, ldsf)); PH(ph_wst(Q, bid, nblk, 0, 1)); PH(ph_peer_cvt(Q, bid, nblk, 0, 1));
    }
    xcd_barrier(bar);
#pragma unroll 1
    for (int l = 0; l < DEPTH; ++l) {
        const int ntok = (l == DEPTH - 1) ? NL : NT;
        DUP(0, PH(ph_norm(Q, l, 0, NT, bid, nblk, l == 0)));      xcd_barrier(bar);
        DUP(1, PH(ph_gemm1_pg(Q, l, bid, nblk, smem)));        xcd_barrier(bar);
        {
            const bool withz = l < DEPTH - 1, split = withz && nblk > 64;
            const int zc = split ? bid : bid, zG = split ? (1 << 20) : nblk;
            if (withz && (split ? bid < 32 : true)) { PH(ph_gemm1_ctxz(Q, l, zc, zG, smem)); }
            if (!split || bid >= 32) { PH(ph_l3(Q, l, split ? bid - 32 : bid, split ? nblk - 32 : nblk)); }
        }
        xcd_barrier(bar);
        DUP(3, PH(ph_attn_dft(Q, bid, nblk, smem, l < DEPTH - 1)));      xcd_barrier(bar);
        DUP(4, PH(ph_merge_pg(Q, l, ntok, bid, nblk, smem)));
        if (l < DEPTH - 1) {
            if (nblk == 256) { if (bid >= 64) { PH(ph_peer_cvt(Q, bid - 64, 192, l + 1, l + 2, 0, 1)); } }
            else { PH(ph_peer_cvt(Q, bid, nblk, l + 1, l + 2)); PH(ph_wst(Q, bid, nblk, l + 1, l + 2)); }
        }
        xcd_barrier(bar);
        PH(ph_out_pg(Q, l, ntok, bid, nblk, smem));
        if (l < DEPTH - 1 && nblk == 256 && bid >= 64) { PH(ph_wst(Q, bid - 64, 192, l + 1, l + 2)); }
        xcd_barrier(bar);
        DUP(5, PH(ph_norm(Q, l, 1, ntok, bid, nblk)));      xcd_barrier(bar);
        DUP(6, PH(ph_score_pg(Q, l, ntok, bid, nblk, smem)));        xcd_barrier(bar);
        DUP(7, PH(ph_topk(Q, ntok, bid, nblk, smem)));
        if (l < DEPTH - 1 && nblk == 256 && bid >= 64) { PH(ph_peer_cvt(Q, bid - 64, 192, l + 1, l + 2, 1, 2)); }
        xcd_barrier(bar);
        DUP(8, PH(ph_peer_u(Q, l, ntok, bid, nblk)));    xcd_barrier(bar);
        DUP(9, PH(ph_peer_a(Q, ntok, bid, nblk)));       xcd_barrier(bar);
        PH(ph_peer_v(Q, l, ntok, bid, nblk)); if (DUPM & (1 << 10)) { PH(ph_peer_v(Q, l, ntok, bid, nblk, true)); }   xcd_barrier(bar);
    }
#undef PH
#undef DUP
#undef LND
#undef GASQ
}

extern "C" void kernel_launch(void* const* d_in, const int* in_sizes, int n_in, void* d_out, int out_size, void* d_ws, size_t ws_size, hipStream_t stream) {
    static int grid = 0;
    if (grid == 0) {
        if (n_in != 21 || ws_size < WS_END) { grid = -1; return; }
        int dev = 0, cus = 0, per_cu = 0;
        if (hipGetDevice(&dev) != hipSuccess || hipDeviceGetAttribute(&cus, hipDeviceAttributeMultiprocessorCount, dev) != hipSuccess) { grid = -1; return; }
        if (hipFuncSetAttribute((const void*)mega_fwd, hipFuncAttributeMaxDynamicSharedMemorySize, LDS_BYTES) != hipSuccess) { grid = -1; return; }
        if (hipOccupancyMaxActiveBlocksPerMultiprocessor(&per_cu, (const void*)mega_fwd, 512, LDS_BYTES) != hipSuccess || per_cu < 1) { (void)hipGetLastError(); }
        grid = (cus / 8) * 8;
    }
    if (grid < 0) return;
    (void)hipMemsetAsync((char*)d_ws + OFF_CTL, 0, 65536, stream);
    Params P{};
    const float** f = (const float**)&P;
    for (int i = 0; i < 21; ++i) f[i] = (const float*)d_in[i];
    P.out = (float*)d_out; P.ws = (unsigned char*)d_ws;
    hipLaunchKernelGGL(mega_fwd, dim3(grid), dim3(512), LDS_BYTES, stream, P);
}
```

```cpp
#include <hip/hip_runtime.h>
#include <stdint.h>
#include <hip/hip_bf16.h>
#include <cmath>

typedef unsigned short bf16_t;
typedef short bf16x8 __attribute__((ext_vector_type(8)));
typedef float f32x4 __attribute__((ext_vector_type(4)));
typedef float f32x16 __attribute__((ext_vector_type(16)));
typedef unsigned u32x4 __attribute__((ext_vector_type(4)));
typedef unsigned u32x2 __attribute__((ext_vector_type(2)));
typedef float f32x2_t __attribute__((ext_vector_type(2)));
typedef __bf16 bf16x2_t __attribute__((ext_vector_type(2)));
typedef int i32x8 __attribute__((ext_vector_type(8)));
typedef int i32x4_ __attribute__((ext_vector_type(4)));
constexpr int SIGLUT_OFF = 131072 + 1024;
constexpr float G8_SCALE = 64.0f;

constexpr int D = 1024, NB = 16, SEQ = 2048, DEPTH = 4, CTX = 256;
constexpr int NL = NB * SEQ, NC = NB * CTX, NT = NL + NC;
constexpr int INC = 4352;
constexpr int KV = SEQ + CTX;
constexpr int NEXP = 16384;
constexpr float C2 = 0.125f * 1.4426950408889634f;
constexpr float EPS = 1e-6f;

constexpr size_t MiB = 1u << 20;
constexpr size_t OFF_CTL = 0;
constexpr size_t OFF_MOD = 1 * MiB;
constexpr size_t OFF_SC = 3 * MiB + 512 * 1024;
constexpr size_t OFF_ROPE = 3 * MiB;
constexpr size_t OFF_XC = 4 * MiB;
constexpr size_t OFF_HB = 20 * MiB;
constexpr size_t OFF_MIX = 92 * MiB;
constexpr size_t OFF_KALL = 164 * MiB;
constexpr size_t OFF_VALL = 173 * MiB;
constexpr size_t OFF_EID = 182 * MiB;
constexpr size_t OFF_GW = 200 * MiB;
constexpr size_t OFF_GT = 218 * MiB;
constexpr size_t OFF_QR = 434 * MiB;
constexpr size_t OFF_ZTL = 470 * MiB;
constexpr size_t OFF_ZTC = 502 * MiB;
constexpr size_t OFF_PP = 506 * MiB;
constexpr size_t OFF_ST = 218 * MiB;
constexpr size_t OFF_W1T = 524 * MiB;
constexpr size_t OFF_WFT = 556 * MiB;
constexpr size_t OFF_WMT = 560 * MiB;
constexpr size_t OFF_WOT = 568 * MiB;
constexpr size_t OFF_WST = 576 * MiB;
constexpr size_t OFF_ADFT = 592 * MiB;
constexpr size_t OFF_ADFTC = 608 * MiB;
constexpr size_t OFF_PU = 609 * MiB;
constexpr size_t OFF_PV = 737 * MiB;
constexpr size_t OFF_WG8 = 866 * MiB;
constexpr size_t OFF_HB8 = 880 * MiB;
constexpr size_t WS_END = 916 * MiB;

struct Params {
    const float *x, *c, *ctx, *c_ctx, *ada_w, *ada_b, *norm_mix, *w_in, *fourier_w, *pool_w, *pool_scale, *pool_proj, *q_norm, *k_norm,
        *attn_proj, *w_out, *norm_ffn, *peer_wq, *peer_keys, *peer_u, *peer_v;
    float* out;
    unsigned char* ws;
};

__device__ __forceinline__ unsigned pk_bf16(float lo, float hi) { f32x2_t v = {lo, hi}; bf16x2_t b = __builtin_convertvector(v, bf16x2_t); return __builtin_bit_cast(unsigned, b); }
__device__ __forceinline__ float bf_lo(unsigned u) { return __uint_as_float(u << 16); }
__device__ __forceinline__ float bf_hi(unsigned u) { return __uint_as_float(u & 0xffff0000u); }
__device__ __forceinline__ float sigmoidf_(float x) { return __builtin_amdgcn_rcpf(1.0f + __expf(-x)); }
__device__ __forceinline__ float gelu_tanh(float x) { const float y = 0.7978845608028654f * (x + 0.044715f * x * x * x); const float t = 1.0f - 2.0f * __builtin_amdgcn_rcpf(1.0f + __expf(2.0f * y)); return 0.5f * x * (1.0f + t); }
template <int CTRL> __device__ __forceinline__ float dpp_f(float v) { return __builtin_bit_cast(float, __builtin_amdgcn_update_dpp(0, __builtin_bit_cast(int, v), CTRL, 0xF, 0xF, true)); }
#define DPP_F(v, ctrl) dpp_f<(ctrl)>(v)
__device__ __forceinline__ float xsum16(float v) { const unsigned u = __builtin_bit_cast(unsigned, v); auto r = __builtin_amdgcn_permlane16_swap(u, u, false, false); return __builtin_bit_cast(float, (unsigned)r[0]) + __builtin_bit_cast(float, (unsigned)r[1]); }
__device__ __forceinline__ float xsum32(float v) { const unsigned u = __builtin_bit_cast(unsigned, v); auto r = __builtin_amdgcn_permlane32_swap(u, u, false, false); return __builtin_bit_cast(float, (unsigned)r[0]) + __builtin_bit_cast(float, (unsigned)r[1]); }
__device__ __forceinline__ float sum8(float v) { v += DPP_F(v, 0xB1); v += DPP_F(v, 0x4E); v += DPP_F(v, 0x141); return v; }
__device__ __forceinline__ float wave_sum(float v) { v = sum8(v); v += DPP_F(v, 0x140); v = xsum16(v); return xsum32(v); }
__device__ __forceinline__ int tidx() { int t = threadIdx.x; asm volatile("" : "+v"(t)); return t; }
__device__ __forceinline__ float dot2bf(unsigned a, unsigned b, float acc) { return __builtin_amdgcn_fdot2_f32_bf16(__builtin_bit_cast(bf16x2_t, a), __builtin_bit_cast(bf16x2_t, b), acc, false); }
__device__ __forceinline__ float dot8(u32x4 a, u32x4 b, float acc) {
    const unsigned a0 = a.x, a1 = a.y, a2 = a.z, a3 = a.w, b0 = b.x, b1 = b.y, b2 = b.z, b3 = b.w;
    acc = dot2bf(a0, b0, acc); acc = dot2bf(a1, b1, acc); acc = dot2bf(a2, b2, acc); acc = dot2bf(a3, b3, acc);
    return acc;
}
__device__ __forceinline__ float* xrow_ptr(const Params& P, int row) { return row < NL ? P.out + (size_t)row * D : (float*)(P.ws + OFF_XC) + (size_t)(row - NL) * D; }
__device__ __forceinline__ int mod_r(int row) { return row < NL ? (row >> 11) : 16; }
__device__ __forceinline__ const float* mod_ptr(const Params& P, int l, int r, int j) { return (const float*)(P.ws + OFF_MOD) + ((size_t)(l * 17 + r) * 6 + j) * D; }
__device__ __forceinline__ int kv_row(int row) { return row < NL ? (row >> 11) * KV + (row & 2047) : ((row - NL) >> 8) * KV + SEQ + ((row - NL) & 255); }

__device__ __forceinline__ void ph_tables(const Params& P, int bid, int nblk) {
    const int TID = tidx();
    float* rc = (float*)(P.ws + OFF_ROPE); float* rs = rc + SEQ * 32;
    for (int i = bid * 512 + TID; i < SEQ * 32; i += nblk * 512) {
        const int t = i >> 5, f = i & 31; const float pos = (float)(f < 16 ? (t >> 6) : (t & 63));
        const float inv = powf(10000.0f, -(float)(f & 15) / 16.0f); const float ang = pos * inv;
        float s, c; sincosf(ang, &s, &c); rc[i] = c; rs[i] = s;
    }
    bf16_t* A = (bf16_t*)(P.ws + OFF_ADFT);
    for (size_t i = (size_t)bid * 512 + TID; i < (size_t)2048 * 2048; i += (size_t)nblk * 512) {
        const int kp = (int)(i >> 11), t = (int)(i & 2047); const int m = (kp * t) & 2047;
        float s, c; sincospif((float)m * (1.0f / 1024.0f), &s, &c);
        A[(size_t)kp * 4096 + t] = (bf16_t)(pk_bf16(c, 0.f) & 0xffff); A[(size_t)kp * 4096 + 2048 + t] = (bf16_t)(pk_bf16(-s, 0.f) & 0xffff);
    }
    bf16_t* Ac = (bf16_t*)(P.ws + OFF_ADFTC);
    for (int i = bid * 512 + TID; i < 256 * 256; i += nblk * 512) {
        const int kp = i >> 8, t = i & 255; const int m = (kp * t) & 255;
        float s, c; sincospif((float)m * (1.0f / 128.0f), &s, &c);
        Ac[kp * 512 + t] = (bf16_t)(pk_bf16(c, 0.f) & 0xffff); Ac[kp * 512 + 256 + t] = (bf16_t)(pk_bf16(-s, 0.f) & 0xffff);
    }
}
__device__ __forceinline__ void ph_mod(const Params& P, int bid, int nblk, float* lds) {
    const int TID = tidx();
    const int tid = TID, c4 = tid & 7, ks = tid >> 3, lane = tid & 63, wid = tid >> 6;
    float* mod = (float*)(P.ws + OFF_MOD);
    float* lsc = lds;
    float* red = lds + 17 * D;
    __syncthreads();
    for (int i = tid; i < 17 * D; i += 512) { const float v = i < 16 * D ? P.c[i] : P.c_ctx[i - 16 * D]; lsc[i] = v * sigmoidf_(v); }
    __syncthreads();
    for (int u = bid; u < DEPTH * 192; u += nblk) {
        const int l = u / 192;
        f32x4 acc[17];
#pragma unroll
        for (int r = 0; r < 17; ++r) acc[r] = (f32x4){0.f, 0.f, 0.f, 0.f};
        const float* w = P.ada_w + ((size_t)l * D + ks * 16) * 6144 + (u % 192) * 32 + c4 * 4;
        f32x4 wv[16];
#pragma unroll
        for (int q = 0; q < 16; ++q) wv[q] = *(const f32x4*)(w + (size_t)q * 6144);
#pragma unroll
        for (int q4 = 0; q4 < 4; ++q4)
#pragma unroll
            for (int r = 0; r < 17; ++r) { const f32x4 cc = *(const f32x4*)(lsc + r * D + ks * 16 + 4 * q4);
                acc[r] += cc.x * wv[4 * q4] + cc.y * wv[4 * q4 + 1] + cc.z * wv[4 * q4 + 2] + cc.w * wv[4 * q4 + 3]; }
#pragma unroll
        for (int r = 0; r < 17; ++r)
#pragma unroll
            for (int e = 0; e < 4; ++e) { float v = acc[r][e]; v += dpp_f<0x128>(v);
                auto sw = __builtin_amdgcn_permlane16_swap(__builtin_bit_cast(unsigned, v), __builtin_bit_cast(unsigned, v), false, false);
                acc[r][e] = __builtin_bit_cast(float, (unsigned)sw[0]) + __builtin_bit_cast(float, (unsigned)sw[1]); }
        __syncthreads();
        if ((lane & 24) == 0) { const int g = wid * 2 + (lane >> 5);
#pragma unroll
            for (int r = 0; r < 17; ++r) *(f32x4*)(red + (g * 17 + r) * 32 + c4 * 4) = acc[r]; }
        __syncthreads();
        for (int i = tid; i < 17 * 32; i += 512) { const int r = i >> 5, c = i & 31; float sum = 0.f;
#pragma unroll
            for (int q = 0; q < 16; ++q) sum += red[(q * 17 + r) * 32 + c];
            const int jj = (u % 192) * 32 + c; mod[(size_t)(l * 17 + r) * 6144 + jj] = sum + P.ada_b[l * 6144 + jj]; }
    }
}
__device__ __forceinline__ void tr_cvt_tile_w(const float* src, int ldn, bf16_t* dst, int ldk, int N, int tile, float* lw, int lane) {
    const int tn = N / 64; const int k0 = (tile / tn) * 32, n0 = (tile % tn) * 64;
    float v[32];
#pragma unroll
    for (int kk = 0; kk < 32; ++kk) v[kk] = src[(size_t)(k0 + kk) * ldn + n0 + lane];
#pragma unroll
    for (int kk = 0; kk < 32; ++kk) lw[kk * 65 + lane] = v[kk];
    asm volatile("s_waitcnt lgkmcnt(0)" ::: "memory");
#pragma unroll
    for (int it = 0; it < 4; ++it) { const int row = it * 16 + (lane >> 2), ch = (lane & 3) * 8; u32x4 o;
        o.x = pk_bf16(lw[(ch + 0) * 65 + row], lw[(ch + 1) * 65 + row]); o.y = pk_bf16(lw[(ch + 2) * 65 + row], lw[(ch + 3) * 65 + row]);
        o.z = pk_bf16(lw[(ch + 4) * 65 + row], lw[(ch + 5) * 65 + row]); o.w = pk_bf16(lw[(ch + 6) * 65 + row], lw[(ch + 7) * 65 + row]);
        *(u32x4*)(dst + (size_t)(n0 + row) * ldk + k0 + ch) = o; }
    asm volatile("s_waitcnt lgkmcnt(0)" ::: "memory");
}
__device__ __forceinline__ void ph_wtrans(const Params& P, int bid, int nblk, float* lds) {
    const int TID = tidx(); const int wid = __builtin_amdgcn_readfirstlane(TID >> 6), lane = TID & 63;
    float* lw = lds + wid * (32 * 65);
    __syncthreads();
    for (int u = bid * 8 + wid; u < DEPTH * 2944; u += nblk * 8) {
        const int l = u / 2944; int t = u % 2944;
        if (t < 2048) tr_cvt_tile_w(P.w_in + (size_t)l * D * INC + 256, INC, (bf16_t*)(P.ws + OFF_W1T) + (size_t)l * 4096 * D, D, 4096, t, lw, lane);
        else if (t < 2560) tr_cvt_tile_w(P.w_out + (size_t)l * D * D, D, (bf16_t*)(P.ws + OFF_WOT) + (size_t)l * D * D, D, D, t - 2048, lw, lane);
        else if (t < 2688) tr_cvt_tile_w(P.fourier_w + (size_t)l * 256 * D, D, (bf16_t*)(P.ws + OFF_WMT) + (size_t)l * D * D, D, D, t - 2560, lw, lane);
        else tr_cvt_tile_w(P.attn_proj + (size_t)l * 512 * D, D, (bf16_t*)(P.ws + OFF_WMT) + (size_t)l * D * D + 512, D, D, t - 2688, lw, lane);
    }
    __syncthreads();
}
__device__ __forceinline__ void ph_wft(const Params& P, int bid, int nblk, float* lds) {
    const int TID = tidx();
    const int tid = TID, lane = TID & 63, r = lane & 31, hi = lane >> 5; const int wid = __builtin_amdgcn_readfirstlane(TID >> 6);
    __syncthreads();
    if (tid < 64) { float s, c; sincospif((float)tid * (1.0f / 32.0f), &s, &c); lds[tid] = c; lds[64 + tid] = s; }
    __syncthreads();
    bf16_t* W = (bf16_t*)(P.ws + OFF_WFT);
    for (int u = bid * 8 + wid; u < DEPTH * 512; u += nblk * 8) {
        const int kt = u & 31, jt = (u >> 5) & 1, part = (u >> 6) & 1, g = (u >> 7) & 3, l = u >> 9;
        const float* tab = lds + part * 64; const int j = jt * 32 + r;
        const float* bp = P.w_in + ((size_t)l * D + kt * 32 + r) * INC + g * 64;
        f32x4 bv[16];
#pragma unroll
        for (int q = 0; q < 16; ++q) bv[q] = *(const f32x4*)(bp + 4 * q);
        f32x16 acc;
#pragma unroll
        for (int q = 0; q < 16; ++q) acc[q] = 0.f;
#pragma unroll
        for (int s2 = 0; s2 < 32; ++s2) { const float a = tab[((2 * s2 + hi) * j) & 63]; const f32x4 b4 = bv[s2 >> 1];
            const float bb = (s2 & 1) ? (hi ? b4.w : b4.z) : (hi ? b4.y : b4.x);
            acc = __builtin_amdgcn_mfma_f32_32x32x2f32(a, bb, acc, 0, 0, 0); }
#pragma unroll
        for (int q = 0; q < 16; ++q) { const int jj = jt * 32 + 8 * (q >> 2) + 4 * hi + (q & 3);
            W[((size_t)l * 512 + part * 256 + g * 64 + jj) * D + kt * 32 + r] = (bf16_t)(pk_bf16(acc[q], 0.f) & 0xffff); }
    }
    __syncthreads();
}
__device__ __forceinline__ unsigned pk_fp8x4(float a, float b, float c, float d) { int w = __builtin_amdgcn_cvt_pk_fp8_f32(a, b, 0, false); w = __builtin_amdgcn_cvt_pk_fp8_f32(c, d, w, true); return (unsigned)w; }
__device__ __forceinline__ void ph_wg8(const Params& P, int bid, int nblk, float* lds) {
    const int TID = tidx(); const int wid = __builtin_amdgcn_readfirstlane(TID >> 6), lane = TID & 63;
    float* lw = lds + wid * (32 * 65);
    __syncthreads();
    for (int u = bid * 8 + wid; u < DEPTH * 1536; u += nblk * 8) {
        const int l = u / 1536, t = u % 1536; const int k0 = (t / 48) * 32, n0 = (t % 48) * 64;
        const float* src = P.w_in + (size_t)l * D * INC + 1280; unsigned char* dst = P.ws + OFF_WG8 + (size_t)l * 3072 * D;
        float v[32];
#pragma unroll
        for (int kk = 0; kk < 32; ++kk) v[kk] = src[(size_t)(k0 + kk) * INC + n0 + lane];
#pragma unroll
        for (int kk = 0; kk < 32; ++kk) lw[kk * 65 + lane] = v[kk] * G8_SCALE;
        asm volatile("s_waitcnt lgkmcnt(0)" ::: "memory");
#pragma unroll
        for (int it = 0; it < 2; ++it) { const int row = it * 32 + (lane >> 1), ch = (lane & 1) * 16; u32x4 o;
            o.x = pk_fp8x4(lw[(ch + 0) * 65 + row], lw[(ch + 1) * 65 + row], lw[(ch + 2) * 65 + row], lw[(ch + 3) * 65 + row]);
            o.y = pk_fp8x4(lw[(ch + 4) * 65 + row], lw[(ch + 5) * 65 + row], lw[(ch + 6) * 65 + row], lw[(ch + 7) * 65 + row]);
            o.z = pk_fp8x4(lw[(ch + 8) * 65 + row], lw[(ch + 9) * 65 + row], lw[(ch + 10) * 65 + row], lw[(ch + 11) * 65 + row]);
            o.w = pk_fp8x4(lw[(ch + 12) * 65 + row], lw[(ch + 13) * 65 + row], lw[(ch + 14) * 65 + row], lw[(ch + 15) * 65 + row]);
            *(u32x4*)(dst + (size_t)(n0 + row) * D + k0 + ch) = o; }
        asm volatile("s_waitcnt lgkmcnt(0)" ::: "memory");
    }
    __syncthreads();
}
__device__ __forceinline__ void ph_wpool(const Params& P, int bid, int nblk, float* lds) {
    const int TID = tidx();
    bf16_t* W = (bf16_t*)(P.ws + OFF_WMT);
    for (int u = bid; u < DEPTH * 4 * 16; u += nblk) {
        const int nc = u & 15, g = (u >> 4) & 3, l = u >> 6; const int n = nc * 64 + (TID & 63), c0 = (TID >> 6) * 8;
        __syncthreads();
        for (int i = TID; i < 64 * 64; i += 512) lds[i] = P.pool_w[(size_t)(l * 4 + g) * 4096 + i];
        __syncthreads();
        float pr[64];
#pragma unroll
        for (int e = 0; e < 64; ++e) pr[e] = P.pool_proj[((size_t)l * 256 + g * 64 + e) * D + n] * P.pool_scale[l * 256 + g * 64 + e];
        float a[8];
#pragma unroll
        for (int c = 0; c < 8; ++c) { a[c] = 0.f;
#pragma unroll
            for (int e = 0; e < 64; ++e) a[c] += lds[(c0 + c) * 64 + e] * pr[e]; }
        u32x4 o; o.x = pk_bf16(a[0], a[1]); o.y = pk_bf16(a[2], a[3]); o.z = pk_bf16(a[4], a[5]); o.w = pk_bf16(a[6], a[7]);
        *(u32x4*)(W + ((size_t)l * D + n) * D + 256 + g * 64 + c0) = o;
    }
}
__device__ __forceinline__ void ph_wst(const Params& P, int bid, int nblk, int l0, int l1) {
    const int TID = tidx();
    bf16_t* W = (bf16_t*)(P.ws + OFF_WST);
    const int wid = __builtin_amdgcn_readfirstlane(TID >> 6), lane = TID & 63, r = lane & 31, hi = lane >> 5;
    for (int u = l0 * 2048 + bid * 8 + wid; u < l1 * 2048; u += nblk * 8) {
        const int kt = u & 31, jt = (u >> 5) & 3, hp = (u >> 7) & 15, l = u >> 11;
        const float* ap = P.peer_keys + ((size_t)(l * 16 + hp) * 128 + jt * 32 + r) * 128;
        const float* bp = P.peer_wq + ((size_t)l * D + kt * 32 + r) * 2048 + hp * 128;
        f32x16 acc;
#pragma unroll
        for (int q = 0; q < 16; ++q) acc[q] = 0.f;
#pragma unroll 1
        for (int q0 = 0; q0 < 32; q0 += 8) { f32x4 av[8], bv[8];
#pragma unroll
            for (int q = 0; q < 8; ++q) { av[q] = *(const f32x4*)(ap + 4 * (q0 + q)); bv[q] = *(const f32x4*)(bp + 4 * (q0 + q)); }
#pragma unroll
            for (int q = 0; q < 8; ++q) {
                acc = __builtin_amdgcn_mfma_f32_32x32x2f32(hi ? av[q].y : av[q].x, hi ? bv[q].y : bv[q].x, acc, 0, 0, 0);
                acc = __builtin_amdgcn_mfma_f32_32x32x2f32(hi ? av[q].w : av[q].z, hi ? bv[q].w : bv[q].z, acc, 0, 0, 0); } }
#pragma unroll
        for (int q = 0; q < 16; ++q) { const int j = jt * 32 + 8 * (q >> 2) + 4 * hi + (q & 3);
            W[((size_t)l * 2048 + hp * 128 + j) * D + kt * 32 + r] = (bf16_t)(pk_bf16(acc[q], 0.f) & 0xffff); }
    }
}
constexpr float U_SCALE = 64.0f, V_SCALE = 8.0f;
__device__ __forceinline__ void ph_peer_cvt(const Params& P, int bid, int nblk, int l0, int l1, int w0 = 0, int w1 = 2) {
    const int TID = tidx();
    const size_t per = (size_t)NEXP * D / 16, nbeg = (size_t)l0 * per, n16 = (size_t)l1 * per;
    for (int w = w0; w < w1; ++w) {
        const f32x4* s = (const f32x4*)(w ? P.peer_v : P.peer_u); unsigned char* d = P.ws + (w ? OFF_PV : OFF_PU); const float sc = w ? V_SCALE : U_SCALE;
        for (size_t i = nbeg + (size_t)bid * 512 + TID; i < n16; i += (size_t)nblk * 512) {
            const f32x4 a = __builtin_nontemporal_load(s + 4 * i), b = __builtin_nontemporal_load(s + 4 * i + 1), c = __builtin_nontemporal_load(s + 4 * i + 2), e4 = __builtin_nontemporal_load(s + 4 * i + 3);
            u32x4 o; o.x = pk_fp8x4(a.x * sc, a.y * sc, a.z * sc, a.w * sc); o.y = pk_fp8x4(b.x * sc, b.y * sc, b.z * sc, b.w * sc); o.z = pk_fp8x4(c.x * sc, c.y * sc, c.z * sc, c.w * sc); o.w = pk_fp8x4(e4.x * sc, e4.y * sc, e4.z * sc, e4.w * sc);
            const size_t row = i >> 6; const int c16 = (int)(i & 63);
            const size_t l = row >> 14, e = row & (NEXP - 1);
            *(u32x4*)(d + (((l * 8 + (c16 >> 3)) * NEXP + e) * 128 + (c16 & 7) * 16)) = o; }
    }
}

__device__ __forceinline__ void ph_norm(const Params& P, int l, int which, int nrows, int bid, int nblk, const bool from_input = false) {
    const int TID = tidx();
    const int wid = __builtin_amdgcn_readfirstlane(TID >> 6), lane = TID & 63;
    const float* gain = (which ? P.norm_ffn : P.norm_mix) + l * D;
    bf16_t* HB = (bf16_t*)(P.ws + OFF_HB);
    f32x4 gg[4];
#pragma unroll
    for (int i = 0; i < 4; ++i) gg[i] = *(const f32x4*)(gain + i * 256 + lane * 4);
    const int stride = nblk * 8;
    for (int row0 = bid * 8 + wid; row0 < nrows; row0 += 2 * stride) {
        f32x4 v[2][4], sa[2][4], sb[2][4];
#pragma unroll
        for (int h = 0; h < 2; ++h) { const int row = min(row0 + h * stride, nrows - 1);
            const float* xr = from_input ? (row < NL ? P.x + (size_t)row * D : P.ctx + (size_t)(row - NL) * D) : xrow_ptr(P, row); const int r = mod_r(row);
            const float* sh = mod_ptr(P, l, r, which ? 3 : 0); const float* sc = mod_ptr(P, l, r, which ? 4 : 1);
#pragma unroll
            for (int i = 0; i < 4; ++i) { v[h][i] = *(const f32x4*)(xr + i * 256 + lane * 4); sa[h][i] = *(const f32x4*)(sc + i * 256 + lane * 4); sb[h][i] = *(const f32x4*)(sh + i * 256 + lane * 4); } }
        asm volatile("" : "+v"(v[0][0]), "+v"(v[0][1]), "+v"(v[0][2]), "+v"(v[0][3]), "+v"(v[1][0]), "+v"(v[1][1]), "+v"(v[1][2]), "+v"(v[1][3]));
#pragma unroll
        for (int h = 0; h < 2; ++h) { const int row = row0 + h * stride;
            float ss = 0.f;
#pragma unroll
            for (int i = 0; i < 4; ++i) ss += v[h][i].x * v[h][i].x + v[h][i].y * v[h][i].y + v[h][i].z * v[h][i].z + v[h][i].w * v[h][i].w;
            ss = wave_sum(ss); const float rstd = rsqrtf(ss * (1.0f / D) + EPS);
            if (row < nrows) {
#pragma unroll
                for (int i = 0; i < 4; ++i) { const int c = i * 256 + lane * 4; const f32x4 g = gg[i], a = sa[h][i], b = sb[h][i];
                    const float o0 = v[h][i].x * rstd * g.x * (1.f + a.x) + b.x, o1 = v[h][i].y * rstd * g.y * (1.f + a.y) + b.y, o2 = v[h][i].z * rstd * g.z * (1.f + a.z) + b.z, o3 = v[h][i].w * rstd * g.w * (1.f + a.w) + b.w;
                    u32x2 o; o.x = pk_bf16(o0, o1); o.y = pk_bf16(o2, o3); *(u32x2*)(HB + (size_t)row * D + c) = o;
                    if (!which) *(unsigned*)(P.ws + OFF_HB8 + (size_t)row * D + c) = pk_fp8x4(o0, o1, o2, o3); }
            }
        }
    }
}

__device__ __forceinline__ void ph_l3(const Params& P, int l, int bid, int nblk) {
    const int TID = tidx();
    const float* rc = (const float*)(P.ws + OFF_ROPE); const float* rs = rc + SEQ * 32;
    {
        const int sub = TID & 7; const bool hi_half = (sub & 2) != 0;
        const f32x4 gq0 = *(const f32x4*)(P.q_norm + l * 64 + sub * 8), gq1 = *(const f32x4*)(P.q_norm + l * 64 + sub * 8 + 4), gk0 = *(const f32x4*)(P.k_norm + l * 64 + sub * 8), gk1 = *(const f32x4*)(P.k_norm + l * 64 + sub * 8 + 4);
        const int stride = nblk * 64, NI = NT * 10;
        for (int i0 = (bid * 512 + TID) >> 3; i0 < NI; i0 += 4 * stride) {
            u32x4 vv[4]; f32x4 rc0[4], rc1[4], rs0[4], rs1[4]; bf16_t* pp[4];
#pragma unroll
            for (int b4 = 0; b4 < 4; ++b4) { const int i = min(i0 + b4 * stride, NI - 1); const int row = i / 10, slot = i - row * 10; const bool isq = slot < 8;
                pp[b4] = (isq ? (bf16_t*)(P.ws + OFF_QR) + (size_t)row * 512 + slot * 64 : (bf16_t*)(P.ws + OFF_KALL) + (size_t)kv_row(row) * 128 + (slot - 8) * 64) + sub * 8;
                vv[b4] = *(const u32x4*)pp[b4];
                const int tix = (row & 2047) * 32 + (sub >> 2) * 16 + (sub & 1) * 8;
                rc0[b4] = *(const f32x4*)(rc + tix); rc1[b4] = *(const f32x4*)(rc + tix + 4); rs0[b4] = *(const f32x4*)(rs + tix); rs1[b4] = *(const f32x4*)(rs + tix + 4); }
            asm volatile("" : "+v"(vv[0]), "+v"(vv[1]), "+v"(vv[2]), "+v"(vv[3]));
#pragma unroll
            for (int b4 = 0; b4 < 4; ++b4) { const int i = i0 + b4 * stride; const int ic = min(i, NI - 1); const int row = ic / 10, slot = ic - row * 10; const bool isq = slot < 8;
                const unsigned v0 = vv[b4].x, v1 = vv[b4].y, v2 = vv[b4].z, v3 = vv[b4].w;
                float x[8] = {bf_lo(v0), bf_hi(v0), bf_lo(v1), bf_hi(v1), bf_lo(v2), bf_hi(v2), bf_lo(v3), bf_hi(v3)};
                float ss = 0.f;
#pragma unroll
                for (int d = 0; d < 8; ++d) ss += x[d] * x[d];
                ss = sum8(ss);
                const float rstd = rsqrtf(ss * (1.0f / 64.0f) + EPS) * (isq ? C2 : 1.0f);
                const f32x4 g0 = isq ? gq0 : gk0, g1 = isq ? gq1 : gk1;
                x[0] *= rstd * g0.x; x[1] *= rstd * g0.y; x[2] *= rstd * g0.z; x[3] *= rstd * g0.w; x[4] *= rstd * g1.x; x[5] *= rstd * g1.y; x[6] *= rstd * g1.z; x[7] *= rstd * g1.w;
                {
                    const f32x4 c0 = rc0[b4], c1 = rc1[b4], s0 = rs0[b4], s1 = rs1[b4]; const bool lat = row < NL;
                    const float cc[8] = {c0.x, c0.y, c0.z, c0.w, c1.x, c1.y, c1.z, c1.w}, sn[8] = {s0.x, s0.y, s0.z, s0.w, s1.x, s1.y, s1.z, s1.w};
#pragma unroll
                    for (int d = 0; d < 8; ++d) { const float other = DPP_F(x[d], 0x4E);
                        const float r = hi_half ? (x[d] * cc[d] + other * sn[d]) : (x[d] * cc[d] - other * sn[d]); x[d] = lat ? r : x[d]; }
                }
                u32x4 o; o.x = pk_bf16(x[0], x[1]); o.y = pk_bf16(x[2], x[3]); o.z = pk_bf16(x[4], x[5]); o.w = pk_bf16(x[6], x[7]);
                if (i < NI) *(u32x4*)pp[b4] = o;
            }
        }
    }
    const bf16_t* PP = (const bf16_t*)(P.ws + OFF_PP); bf16_t* MIX = (bf16_t*)(P.ws + OFF_MIX);
    for (int i = bid * 512 + TID; i < NT * 32; i += nblk * 512) {
        const int row = i >> 5, ch = (i & 31) * 8, g = ch >> 6, win = 2 << g;
        int base, t, L; if (row < NL) { base = row & ~2047; t = row & 2047; L = SEQ; } else { base = NL + ((row - NL) & ~255); t = (row - NL) & 255; L = CTX; }
        const int lo = max(t - win / 2, 0), hi = min(t + win - win / 2, L);
        float s[8];
#pragma unroll
        for (int q = 0; q < 8; ++q) s[q] = 0.f;
        u32x4 wv[16];
#pragma unroll
        for (int k = 0; k < 16; ++k) wv[k] = *(const u32x4*)(PP + (size_t)(base + min(lo + k, hi - 1)) * 256 + ch);
#pragma unroll
        for (int k = 0; k < 16; ++k) { const float w = lo + k < hi ? 1.0f : 0.0f; const unsigned a0 = wv[k].x, a1 = wv[k].y, a2 = wv[k].z, a3 = wv[k].w;
            s[0] += w * bf_lo(a0); s[1] += w * bf_hi(a0); s[2] += w * bf_lo(a1); s[3] += w * bf_hi(a1); s[4] += w * bf_lo(a2); s[5] += w * bf_hi(a2); s[6] += w * bf_lo(a3); s[7] += w * bf_hi(a3); }
        const float inv = 1.0f / (float)(hi - lo); const u32x4 me = *(const u32x4*)(PP + (size_t)row * 256 + ch);
        u32x4 o; o.x = pk_bf16(s[0] * inv - bf_lo(me.x), s[1] * inv - bf_hi(me.x)); o.y = pk_bf16(s[2] * inv - bf_lo(me.y), s[3] * inv - bf_hi(me.y));
        o.z = pk_bf16(s[4] * inv - bf_lo(me.z), s[5] * inv - bf_hi(me.z)); o.w = pk_bf16(s[6] * inv - bf_lo(me.w), s[7] * inv - bf_hi(me.w));
        *(u32x4*)(MIX + (size_t)row * D + 256 + ch) = o;
    }
}

__device__ __forceinline__ int fkey(float v) { const int b = __float_as_int(v); return b ^ ((b >> 31) & 0x7fffffff); }
__device__ __forceinline__ float kval(int k) { return __int_as_float(k ^ ((k >> 31) & 0x7fffffff)); }
__device__ __forceinline__ float kval16(int k) { const int s = k >> 16; return __int_as_float((s ^ ((s >> 31) & 0x7fff)) << 16); }
#define CE_DESC(a, b) do { const int hi_ = max(a, b), lo_ = min(a, b); a = hi_; b = lo_; } while (0)
__device__ __forceinline__ void bitonic_merge16(int (&a)[16]) {
#pragma unroll
    for (int j = 8; j > 0; j >>= 1)
#pragma unroll
        for (int i = 0; i < 16; ++i) { const int l = i ^ j; if (l > i) CE_DESC(a[i], a[l]); }
}
__device__ __forceinline__ void bitonic_sort16(int (&a)[16]) {
#pragma unroll
    for (int k = 2; k <= 16; k <<= 1)
#pragma unroll
        for (int j = k >> 1; j > 0; j >>= 1)
#pragma unroll
            for (int i = 0; i < 16; ++i) { const int l = i ^ j; if (l > i) { if ((i & k) == 0 || k == 16) CE_DESC(a[i], a[l]); else CE_DESC(a[l], a[i]); } }
}
__device__ __forceinline__ void top16_merge(int (&run)[16], int (&c)[16]) {
    bitonic_sort16(c);
#pragma unroll
    for (int i = 0; i < 16; ++i) run[i] = max(run[i], c[15 - i]);
    bitonic_merge16(run);
}
__device__ __forceinline__ void ph_topk(const Params& P, int ntok, int bid, int nblk, unsigned char* lds) {
    const int TID = tidx();
    const int wid = __builtin_amdgcn_readfirstlane(TID >> 6), lane = TID & 63;
    const bf16_t* ST = (const bf16_t*)(P.ws + OFF_ST); unsigned* EID = (unsigned*)(P.ws + OFF_EID); float* GW = (float*)(P.ws + OFF_GW);
    unsigned char* myl = lds + TID * 36;
    for (int u = bid * 8 + wid; u < (ntok / 64) * 8; u += nblk * 8) {
        const int h = u & 7, tok = (u >> 3) * 64 + lane;
        int l1[16], l2[16];
        const bf16_t* s1 = ST + (size_t)(h * 256) * NT + tok; const bf16_t* s2 = s1 + (size_t)128 * NT;
        unsigned fa[16], fb[16];
#pragma unroll
        for (int q = 0; q < 16; ++q) { fa[q] = s1[(size_t)q * NT]; fb[q] = s2[(size_t)q * NT]; }
#pragma unroll 1
        for (int j0 = 0; j0 < 128; j0 += 16) {
            int a[16], b[16];
#pragma unroll
            for (int q = 0; q < 16; ++q) { a[q] = (int)((fa[q] << 16) | (unsigned)(127 - (j0 + q))); b[q] = (int)((fb[q] << 16) | (unsigned)(127 - (j0 + q))); }
            const int jn = j0 + 16 < 128 ? j0 + 16 : j0;
#pragma unroll
            for (int q = 0; q < 16; ++q) { fa[q] = s1[(size_t)(jn + q) * NT]; fb[q] = s2[(size_t)(jn + q) * NT]; }
            if (j0 == 0) { bitonic_sort16(a); bitonic_sort16(b);
#pragma unroll
                for (int i = 0; i < 16; ++i) { l1[i] = a[i]; l2[i] = b[i]; } }
            else { top16_merge(l1, a); top16_merge(l2, b); }
        }
        float v1[16], v2[16];
#pragma unroll
        for (int i = 0; i < 16; ++i) { v1[i] = kval16(l1[i]); v2[i] = kval16(l2[i]); myl[i] = (unsigned char)(127 - (l1[i] & 127)); myl[16 + i] = (unsigned char)(127 - (l2[i] & 127)); }
        int cd[64];
        { int n = 0;
#pragma unroll
          for (int i = 0; i < 16; ++i)
#pragma unroll
              for (int j = 0; j < 16; ++j) if ((i + 1) * (j + 1) <= 16) { cd[n] = (fkey(v1[i] + v2[j]) & ~255) | (255 - (i * 16 + j)); ++n; }
#pragma unroll
          for (int q = 50; q < 64; ++q) cd[q] = INT_MIN; }
        int l3[16], c[16];
#pragma unroll
        for (int q = 0; q < 16; ++q) l3[q] = cd[q];
#pragma unroll
        for (int q = 0; q < 8; ++q) c[q] = cd[16 + q];
        c[8] = INT_MIN; c[9] = INT_MIN; c[10] = INT_MIN; c[11] = cd[28]; c[12] = cd[27]; c[13] = cd[26]; c[14] = cd[25]; c[15] = cd[24];
        bitonic_merge16(c);
#pragma unroll
        for (int i = 0; i < 16; ++i) l3[i] = max(l3[i], c[15 - i]);
        bitonic_merge16(l3);
#pragma unroll
        for (int q = 0; q < 13; ++q) c[q] = cd[29 + q];
        c[13] = INT_MIN; c[14] = INT_MIN; c[15] = INT_MIN;
        top16_merge(l3, c);
#pragma unroll
        for (int i = 0; i < 8; ++i) l3[8 + i] = max(l3[8 + i], cd[49 - i]);
        bitonic_merge16(l3);
        float t[16]; float sum = 0.f; const float t0 = kval((l3[0] & ~255) | 128);
#pragma unroll
        for (int k = 0; k < 16; ++k) { t[k] = __expf(kval((l3[k] & ~255) | 128) - t0); sum += t[k]; }
        const float inv = 1.0f / sum;
        int e[16];
#pragma unroll
        for (int k = 0; k < 16; ++k) { const int pos = 255 - (l3[k] & 255); e[k] = (int)myl[pos >> 4] * 128 + (int)myl[16 + (pos & 15)]; t[k] *= inv; }
#pragma unroll
        for (int k = 0; k < 16; k += 4) *(f32x4*)(GW + (size_t)tok * 128 + h * 16 + k) = (f32x4){t[k], t[k + 1], t[k + 2], t[k + 3]};
#pragma unroll
        for (int k = 0; k < 16; k += 8) *(u32x4*)(EID + (size_t)tok * 64 + h * 8 + (k >> 1)) = (u32x4){(unsigned)e[k] | ((unsigned)e[k + 1] << 16), (unsigned)e[k + 2] | ((unsigned)e[k + 3] << 16), (unsigned)e[k + 4] | ((unsigned)e[k + 5] << 16), (unsigned)e[k + 6] | ((unsigned)e[k + 7] << 16)};
    }
}

constexpr size_t OFF_PB = OFF_ST;
constexpr size_t OFF_CV = OFF_ST + 144 * MiB;
__device__ __forceinline__ int id16(const u32x4& a, const u32x4& b, int it) {
    const unsigned w = it < 8 ? (it < 4 ? (it < 2 ? a.x : a.y) : (it < 6 ? a.z : a.w)) : (it < 12 ? (it < 10 ? b.x : b.y) : (it < 14 ? b.z : b.w));
    return (it & 1) ? (int)(w >> 16) : (int)(w & 0xffffu);
}
__device__ __forceinline__ void unpk_fp8x16p(const u32x4& w, f32x2_t (&f)[8]) {
    const unsigned d0 = w.x, d1 = w.y, d2 = w.z, d3 = w.w;
    f[0] = __builtin_amdgcn_cvt_pk_f32_fp8((int)d0, false); f[1] = __builtin_amdgcn_cvt_pk_f32_fp8((int)d0, true); f[2] = __builtin_amdgcn_cvt_pk_f32_fp8((int)d1, false); f[3] = __builtin_amdgcn_cvt_pk_f32_fp8((int)d1, true);
    f[4] = __builtin_amdgcn_cvt_pk_f32_fp8((int)d2, false); f[5] = __builtin_amdgcn_cvt_pk_f32_fp8((int)d2, true); f[6] = __builtin_amdgcn_cvt_pk_f32_fp8((int)d3, false); f[7] = __builtin_amdgcn_cvt_pk_f32_fp8((int)d3, true);
}
__device__ __forceinline__ void unpk_fp8x16(const u32x4& w, float (&f)[16]) {
    const unsigned d0 = w.x, d1 = w.y, d2 = w.z, d3 = w.w;
    f32x2_t t;
    t = __builtin_amdgcn_cvt_pk_f32_fp8((int)d0, false); f[0] = t.x; f[1] = t.y; t = __builtin_amdgcn_cvt_pk_f32_fp8((int)d0, true); f[2] = t.x; f[3] = t.y;
    t = __builtin_amdgcn_cvt_pk_f32_fp8((int)d1, false); f[4] = t.x; f[5] = t.y; t = __builtin_amdgcn_cvt_pk_f32_fp8((int)d1, true); f[6] = t.x; f[7] = t.y;
    t = __builtin_amdgcn_cvt_pk_f32_fp8((int)d2, false); f[8] = t.x; f[9] = t.y; t = __builtin_amdgcn_cvt_pk_f32_fp8((int)d2, true); f[10] = t.x; f[11] = t.y;
    t = __builtin_amdgcn_cvt_pk_f32_fp8((int)d3, false); f[12] = t.x; f[13] = t.y; t = __builtin_amdgcn_cvt_pk_f32_fp8((int)d3, true); f[14] = t.x; f[15] = t.y;
}
__device__ __forceinline__ unsigned rowoff16(const u32x4 (&id)[2], int it, unsigned lo16, unsigned c128) {
    const u32x4 v4 = id[it >> 3]; const int e = (it >> 1) & 3; const unsigned w = e == 0 ? v4.x : e == 1 ? v4.y : e == 2 ? v4.z : v4.w; unsigned r;
    if (it & 1) asm("v_mad_u32_u16 %0, %1, %2, %3 op_sel:[1,0,0,0]" : "=v"(r) : "v"(w), "v"(c128), "v"(lo16));
    else        asm("v_mad_u32_u16 %0, %1, %2, %3" : "=v"(r) : "v"(w), "v"(c128), "v"(lo16));
    return r;
}
__device__ __forceinline__ void ph_peer_u(const Params& P, int l, int ntok, int bid, int nblk) {
    const int TID = tidx(); const int wid = __builtin_amdgcn_readfirstlane(TID >> 6), lane = TID & 63, c8 = lane & 7, q = lane >> 3;
    const int grp = bid & 7, nw = (nblk >> 3) * 8, w0 = (bid >> 3) * 8 + wid;
    if (w0 >= ntok) return;
    const int tl = w0 + ((ntok - 1 - w0) / nw) * nw;
    const bf16_t* HB = (const bf16_t*)(P.ws + OFF_HB) + grp * 128 + c8 * 16; const unsigned* EID = (const unsigned*)(P.ws + OFF_EID) + q * 8; unsigned c128 = 128u; asm volatile("" : "+v"(c128));
    float* PB = (float*)(P.ws + OFF_PB) + (size_t)grp * NT * 128 + lane;
    const unsigned char* Tu = P.ws + OFF_PU + ((size_t)(l * 8 + grp) * NEXP) * 128;
    const unsigned lo16 = (unsigned)c8 * 16u;
    u32x4 buf[16], idN[2], idNN[2], xaC, xbC, xaN, xbN, xaNN, xbNN;
#define PU_LOADI(T, ID, XA, XB) do { const int T_ = min((T), tl); _Pragma("unroll") for (int i_ = 0; i_ < 2; ++i_) ID[i_] = *(const u32x4*)(EID + (size_t)T_ * 64 + i_ * 4); XA = *(const u32x4*)(HB + (size_t)T_ * D); XB = *(const u32x4*)(HB + (size_t)T_ * D + 8); } while (0)
    { u32x4 id0[2]; PU_LOADI(w0, id0, xaC, xbC);
#pragma unroll
      for (int it = 0; it < 16; ++it) buf[it] = *(const u32x4*)(Tu + rowoff16(id0, it, lo16, c128)); }
    PU_LOADI(w0 + nw, idN, xaN, xbN);
    for (int t0 = w0; t0 < ntok; t0 += nw) {
        PU_LOADI(t0 + 2 * nw, idNN, xaNN, xbNN);
        const unsigned x0 = xaC.x, x1 = xaC.y, x2 = xaC.z, x3 = xaC.w, x4 = xbC.x, x5 = xbC.y, x6 = xbC.z, x7 = xbC.w;
        const f32x2_t xv[8] = {{bf_lo(x0), bf_hi(x0)}, {bf_lo(x1), bf_hi(x1)}, {bf_lo(x2), bf_hi(x2)}, {bf_lo(x3), bf_hi(x3)}, {bf_lo(x4), bf_hi(x4)}, {bf_lo(x5), bf_hi(x5)}, {bf_lo(x6), bf_hi(x6)}, {bf_lo(x7), bf_hi(x7)}};
        float r0 = 0.f, r1 = 0.f;
#pragma unroll
        for (int it = 0; it < 16; ++it) { f32x2_t uf[8]; unpk_fp8x16p(buf[it], uf);
            buf[it] = *(const u32x4*)(Tu + rowoff16(idN, it, lo16, c128));
            f32x2_t d = uf[0] * xv[0];
#pragma unroll
            for (int i = 1; i < 8; ++i) d = __builtin_elementwise_fma(uf[i], xv[i], d);
            const float p = sum8(d.x + d.y); if (c8 == (it & 7)) { if (it < 8) r0 = p; else r1 = p; } }
        float* pb = PB + (size_t)t0 * 128; pb[0] = r0; pb[64] = r1;
        xaC = xaN; xbC = xbN; xaN = xaNN; xbN = xbNN;
#pragma unroll
        for (int i = 0; i < 2; ++i) idN[i] = idNN[i];
    }
#undef PU_LOADI
}
__device__ __forceinline__ void ph_peer_a(const Params& P, int ntok, int bid, int nblk) {
    const int TID = tidx(); const int wid = __builtin_amdgcn_readfirstlane(TID >> 6), lane = TID & 63;
    const float* PB = (const float*)(P.ws + OFF_PB); const float* GW = (const float*)(P.ws + OFF_GW); float* CV = (float*)(P.ws + OFF_CV);
    constexpr int TB = 4;
    const int stride = nblk * 8;
    for (int t0 = bid * 8 + wid; t0 < ntok; t0 += TB * stride) {
        float pb[TB][2][8], gw[TB][2];
#pragma unroll
        for (int h = 0; h < TB; ++h) { const int t = min(t0 + h * stride, ntok - 1);
#pragma unroll
            for (int k = 0; k < 2; ++k) {
#pragma unroll
                for (int j = 0; j < 8; ++j) pb[h][k][j] = PB[((size_t)j * NT + t) * 128 + k * 64 + lane];
                gw[h][k] = GW[(size_t)t * 128 + (lane >> 3) * 16 + k * 8 + (lane & 7)]; } }
        asm volatile("" : "+v"(gw[0][0]), "+v"(gw[1][0]), "+v"(gw[2][0]), "+v"(gw[3][0]), "+v"(gw[0][1]), "+v"(gw[1][1]), "+v"(gw[2][1]), "+v"(gw[3][1]));
#pragma unroll
        for (int h = 0; h < TB; ++h) { const int t = t0 + h * stride;
            if (t < ntok) {
#pragma unroll
                for (int k = 0; k < 2; ++k) { float a = 0.f;
#pragma unroll
                    for (int j = 0; j < 8; ++j) a += pb[h][k][j];
                    const int p = (lane >> 3) * 16 + k * 8 + (lane & 7);
                    CV[(size_t)t * 128 + p] = gw[h][k] * gelu_tanh(a * (1.0f / U_SCALE)) * (1.0f / V_SCALE); } } }
    }
}
__device__ __forceinline__ float red16(float a, float b) { auto r = __builtin_amdgcn_permlane16_swap(__builtin_bit_cast(unsigned, a), __builtin_bit_cast(unsigned, b), false, false); return __builtin_bit_cast(float, (unsigned)r[0]) + __builtin_bit_cast(float, (unsigned)r[1]); }
__device__ __forceinline__ float red32(float a, float b) { auto r = __builtin_amdgcn_permlane32_swap(__builtin_bit_cast(unsigned, a), __builtin_bit_cast(unsigned, b), false, false); return __builtin_bit_cast(float, (unsigned)r[0]) + __builtin_bit_cast(float, (unsigned)r[1]); }
__device__ __forceinline__ void ph_peer_v(const Params& P, int l, int ntok, int bid, int nblk, const bool dry = false) {
    const int TID = tidx(); const int wid = __builtin_amdgcn_readfirstlane(TID >> 6), lane = TID & 63, c8 = lane & 7, q = lane >> 3;
    const int grp = bid & 7, nw = (nblk >> 3) * 8, w0 = (bid >> 3) * 8 + wid;
    if (w0 >= ntok) return;
    const int tl = w0 + ((ntok - 1 - w0) / nw) * nw;
    unsigned c128 = 128u; asm volatile("" : "+v"(c128)); const unsigned* EID = (const unsigned*)(P.ws + OFF_EID) + q * 8; const float* CV = (const float*)(P.ws + OFF_CV) + q * 16;
    const unsigned char* Tv = P.ws + OFF_PV + ((size_t)(l * 8 + grp) * NEXP) * 128;
    const unsigned lo16 = (unsigned)c8 * 16u;
    const int xcol = grp * 128 + c8 * 16 + 4 * (lane >> 4);
    const bool writer = (lane & 8) == 0;
    u32x4 buf[16], idN[2], idNN[2]; f32x2_t cvC[8], cvN[8];
#define PV_LOADI(T, ID) do { const int T_ = min((T), tl); _Pragma("unroll") for (int i_ = 0; i_ < 2; ++i_) ID[i_] = *(const u32x4*)(EID + (size_t)T_ * 64 + i_ * 4); } while (0)
#define PV_LOADC(T, CVX) do { const int T_ = min((T), tl); _Pragma("unroll") for (int i_ = 0; i_ < 4; ++i_) { const f32x4 c4_ = *(const f32x4*)(CV + (size_t)T_ * 128 + i_ * 4); CVX[2 * i_] = (f32x2_t){c4_.x, c4_.y}; CVX[2 * i_ + 1] = (f32x2_t){c4_.z, c4_.w}; } } while (0)
    { u32x4 id0[2]; PV_LOADI(w0, id0); PV_LOADC(w0, cvC);
#pragma unroll
      for (int it = 0; it < 16; ++it) buf[it] = *(const u32x4*)(Tv + rowoff16(id0, it, lo16, c128)); }
    PV_LOADI(w0 + nw, idN);
    f32x4 gpre = {0.f, 0.f, 0.f, 0.f}; int rcur = -1;
    for (int t0 = w0; t0 < ntok; t0 += nw) {
        PV_LOADI(t0 + 2 * nw, idNN); PV_LOADC(t0 + nw, cvN);
        float* xp = xrow_ptr(P, t0) + xcol; const float* m5 = mod_ptr(P, l, mod_r(t0), 5) + xcol;
        f32x4 xpre;
        if (!dry && writer) { xpre = *(const f32x4*)xp; const int rr_ = mod_r(t0); if (rr_ != rcur) { gpre = *(const f32x4*)m5; rcur = rr_; } }
        f32x2_t o2[8];
#pragma unroll
        for (int i = 0; i < 8; ++i) o2[i] = (f32x2_t){0.f, 0.f};
#pragma unroll
        for (int it = 0; it < 16; ++it) { f32x2_t vf[8]; unpk_fp8x16p(buf[it], vf);
            buf[it] = *(const u32x4*)(Tv + rowoff16(idN, it, lo16, c128));
#pragma unroll
            for (int i = 0; i < 8; ++i) { if (it & 1) asm("v_pk_fma_f32 %0, %1, %2, %0 op_sel:[0,1,0] op_sel_hi:[1,1,1]" : "+v"(o2[i]) : "v"(vf[i]), "v"(cvC[it >> 1]));
                                          else        asm("v_pk_fma_f32 %0, %1, %2, %0 op_sel_hi:[1,0,1]" : "+v"(o2[i]) : "v"(vf[i]), "v"(cvC[it >> 1])); } }
        float w[16];
#pragma unroll
        for (int i = 0; i < 8; ++i) { const float ox = o2[i].x, oy = o2[i].y; w[2 * i] = ox + DPP_F(ox, 0x128); w[2 * i + 1] = oy + DPP_F(oy, 0x128); }
        float z[4];
#pragma unroll
        for (int j = 0; j < 4; ++j) z[j] = red32(red16(w[j], w[4 + j]), red16(w[8 + j], w[12 + j]));
        if (dry) {
#pragma unroll
            for (int j = 0; j < 4; ++j) asm volatile("" :: "v"(z[j]));
        } else if (writer) {
            f32x4 x = xpre; x.x += gpre.x * z[0]; x.y += gpre.y * z[1]; x.z += gpre.z * z[2]; x.w += gpre.w * z[3]; *(f32x4*)xp = x;
        }
#pragma unroll
        for (int i = 0; i < 8; ++i) cvC[i] = cvN[i];
#pragma unroll
        for (int i = 0; i < 2; ++i) idN[i] = idNN[i];
    }
#undef PV_LOADI
#undef PV_LOADC
}

namespace pg8 {
#define PG8_LAS __attribute__((address_space(3)))
constexpr int BM = 256, BK = 64, HALF = 128, HTB = HALF * BK * 2, STAGE_BYTES = 8 * HTB, NXCD = 8, WGM = 4;
__host__ __device__ __forceinline__ int lds_byte(int r, int c) { const int ch = (c >> 3) ^ ((r >> 1) & 7); return r * 128 + ch * 16 + (c & 7) * 2; }
__host__ __device__ __forceinline__ void stage_rc(int b, int& R, int& C) { R = b >> 7; C = ((((b >> 4) & 7) ^ ((R >> 1) & 7)) << 3) + ((b & 15) >> 1); }
__host__ __device__ __forceinline__ int perm32(int rho) { const int n = rho >> 4, i = rho & 15; return 8 * (i >> 2) + 4 * n + (i & 3); }
struct Unit { int pm, pn, nt, kofs, tag; };
struct Gemm { const bf16_t* A; const bf16_t* Bt; int lda, ldb; };
struct TileOrder {
    int nM, nN, nwg, G, c;
    __device__ __forceinline__ void init(int nM_, int nN_, int G_, int c_) { nM = nM_; nN = nN_; nwg = nM * nN; G = G_; c = c_; }
    __device__ __forceinline__ bool tile(int i, int& pm, int& pn) const {
        const long L = (long)i * G + c; if (L >= nwg) return false;
        int wgid = (int)L; { const int q = nwg / NXCD, r = nwg % NXCD, xcd = wgid % NXCD, off = wgid / NXCD; wgid = (xcd < r ? xcd * (q + 1) : r * (q + 1) + (xcd - r) * q) + off; }
        const int nig = WGM * nN, gid = wgid / nig, fm = gid * WGM, gsz = (nM - fm) < WGM ? (nM - fm) : WGM;
        pm = fm + ((wgid % nig) % gsz); pn = (wgid % nig) / gsz; return true;
    }
};
struct PlainSched { TileOrder T; int nt;
    __device__ __forceinline__ bool next(int i, Unit& u) const { if (!T.tile(i, u.pm, u.pn)) return false; u.nt = nt; u.kofs = 0; u.tag = 0; return true; } };
struct CtxZSched { int c, G, nt;
    __device__ __forceinline__ bool next(int i, Unit& u) const { const int L = i * G + c; if (L >= 32) return false; u.pm = L & 1; u.pn = 128 + (L >> 1); u.nt = nt; u.kofs = 0; u.tag = 0; return true; } };
struct MergeSched { TileOrder T;
    __device__ __forceinline__ bool next(int i, Unit& u) const { const int ti = i / 3, br = i - 3 * ti; if (!T.tile(ti, u.pm, u.pn)) return false;
        u.tag = br; u.nt = br == 2 ? 8 : 4; u.kofs = br == 0 ? 0 : br == 1 ? 512 : 1024; return true; } };

template <class Epi, class Sched, bool FP8 = false>
__device__ __forceinline__ void gemm_phase(PG8_LAS unsigned char* lds, const Gemm g, const Sched& S, const Epi& E) {
    const int TID = tidx();
    const int tid = TID, wid = __builtin_amdgcn_readfirstlane(tid >> 6), lane = tid & 63, wr = wid >> 2, wc = wid & 3, fr = lane & 15, fq = lane >> 4;
    unsigned voffA[2], voffB[2];
#pragma unroll
    for (int i = 0; i < 2; ++i) { int R, C; stage_rc(tid * 16 + i * 8192, R, C); const int Rb = Epi::PERM ? ((R & ~31) + perm32(R & 31)) : R;
        voffA[i] = (unsigned)(R * g.lda + C) * 2u; voffB[i] = (unsigned)(Rb * g.ldb + C) * 2u; }
    const size_t kstep = (size_t)(BK * 2);
    const size_t hstepA = (size_t)HALF * g.lda * 2, hstepB = (size_t)HALF * g.ldb * 2;
    const size_t tstepA = 2 * hstepA, tstepB = 2 * hstepB;
    const unsigned ldsw = (unsigned)wid * 1024u;
    const int aoffk[2] = {lds_byte(wr * 64 + fr, fq * 8), lds_byte(wr * 64 + fr, fq * 8 + 32)}, boffk[2] = {lds_byte(wc * 32 + fr, fq * 8), lds_byte(wc * 32 + fr, fq * 8 + 32)};
#define PG8_SA(b, h) (((b) * 2 + (h)) * HTB)
#define PG8_SB(b, h) ((4 + (b) * 2 + (h)) * HTB)
#define PG8_STAGE(bufoff, gbase, voff) do { _Pragma("unroll") for (int _i = 0; _i < 2; ++_i) \
        __builtin_amdgcn_global_load_lds((const unsigned*)((const char*)(gbase) + (voff)[_i]), (PG8_LAS unsigned*)(lds + (bufoff) + ldsw + _i * 8192), 16, 0, 0); } while (0)
#define PG8_LDA(dst, b, h) do { _Pragma("unroll") for (int m = 0; m < 4; ++m) { if constexpr (FP8) { const i32x4_ lo_ = *(const PG8_LAS i32x4_*)(lds + PG8_SA(b, h) + aoffk[0] + m * 2048), hi_ = *(const PG8_LAS i32x4_*)(lds + PG8_SA(b, h) + aoffk[1] + m * 2048); dst##8[m] = __builtin_shufflevector(lo_, hi_, 0, 1, 2, 3, 4, 5, 6, 7); } \
        else { _Pragma("unroll") for (int k = 0; k < 2; ++k) dst[m][k] = *(const PG8_LAS bf16x8*)(lds + PG8_SA(b, h) + aoffk[k] + m * 2048); } } } while (0)
#define PG8_LDB(dst, b, h) do { _Pragma("unroll") for (int n = 0; n < 2; ++n) { if constexpr (FP8) { const i32x4_ lo_ = *(const PG8_LAS i32x4_*)(lds + PG8_SB(b, h) + boffk[0] + n * 2048), hi_ = *(const PG8_LAS i32x4_*)(lds + PG8_SB(b, h) + boffk[1] + n * 2048); dst##8[n] = __builtin_shufflevector(lo_, hi_, 0, 1, 2, 3, 4, 5, 6, 7); } \
        else { _Pragma("unroll") for (int k = 0; k < 2; ++k) dst[n][k] = *(const PG8_LAS bf16x8*)(lds + PG8_SB(b, h) + boffk[k] + n * 2048); } } } while (0)
#define PG8_MMA(ai, bj, At, Bt) do { __builtin_amdgcn_s_setprio(1); _Pragma("unroll") for (int m = 0; m < 4; ++m) _Pragma("unroll") for (int n = 0; n < 2; ++n) { \
        if constexpr (FP8) asm volatile("v_mfma_scale_f32_16x16x128_f8f6f4 %0, %1, %2, %0, %3, %3 op_sel_hi:[0,0,0]" : "+v"(acc[ai][bj][m][n]) : "v"(Bt##8[n]), "v"(At##8[m]), "v"(scale1));   \
        else { _Pragma("unroll") for (int k = 0; k < 2; ++k) acc[ai][bj][m][n] = __builtin_amdgcn_mfma_f32_16x16x32_bf16(Bt[n][k], At[m][k], acc[ai][bj][m][n], 0, 0, 0); } } \
        __builtin_amdgcn_s_setprio(0); } while (0)
#define PG8_WAIT_V(n) asm volatile("s_waitcnt vmcnt(" #n ")" ::: "memory")
#define PG8_WAIT_L(n) asm volatile("s_waitcnt lgkmcnt(" #n ")" ::: "memory")
#define PG8_BAR __builtin_amdgcn_s_barrier()
#define PG8_SCHED __builtin_amdgcn_sched_barrier(0)
    Unit cur, nxt; int ui = 0;
    if (!S.next(0, cur)) return;
    int scale1 = 0x7F7F7F7F; asm volatile("" : "+v"(scale1));
    f32x4 acc[2][2][4][2];
#pragma unroll
    for (int a = 0; a < 2; ++a)
#pragma unroll
        for (int b = 0; b < 2; ++b)
#pragma unroll
            for (int m = 0; m < 4; ++m)
#pragma unroll
                for (int n = 0; n < 2; ++n) acc[a][b][m][n] = (f32x4){0.f, 0.f, 0.f, 0.f};
    bf16x8 At[4][2], B0[2][2], B1[2][2];
    i32x8 At8[4], B08[2], B18[2];
    const char* cA = (const char*)g.A + (size_t)cur.pm * tstepA + cur.kofs; const char* cB = (const char*)g.Bt + (size_t)cur.pn * tstepB + cur.kofs;
    PG8_STAGE(PG8_SB(0, 0), cB, voffB); PG8_STAGE(PG8_SB(0, 1), cB + hstepB, voffB); PG8_STAGE(PG8_SA(0, 0), cA, voffA); PG8_STAGE(PG8_SA(0, 1), cA + hstepA, voffA);
    if (wr == 1) PG8_BAR;
    PG8_WAIT_V(2); PG8_BAR;
    PG8_STAGE(PG8_SB(1, 0), cB + kstep, voffB); PG8_STAGE(PG8_SA(1, 0), cA + kstep, voffA); PG8_STAGE(PG8_SB(1, 1), cB + hstepB + kstep, voffB);
    PG8_WAIT_V(6); PG8_BAR;
    for (;;) {
        const bool has_next = S.next(ui + 1, nxt);
        const char* nA = has_next ? (const char*)g.A + (size_t)nxt.pm * tstepA + nxt.kofs : cA; const char* nB = has_next ? (const char*)g.Bt + (size_t)nxt.pn * tstepB + nxt.kofs : cB;
        const int nt = cur.nt;
        for (int t = 0; t < nt; t += 2) {
            const bool last = (t == nt - 2);
            const char* a1 = cA + (size_t)(t + 1) * kstep;
            const char* a2 = last ? nA : cA + (size_t)(t + 2) * kstep; const char* b2 = last ? nB : cB + (size_t)(t + 2) * kstep;
            const char* a3 = a2 + kstep; const char* b3 = b2 + kstep;
            PG8_LDB(B0, 0, 0); PG8_LDB(B1, 0, 1); PG8_SCHED; PG8_LDA(At, 0, 0); PG8_STAGE(PG8_SA(1, 1), a1 + hstepA, voffA);
            PG8_WAIT_V(8); PG8_WAIT_L(0); PG8_BAR; PG8_MMA(0, 0, At, B0); PG8_MMA(0, 1, At, B1); PG8_BAR; PG8_SCHED;
            PG8_LDA(At, 0, 1); PG8_STAGE(PG8_SB(0, 0), b2, voffB); PG8_STAGE(PG8_SB(0, 1), b2 + hstepB, voffB); PG8_STAGE(PG8_SA(0, 0), a2, voffA);
            PG8_WAIT_V(8); PG8_WAIT_L(0); PG8_BAR; PG8_MMA(1, 0, At, B0); PG8_MMA(1, 1, At, B1); PG8_BAR; PG8_SCHED;
            PG8_LDB(B0, 1, 0); PG8_LDB(B1, 1, 1); PG8_SCHED; PG8_LDA(At, 1, 0); PG8_STAGE(PG8_SA(0, 1), a2 + hstepA, voffA);
            PG8_WAIT_V(8); PG8_WAIT_L(0); PG8_BAR; PG8_MMA(0, 0, At, B0); PG8_MMA(0, 1, At, B1); PG8_BAR; PG8_SCHED;
            PG8_LDA(At, 1, 1); PG8_STAGE(PG8_SB(1, 0), b3, voffB); PG8_STAGE(PG8_SB(1, 1), b3 + hstepB, voffB); PG8_STAGE(PG8_SA(1, 0), a3, voffA);
            PG8_WAIT_V(8); PG8_WAIT_L(0); PG8_BAR; PG8_MMA(1, 0, At, B0); PG8_MMA(1, 1, At, B1); PG8_BAR; PG8_SCHED;
        }
        if (wr == 0) PG8_BAR;
        if constexpr (FP8) asm volatile("s_nop 15\n\ts_nop 15" ::: "memory");
        E(acc, cur, wr, wc, fr, fq);
        if (!has_next) break;
        if (!E.keeps(cur)) {
#pragma unroll
        for (int a = 0; a < 2; ++a)
#pragma unroll
            for (int b = 0; b < 2; ++b)
#pragma unroll
                for (int m = 0; m < 4; ++m)
#pragma unroll
                    for (int n = 0; n < 2; ++n) acc[a][b][m][n] = (f32x4){0.f, 0.f, 0.f, 0.f};
        }
        cur = nxt; cA = nA; cB = nB; ++ui;
        if (wr == 1) PG8_BAR;
    }
    PG8_WAIT_V(0);
    PG8_BAR;
#undef PG8_SA
#undef PG8_SB
#undef PG8_STAGE
#undef PG8_LDA
#undef PG8_LDB
#undef PG8_MMA
#undef PG8_WAIT_V
#undef PG8_WAIT_L
#undef PG8_BAR
#undef PG8_SCHED
}
__device__ __forceinline__ u32x4 pack8(f32x4 v0, f32x4 v1) { u32x4 w; w.x = pk_bf16(v0[0], v0[1]); w.y = pk_bf16(v0[2], v0[3]); w.z = pk_bf16(v1[0], v1[1]); w.w = pk_bf16(v1[2], v1[3]); return w; }
__device__ __forceinline__ u32x2 pack8u(f32x4 a, f32x4 b) {
    u32x2 w;
    w.x = (unsigned)__builtin_rintf(a[0] * 255.f) | ((unsigned)__builtin_rintf(a[1] * 255.f) << 8) | ((unsigned)__builtin_rintf(a[2] * 255.f) << 16) | ((unsigned)__builtin_rintf(a[3] * 255.f) << 24);
    w.y = (unsigned)__builtin_rintf(b[0] * 255.f) | ((unsigned)__builtin_rintf(b[1] * 255.f) << 8) | ((unsigned)__builtin_rintf(b[2] * 255.f) << 16) | ((unsigned)__builtin_rintf(b[3] * 255.f) << 24);
    return w;
}
__device__ __forceinline__ void unpk8u(u32x2 w, float (&f)[8]) {
    const unsigned x = w.x, y = w.y; const float k = 1.0f / 255.0f;
    f[0] = (float)(x & 255u) * k; f[1] = (float)((x >> 8) & 255u) * k; f[2] = (float)((x >> 16) & 255u) * k; f[3] = (float)(x >> 24) * k;
    f[4] = (float)(y & 255u) * k; f[5] = (float)((y >> 8) & 255u) * k; f[6] = (float)((y >> 16) & 255u) * k; f[7] = (float)(y >> 24) * k;
}
__device__ __forceinline__ f32x4 sig4(f32x4 v) { return (f32x4){sigmoidf_(v[0]), sigmoidf_(v[1]), sigmoidf_(v[2]), sigmoidf_(v[3])}; }
struct EpiG1 {
    static constexpr bool PERM = true; __device__ __forceinline__ bool keeps(const Unit&) const { return false; } unsigned char* ws;
    __device__ __forceinline__ void operator()(const f32x4 (&acc)[2][2][4][2], const Unit& u, int wr, int wc, int fr, int fq) const {
        const int rl = wr * 64 + fr, cl = wc * 32 + 8 * fq; const int row0 = u.pm * BM + rl;
        const int kvb = (u.pm < 128 ? (u.pm >> 3) * KV + (u.pm & 7) * 256 : (u.pm - 128) * KV + SEQ) + rl;
#pragma unroll
        for (int ai = 0; ai < 2; ++ai)
#pragma unroll
            for (int m = 0; m < 4; ++m) { const int ro = ai * HALF + m * 16;
#pragma unroll
                for (int bj = 0; bj < 2; ++bj) { const f32x4 v0 = acc[ai][bj][m][0], v1 = acc[ai][bj][m][1];
                    if (u.pn == 0) *(u32x4*)((bf16_t*)(ws + OFF_PP) + (size_t)(row0 + ro) * 256 + bj * HALF + cl) = pack8(v0, v1);
                    else if (u.pn < 3) *(u32x4*)((bf16_t*)(ws + OFF_QR) + (size_t)(row0 + ro) * 512 + (u.pn - 1) * 256 + bj * HALF + cl) = pack8(v0, v1);
                    else if (u.pn == 3) *(u32x4*)((bf16_t*)(ws + (bj ? OFF_VALL : OFF_KALL)) + (size_t)(kvb + ro) * 128 + cl) = pack8(v0, v1);
                    else *(u32x2*)(ws + OFF_GT + (size_t)(row0 + ro) * 3072 + (u.pn - 4) * 256 + bj * HALF + cl) = pack8u(sig4(v0), sig4(v1)); } }
    }
};
struct EpiG8 {
    static constexpr bool PERM = true; __device__ __forceinline__ bool keeps(const Unit&) const { return false; } unsigned char* ws; const PG8_LAS unsigned char* lut;
    __device__ __forceinline__ unsigned g4(const f32x4 v) const {
        const unsigned i0 = min((unsigned)(v[0] + 512.5f), 1023u), i1 = min((unsigned)(v[1] + 512.5f), 1023u), i2 = min((unsigned)(v[2] + 512.5f), 1023u), i3 = min((unsigned)(v[3] + 512.5f), 1023u);
        return (unsigned)lut[i0] | ((unsigned)lut[i1] << 8) | ((unsigned)lut[i2] << 16) | ((unsigned)lut[i3] << 24);
    }
    __device__ __forceinline__ void operator()(const f32x4 (&acc)[2][2][4][2], const Unit& u, int wr, int wc, int fr, int fq) const {
        const int row0 = u.pm * BM + wr * 64 + fr, cl = wc * 32 + 8 * (fq & ~1); const int odd = fq & 1;
#pragma unroll
        for (int ai = 0; ai < 2; ++ai)
#pragma unroll
            for (int bj = 0; bj < 2; ++bj)
#pragma unroll
                for (int mp = 0; mp < 2; ++mp) {
                    const unsigned a0 = g4(acc[ai][bj][2 * mp][0]), a1 = g4(acc[ai][bj][2 * mp][1]), b0 = g4(acc[ai][bj][2 * mp + 1][0]), b1 = g4(acc[ai][bj][2 * mp + 1][1]);
                    auto s0 = __builtin_amdgcn_permlane16_swap(a0, b0, false, false); auto s1 = __builtin_amdgcn_permlane16_swap(a1, b1, false, false);
                    u32x4 o; o.x = (unsigned)s0[0]; o.y = (unsigned)s1[0]; o.z = (unsigned)s0[1]; o.w = (unsigned)s1[1];
                    *(u32x4*)(ws + OFF_GT + (size_t)(row0 + ai * HALF + (2 * mp + odd) * 16) * 3072 + u.pn * 256 + bj * HALF + cl) = o; }
    }
};
struct EpiGZ {
    static constexpr bool PERM = true; __device__ __forceinline__ bool keeps(const Unit&) const { return false; } unsigned char* ws;
    __device__ __forceinline__ void operator()(const f32x4 (&acc)[2][2][4][2], const Unit& u, int wr, int wc, int fr, int fq) const {
        const int ch0 = wr * 64 + fr, tl = wc * 32 + 8 * fq;
        bf16_t* base; int pitch;
        if (u.pn < 128) { base = (bf16_t*)(ws + OFF_ZTL) + (size_t)((u.pn >> 3) * 256) * 4096 + u.pm * 2048 + (u.pn & 7) * 256; pitch = 4096; }
        else { base = (bf16_t*)(ws + OFF_ZTC) + (size_t)((u.pn - 128) * 256) * 512 + u.pm * 256; pitch = 512; }
#pragma unroll
        for (int ai = 0; ai < 2; ++ai)
#pragma unroll
            for (int m = 0; m < 4; ++m) { const int ch = ch0 + ai * HALF + m * 16;
#pragma unroll
                for (int bj = 0; bj < 2; ++bj) *(u32x4*)(base + (size_t)ch * pitch + bj * HALF + tl) = pack8(acc[ai][bj][m][0], acc[ai][bj][m][1]); }
    }
};
struct EpiRe8 {
    static constexpr bool PERM = true; __device__ __forceinline__ bool keeps(const Unit&) const { return false; } bf16_t* mix; int ctx;
    __device__ __forceinline__ void operator()(const f32x4 (&acc)[2][2][4][2], const Unit& u, int wr, int wc, int fr, int fq) const {
        const int rb = (ctx ? NL + u.tag * CTX : u.tag * SEQ + (u.pm & 7) * 256) + wr * 64 + fr, cl = wc * 32 + 8 * fq;
        const float sc = ctx ? 1.0f / 128.0f : 0.0027621358640099515f;
#pragma unroll
        for (int ai = 0; ai < 2; ++ai)
#pragma unroll
            for (int m = 0; m < 4; ++m)
#pragma unroll
                for (int bj = 0; bj < 2; ++bj) *(u32x4*)(mix + (size_t)(rb + ai * HALF + m * 16) * D + bj * HALF + cl) = pack8(acc[ai][bj][m][0] * sc, acc[ai][bj][m][1] * sc);
    }
};
struct EpiMg {
    static constexpr bool PERM = true; unsigned char* ws;
    __device__ __forceinline__ bool keeps(const Unit& u) const { return u.tag != 2; }
    __device__ __forceinline__ void operator()(f32x4 (&acc)[2][2][4][2], const Unit& u, int wr, int wc, int fr, int fq) const {
        const int row0 = u.pm * BM + wr * 64 + fr, col0 = u.pn * BM + wc * 32 + 8 * fq;
        const unsigned char* gt = ws + OFF_GT + u.tag * 1024; bf16_t* U = (bf16_t*)(ws + OFF_HB);
        const unsigned go = (unsigned)row0 * 3072u + (unsigned)col0, dofs = u.tag != 2 ? 1024u : 0u; const bool ratio = u.tag != 2;
#pragma unroll
        for (int g = 0; g < 4; ++g) {
            u32x2 gn[2][2], gd[2][2];
#pragma unroll
            for (int mm = 0; mm < 2; ++mm)
#pragma unroll
                for (int bj = 0; bj < 2; ++bj) { const unsigned o = go + (unsigned)((g >> 1) * HALF + ((g & 1) * 2 + mm) * 16) * 3072u + (unsigned)(bj * HALF);
                    gn[mm][bj] = *(const u32x2*)(gt + o); gd[mm][bj] = *(const u32x2*)(gt + (o + dofs)); }
#pragma unroll
            for (int mm = 0; mm < 2; ++mm)
#pragma unroll
                for (int bj = 0; bj < 2; ++bj) { const int ai = g >> 1, m = (g & 1) * 2 + mm; float f[8], d[8];
                    u32x2 dd = gd[mm][bj]; dd.x = ratio ? dd.x : 0xFFFFFFFFu; dd.y = ratio ? dd.y : 0xFFFFFFFFu;
                    unpk8u(gn[mm][bj], f); unpk8u(dd, d);
#pragma unroll
                    for (int i = 0; i < 8; ++i) f[i] = fmaxf(f[i], 1e-20f) * __builtin_amdgcn_rcpf(fmaxf(d[i], 1e-20f));
                    f32x4 v0 = acc[ai][bj][m][0], v1 = acc[ai][bj][m][1];
                    v0[0] *= f[0]; v0[1] *= f[1]; v0[2] *= f[2]; v0[3] *= f[3]; v1[0] *= f[4]; v1[1] *= f[5]; v1[2] *= f[6]; v1[3] *= f[7];
                    acc[ai][bj][m][0] = v0; acc[ai][bj][m][1] = v1; }
        }
        if (u.tag == 2) {
#pragma unroll
            for (int ai = 0; ai < 2; ++ai)
#pragma unroll
                for (int m = 0; m < 4; ++m)
#pragma unroll
                    for (int bj = 0; bj < 2; ++bj) *(u32x4*)(U + (size_t)(row0 + ai * HALF + m * 16) * D + col0 + bj * HALF) = pack8(acc[ai][bj][m][0], acc[ai][bj][m][1]);
        }
    }
};
struct EpiO {
    static constexpr bool PERM = false; __device__ __forceinline__ bool keeps(const Unit&) const { return false; } float* out; unsigned char* ws; int l; const float* xin; const float* cin;
    __device__ __forceinline__ void operator()(const f32x4 (&acc)[2][2][4][2], const Unit& u, int wr, int wc, int fr, int fq) const {
        const int rl = wr * 64 + fr, col0 = u.pn * BM + wc * 32 + 4 * fq;
        float* xb = (u.pm < 128 ? out + (size_t)u.pm * BM * D : (float*)(ws + OFF_XC) + (size_t)(u.pm - 128) * BM * D) + (size_t)rl * D + col0;
        const float* xr = (u.pm < 128 ? xin + (size_t)u.pm * BM * D : cin + (size_t)(u.pm - 128) * BM * D) + (size_t)rl * D + col0;
        const float* m2 = (const float*)(ws + OFF_MOD) + ((size_t)(l * 17 + (u.pm < 128 ? (u.pm >> 3) : 16)) * 6 + 2) * D + col0;
        f32x4 gv[2][2];
#pragma unroll
        for (int bj = 0; bj < 2; ++bj)
#pragma unroll
            for (int n = 0; n < 2; ++n) gv[bj][n] = *(const f32x4*)(m2 + bj * HALF + n * 16);
        f32x4 xv[2][2][2][2];
#define EO_LOAD(G, BUF) do { _Pragma("unroll") for (int mm = 0; mm < 2; ++mm) { const int ai_ = (G) >> 1, m_ = ((G) & 1) * 2 + mm; const size_t ro_ = (size_t)(ai_ * HALF + m_ * 16) * D; \
            _Pragma("unroll") for (int bj = 0; bj < 2; ++bj) _Pragma("unroll") for (int n = 0; n < 2; ++n) xv[BUF][mm][bj][n] = *(const f32x4*)(xr + ro_ + bj * HALF + n * 16); } } while (0)
        EO_LOAD(0, 0);
#pragma unroll
        for (int g = 0; g < 4; ++g) { const int cb = g & 1;
            if (g < 3) EO_LOAD(g + 1, cb ^ 1);
            asm volatile("" : "+v"(xv[cb][0][0][0]), "+v"(xv[cb][0][0][1]), "+v"(xv[cb][0][1][0]), "+v"(xv[cb][0][1][1]), "+v"(xv[cb][1][0][0]), "+v"(xv[cb][1][0][1]), "+v"(xv[cb][1][1][0]), "+v"(xv[cb][1][1][1]));
#pragma unroll
            for (int mm = 0; mm < 2; ++mm) { const int ai = g >> 1, m = (g & 1) * 2 + mm; const size_t ro = (size_t)(ai * HALF + m * 16) * D;
#pragma unroll
                for (int bj = 0; bj < 2; ++bj)
#pragma unroll
                    for (int n = 0; n < 2; ++n) *(f32x4*)(xb + ro + bj * HALF + n * 16) = xv[cb][mm][bj][n] + gv[bj][n] * acc[ai][bj][m][n]; }
        }
#undef EO_LOAD
    }
};
struct EpiS {
    static constexpr bool PERM = true; __device__ __forceinline__ bool keeps(const Unit&) const { return false; } bf16_t* st;
    __device__ __forceinline__ void operator()(const f32x4 (&acc)[2][2][4][2], const Unit& u, int wr, int wc, int fr, int fq) const {
        bf16_t* base = st + (size_t)(u.pm * BM + wr * 64 + fr) * NT + u.pn * BM + wc * 32 + 8 * fq;
#pragma unroll
        for (int ai = 0; ai < 2; ++ai)
#pragma unroll
            for (int m = 0; m < 4; ++m)
#pragma unroll
                for (int bj = 0; bj < 2; ++bj) { u32x4 p = pack8(acc[ai][bj][m][0], acc[ai][bj][m][1]);
                    p.x ^= ((p.x >> 15) & 0x00010001u) * 0x7fffu; p.y ^= ((p.y >> 15) & 0x00010001u) * 0x7fffu; p.z ^= ((p.z >> 15) & 0x00010001u) * 0x7fffu; p.w ^= ((p.w >> 15) & 0x00010001u) * 0x7fffu;
                    *(u32x4*)(base + (size_t)(ai * HALF + m * 16) * NT + bj * HALF) = p; }
    }
};
struct DftSched { int G, c, ctx;
    __device__ __forceinline__ bool next(int i, Unit& u) const { const int L = i * G + c; const int n = ctx ? NB : NB * 8; if (L >= n) return false;
        if (ctx) { u.pm = 0; u.pn = L; u.tag = L; u.nt = 8; } else { u.pm = L & 7; u.pn = L >> 3; u.tag = L >> 3; u.nt = 64; }
        u.kofs = 0; return true; } };
}


__device__ __forceinline__ void ph_gemm1_pg(const Params& P, int l, int bid, int nblk, unsigned char* smem) {
    PG8_LAS unsigned char* lds = (PG8_LAS unsigned char*)smem; const bf16_t* HB = (const bf16_t*)(P.ws + OFF_HB);
    { pg8::Gemm g{(const bf16_t*)(P.ws + OFF_HB8), (const bf16_t*)(P.ws + OFF_WG8 + (size_t)l * 3072 * D), D / 2, D / 2}; pg8::PlainSched S; S.T.init(NT / 256, 12, nblk, bid); S.nt = 8; pg8::EpiG8 E{P.ws, (const PG8_LAS unsigned char*)(lds + SIGLUT_OFF)};
      pg8::gemm_phase<pg8::EpiG8, pg8::PlainSched, true>(lds, g, S, E); }
    { pg8::Gemm g{HB, (const bf16_t*)(P.ws + OFF_W1T) + (size_t)l * 4096 * D, D, D}; pg8::PlainSched S; S.T.init(NT / 256, 4, nblk, nblk == 256 ? (bid + 64) & 255 : bid); S.nt = 16; pg8::EpiG1 E{P.ws}; pg8::gemm_phase(lds, g, S, E); }
    { pg8::Gemm g{(const bf16_t*)(P.ws + OFF_WFT) + (size_t)l * 512 * D, HB, D, D}; pg8::PlainSched S; S.T.init(2, NL / 256, nblk, bid); S.nt = 16; pg8::EpiGZ E{P.ws}; pg8::gemm_phase(lds, g, S, E); }
}
__device__ __forceinline__ void ph_gemm1_ctxz(const Params& P, int l, int c, int G, unsigned char* smem) {
    PG8_LAS unsigned char* lds = (PG8_LAS unsigned char*)smem;
    pg8::Gemm g{(const bf16_t*)(P.ws + OFF_WFT) + (size_t)l * 512 * D, (const bf16_t*)(P.ws + OFF_HB), D, D}; pg8::CtxZSched S{c, G, 16}; pg8::EpiGZ E{P.ws}; pg8::gemm_phase(lds, g, S, E);
}
__device__ __forceinline__ void ph_merge_pg(const Params& P, int l, int ntok, int bid, int nblk, unsigned char* smem) {
    PG8_LAS unsigned char* lds = (PG8_LAS unsigned char*)smem;
    pg8::Gemm g{(const bf16_t*)(P.ws + OFF_MIX), (const bf16_t*)(P.ws + OFF_WMT) + (size_t)l * D * D, D, D}; pg8::MergeSched S; S.T.init(ntok / 256, 4, nblk, bid); pg8::EpiMg E{P.ws}; pg8::gemm_phase(lds, g, S, E);
}
__device__ __forceinline__ void ph_out_pg(const Params& P, int l, int ntok, int bid, int nblk, unsigned char* smem) {
    PG8_LAS unsigned char* lds = (PG8_LAS unsigned char*)smem;
    pg8::Gemm g{(const bf16_t*)(P.ws + OFF_HB), (const bf16_t*)(P.ws + OFF_WOT) + (size_t)l * D * D, D, D}; pg8::PlainSched S; S.T.init(ntok / 256, 4, nblk, bid); S.nt = 16; pg8::EpiO E{P.out, P.ws, l, l == 0 ? P.x : (const float*)P.out, l == 0 ? P.ctx : (const float*)(P.ws + OFF_XC)}; pg8::gemm_phase(lds, g, S, E);
}
__device__ __forceinline__ void ph_score_pg(const Params& P, int l, int ntok, int bid, int nblk, unsigned char* smem) {
    PG8_LAS unsigned char* lds = (PG8_LAS unsigned char*)smem;
    pg8::Gemm g{(const bf16_t*)(P.ws + OFF_WST) + (size_t)l * 2048 * D, (const bf16_t*)(P.ws + OFF_HB), D, D}; pg8::PlainSched S; S.T.init(8, ntok / 256, nblk, bid); S.nt = 16; pg8::EpiS E{(bf16_t*)(P.ws + OFF_ST)}; pg8::gemm_phase(lds, g, S, E);
}


namespace attn_body {
using bf16=__hip_bfloat16;
using bf16x8=__attribute__((ext_vector_type(8)))short;
using s16x4=__attribute__((ext_vector_type(4)))short;
using f32x16=__attribute__((ext_vector_type(16)))float;
using u32x4=__attribute__((ext_vector_type(4)))unsigned;
constexpr int D=64,QP=512,KP=128,OP=1024;
constexpr int NW=8,QBLK=32,QB=QBLK*NW,KVBLK=64;
__device__ __forceinline__ int crow(int r,int hi){return (r&3)+8*(r>>2)+4*hi;}
#define SBAR() __builtin_amdgcn_sched_barrier(0)
constexpr int NSLOT=3, SLOTB=8192;
constexpr int LDS_K=0, LDS_V=NSLOT*SLOTB, LDS_WS=2*NSLOT*SLOTB, LDS_OST=LDS_WS+NW*64*4, LDS_BYTES=LDS_OST+NW*4096;
constexpr float C2=0.125f*1.4426950408889634f;
__device__ __forceinline__ void glds16(const void*gsrc,unsigned lds_dst){unsigned keep;
  asm volatile("s_mov_b32 %0, m0\n\ts_mov_b32 m0, %2\n\ts_nop 0\n\tglobal_load_lds_dwordx4 %1, off\n\ts_mov_b32 m0, %0":"=&s"(keep):"v"(gsrc),"s"(lds_dst):"memory");}
__device__ __forceinline__ float max3f(float a,float b,float c){float r;asm("v_max3_f32 %0, %1, %2, %3":"=v"(r):"v"(a),"v"(b),"v"(c));return r;}
__device__ __forceinline__ float max2f(float a,float b){float r;asm("v_max_f32_e32 %0, %1, %2":"=v"(r):"v"(a),"v"(b));return r;}
__device__ __forceinline__ float fadd_s(float a,float b){float r;asm("v_add_f32_e32 %0, %1, %2":"=v"(r):"v"(a),"v"(b));return r;}
__device__ __forceinline__ float fsub_s(float a,float b){float r;asm("v_sub_f32_e32 %0, %1, %2":"=v"(r):"v"(a),"v"(b));return r;}
typedef float f32x2_t __attribute__((ext_vector_type(2))); typedef __bf16 bf16x2_t __attribute__((ext_vector_type(2)));
__device__ __forceinline__ unsigned cvtpk_s(float lo,float hi){f32x2_t v={lo,hi};bf16x2_t b=__builtin_convertvector(v,bf16x2_t);return __builtin_bit_cast(unsigned,b);}
#define WAIT_BAR(N) asm volatile("s_waitcnt vmcnt(" #N ") lgkmcnt(0)\n\ts_barrier":::"memory")

__device__ __forceinline__ void qkt(f32x16&p0,f32x16&p1,const char*Kslot,const bf16x8*qr,const f32x16&negm,int r32,int hi){
  const char*kb=Kslot+hi*1024+r32*16;
  #pragma unroll
  for(int d0=0;d0<4;++d0){
    const bf16x8 b0=*reinterpret_cast<const bf16x8*>(kb+d0*2048);
    const bf16x8 b1=*reinterpret_cast<const bf16x8*>(kb+d0*2048+512);
    if(d0==0){p0=__builtin_amdgcn_mfma_f32_32x32x16_bf16(b0,qr[0],negm,0,0,0);p1=__builtin_amdgcn_mfma_f32_32x32x16_bf16(b1,qr[0],negm,0,0,0);}
    else{p0=__builtin_amdgcn_mfma_f32_32x32x16_bf16(b0,qr[d0],p0,0,0,0);p1=__builtin_amdgcn_mfma_f32_32x32x16_bf16(b1,qr[d0],p1,0,0,0);}}
}
typedef __attribute__((address_space(3))) const char* lds_cptr;
typedef short v4i16_t __attribute__((ext_vector_type(4)));
__device__ __forceinline__ void kload8(bf16x8*kf,lds_cptr kp){
  kf[0]=*(const __attribute__((address_space(3))) bf16x8*)(kp);      kf[1]=*(const __attribute__((address_space(3))) bf16x8*)(kp+512);
  kf[2]=*(const __attribute__((address_space(3))) bf16x8*)(kp+2048); kf[3]=*(const __attribute__((address_space(3))) bf16x8*)(kp+2560);
  kf[4]=*(const __attribute__((address_space(3))) bf16x8*)(kp+4096); kf[5]=*(const __attribute__((address_space(3))) bf16x8*)(kp+4608);
  kf[6]=*(const __attribute__((address_space(3))) bf16x8*)(kp+6144); kf[7]=*(const __attribute__((address_space(3))) bf16x8*)(kp+6656);
}
__device__ __forceinline__ void kload2(bf16x8*kf,lds_cptr kp,int j){ kf[2*j]=*(const __attribute__((address_space(3))) bf16x8*)(kp+j*2048); kf[2*j+1]=*(const __attribute__((address_space(3))) bf16x8*)(kp+j*2048+512); }
__device__ __forceinline__ s16x4 vtr(lds_cptr p){ return __builtin_bit_cast(s16x4,__builtin_amdgcn_ds_read_tr16_b64_v4i16((__attribute__((address_space(3))) v4i16_t*)p)); }
__device__ __forceinline__ float rowmax(const f32x16&p0,const f32x16&p1){
  float a=max3f(p0[0],p0[1],p1[0]),b=max3f(p0[2],p0[3],p1[1]);a=max3f(a,p1[2],p1[3]);
  #pragma unroll
  for(int r=4;r<16;r+=4){a=max3f(a,p0[r],p0[r+1]);b=max3f(b,p0[r+2],p0[r+3]);a=max3f(a,p1[r],p1[r+1]);b=max3f(b,p1[r+2],p1[r+3]);}
  const float m=max2f(a,b);
  auto rr=__builtin_amdgcn_permlane32_swap(__float_as_uint(m),__float_as_uint(m),false,false);
  return max2f(__uint_as_float(rr[0]),__uint_as_float(rr[1]));
}
__device__ __forceinline__ void pv(f32x16*o,int vb,bf16x8 pa0,bf16x8 pa1,bf16x8 pa2,bf16x8 pa3){
  #pragma unroll
  for(int d0=0;d0<2;++d0){s16x4 lo[4],hi[4];
    #pragma unroll
    for(int ks=0;ks<4;++ks){
      asm volatile("ds_read_b64_tr_b16 %0,%1 offset:%c2":"=&v"(lo[ks]):"v"(vb),"i"(d0*4096+ks*1024):"memory");
      asm volatile("ds_read_b64_tr_b16 %0,%1 offset:%c2":"=&v"(hi[ks]):"v"(vb),"i"(d0*4096+ks*1024+512):"memory");}
    asm volatile("s_waitcnt lgkmcnt(0)":::"memory");SBAR();
    #define PK(k) (bf16x8){lo[k][0],lo[k][1],lo[k][2],lo[k][3],hi[k][0],hi[k][1],hi[k][2],hi[k][3]}
    o[d0]=__builtin_amdgcn_mfma_f32_32x32x16_bf16(pa0,PK(0),o[d0],0,0,0);
    o[d0]=__builtin_amdgcn_mfma_f32_32x32x16_bf16(pa1,PK(1),o[d0],0,0,0);
    o[d0]=__builtin_amdgcn_mfma_f32_32x32x16_bf16(pa2,PK(2),o[d0],0,0,0);
    o[d0]=__builtin_amdgcn_mfma_f32_32x32x16_bf16(pa3,PK(3),o[d0],0,0,0);
    #undef PK
  }
}

#ifndef ATTN_STORE16
#define ATTN_STORE16(p,v) (*(u32x4*)(p)=(v))
#endif
template<int THRL> __device__ __forceinline__ void attn_unit(const bf16*Qu,const bf16*__restrict__ Kh,const bf16*__restrict__ Vh,bf16*Ou,const int NT,char*shm){
  const int tid=tidx(),lane=tid&63,r32=lane&31,hi=lane>>5; const int wid=__builtin_amdgcn_readfirstlane(tid>>6);
  const bf16*Qw=Qu+(long)(wid*QBLK)*QP;
  const unsigned lds0=(unsigned)(uintptr_t)shm;
  float*wsf=(float*)(shm+LDS_WS)+wid*64;
  const bf16*ksrc=Kh+(long)lane*KP+wid*8;
  const bf16*vsrc=Vh+(long)(16*(wid&3)+(lane>>2))*KP+(wid>>2)*32+(lane&3)*8;
  const unsigned kdst=lds0+LDS_K+wid*1024, vdst=lds0+LDS_V+wid*1024;
  #define DMA_K(t,slot) glds16(ksrc+(long)(t)*KVBLK*KP,(unsigned)__builtin_amdgcn_readfirstlane(kdst+(slot)))
  #define DMA_V(t,slot) glds16(vsrc+(long)(t)*KVBLK*KP,(unsigned)__builtin_amdgcn_readfirstlane(vdst+(slot)))
  const int vb0=(int)(lds0+LDS_V)+((lane>>4)&1)*32+(lane&3)*8+(4*hi+((lane&15)>>2))*64;
  const char*Kbase=shm+LDS_K; bf16x8 kf[8];
  const lds_cptr shm3=(lds_cptr)shm; const lds_cptr kp0=shm3+LDS_K+hi*1024+r32*16; const lds_cptr vp0=shm3+LDS_V+((lane>>4)&1)*32+(lane&3)*8+(4*hi+((lane&15)>>2))*64;
  DMA_K(0,0);DMA_V(0,0);DMA_K(1,SLOTB);
  bf16x8 qr[4];
  #pragma unroll
  for(int d0=0;d0<4;++d0)qr[d0]=*reinterpret_cast<const bf16x8*>(&Qw[(long)r32*QP+d0*16+hi*8]);
  float mhat=0.f,l_reg=0.f;f32x16 o[2];o[0]=f32x16{};o[1]=f32x16{};f32x16 negm=f32x16{};asm volatile("":"+v"(negm));
  #define CMASK(P0,P1,t) do{}while(0)
  bool resc=false;
  #define START(P0,P1) do{ const float rm=rowmax(P0,P1); resc=false; \
    { const float dl=rm; mhat=fadd_s(mhat,dl); \
      _Pragma("unroll") for(int r=0;r<16;++r){P0[r]=fsub_s(P0[r],dl);P1[r]=fsub_s(P1[r],dl);} \
      _Pragma("unroll") for(int r=0;r<16;++r)negm[r]=-mhat; asm volatile("":"+v"(negm)); } \
    _Pragma("unroll") for(int r=0;r<16;++r)P0[r]=__builtin_amdgcn_exp2f(P0[r]); }while(0)
  #define RESC() do{ if(resc){ asm volatile("s_waitcnt lgkmcnt(0)":::"memory"); \
      _Pragma("unroll") for(int d_=0;d_<2;++d_) _Pragma("unroll") for(int r=0;r<16;++r)o[d_][r]*=wsf[crow(r,hi)]; } }while(0)
  f32x16 pA0,pA1,pB0,pB1;
  int sl_prev=0,sl_cur=0,sl_next=SLOTB;
  #define ROT() do{sl_prev=sl_cur;sl_cur=sl_next;sl_next=(sl_next==(NSLOT-1)*SLOTB)?0:sl_next+SLOTB;}while(0)
  DMA_K(2,2*SLOTB);
  WAIT_BAR(3);
  qkt(pA0,pA1,Kbase,qr,negm,r32,hi);asm volatile("s_nop 15\n\ts_nop 7":"+v"(pA0),"+v"(pA1));CMASK(pA0,pA1,0);
  START(pA0,pA1);
  _Pragma("unroll") for(int r=0;r<16;++r)pA1[r]=__builtin_amdgcn_exp2f(pA1[r]);
  WAIT_BAR(0);
  DMA_K(3,0);DMA_V(1,SLOTB);
  ROT();
  kload8(kf,kp0+sl_cur);
  WAIT_BAR(2);
  s16x4 vlo[8],vhi[8]; u32x4 pw0,pw1,pw2,pw3;
  #define PKW(P,B) cvtpk_s(P[B],P[B+1])
  #define PAF(k) __builtin_bit_cast(bf16x8,pw##k)
  #define VFR(i) (bf16x8){vlo[i][0],vlo[i][1],vlo[i][2],vlo[i][3],vhi[i][0],vhi[i][1],vhi[i][2],vhi[i][3]}
  #define PIN(x) asm volatile("":"+v"(x))
  #define MX3(a,b,c) __builtin_fmaxf(__builtin_fmaxf((a),(b)),(c))
  #define GAPA(MF,A0,A1,A2,A3,W0,W1,PW) do{ MF; sacc+=A0; sacc+=A1; sacc+=A2; sacc+=A3; PIN(sacc); W0; W1; PIN(PW); SBAR(); }while(0)
  #define EX(v) __builtin_amdgcn_exp2f(v)
  #define GAPB(MF,X,B) do{ MF; X[B]=EX(X[B]); X[B+1]=EX(X[B+1]); X[B+2]=EX(X[B+2]); X[B+3]=EX(X[B+3]); PIN(X); SBAR(); }while(0)
  #define VRD(i) do{ vlo[i]=vtr(vp_+(((i)>>2)*4096+((i)&3)*1024)); vhi[i]=vtr(vp_+(((i)>>2)*4096+((i)&3)*1024+512)); }while(0)
  #define KRD(G,j) do{ if(G){ kload2(kf,kp0+sl_next,j); SBAR(); } }while(0)
  #define STEP(C0,C1,P0,P1,t,GK,GV,GL) do{ SBAR(); \
    const lds_cptr vp_=vp0+sl_prev; \
    VRD(0); SBAR(); float sacc=(P0[0]+P0[1]); \
    GAPA(C0=__builtin_amdgcn_mfma_f32_32x32x16_bf16(kf[0],qr[0],negm,0,0,0), P0[2],P0[3],P0[4],P0[5],     pw0[0]=PKW(P0,0), pw0[1]=PKW(P0,2), pw0); \
    VRD(4); SBAR(); GAPA(C1=__builtin_amdgcn_mfma_f32_32x32x16_bf16(kf[1],qr[0],negm,0,0,0), P0[6],P0[7],P0[8],P0[9],     pw0[2]=PKW(P0,4), pw0[3]=PKW(P0,6), pw0); \
    VRD(1); SBAR(); GAPA(C0=__builtin_amdgcn_mfma_f32_32x32x16_bf16(kf[2],qr[1],C0,0,0,0),   P0[10],P0[11],P0[12],P0[13], pw1[0]=PKW(P0,8), pw1[1]=PKW(P0,10), pw1); \
    VRD(5); SBAR(); GAPA(C1=__builtin_amdgcn_mfma_f32_32x32x16_bf16(kf[3],qr[1],C1,0,0,0),   P0[14],P0[15],P1[0],P1[1],   pw1[2]=PKW(P0,12),pw1[3]=PKW(P0,14), pw1); \
    VRD(2); SBAR(); GAPA(C0=__builtin_amdgcn_mfma_f32_32x32x16_bf16(kf[4],qr[2],C0,0,0,0),   P1[2],P1[3],P1[4],P1[5],     pw2[0]=PKW(P1,0), pw2[1]=PKW(P1,2), pw2); \
    VRD(6); SBAR(); GAPA(C1=__builtin_amdgcn_mfma_f32_32x32x16_bf16(kf[5],qr[2],C1,0,0,0),   P1[6],P1[7],P1[8],P1[9],     pw2[2]=PKW(P1,4), pw2[3]=PKW(P1,6), pw2); \
    VRD(3); SBAR(); GAPA(C0=__builtin_amdgcn_mfma_f32_32x32x16_bf16(kf[6],qr[3],C0,0,0,0),   P1[10],P1[11],P1[12],P1[13], pw3[0]=PKW(P1,8), pw3[1]=PKW(P1,10), pw3); \
    VRD(7); SBAR(); GAPA(C1=__builtin_amdgcn_mfma_f32_32x32x16_bf16(kf[7],qr[3],C1,0,0,0),   P1[14],P1[15],0.f,0.f,       pw3[2]=PKW(P1,12),pw3[3]=PKW(P1,14), pw3); \
    l_reg+=sacc; \
    if(GK){DMA_K((t)+3,sl_cur);} if(GV){DMA_V((t)+1,sl_next);} \
    CMASK(C0,C1,t); \
    { float a=MX3(C0[0],C0[1],C1[0]),b=MX3(C0[2],C0[3],C1[1]); a=MX3(a,C1[2],C1[3]); \
      _Pragma("unroll") for(int r=4;r<16;r+=4){a=MX3(a,C0[r],C0[r+1]);b=MX3(b,C0[r+2],C0[r+3]);a=MX3(a,C1[r],C1[r+1]);b=MX3(b,C1[r+2],C1[r+3]);} \
      float rm=__builtin_fmaxf(a,b); { auto rr=__builtin_amdgcn_permlane32_swap(__float_as_uint(rm),__float_as_uint(rm),false,false); rm=__builtin_fmaxf(__uint_as_float(rr[0]),__uint_as_float(rr[1])); } \
      resc=false; \
      if(__builtin_expect(__any(rm>(float)THRL),0)){ const float dl=__builtin_fmaxf(rm,0.f); mhat+=dl; \
        _Pragma("unroll") for(int r=0;r<16;++r){C0[r]-=dl;C1[r]-=dl;} \
        _Pragma("unroll") for(int r=0;r<16;++r)negm[r]=-mhat; asm volatile("":"+v"(negm)); \
        const float f=__builtin_amdgcn_exp2f(-dl); l_reg*=f; if(hi==0)wsf[r32]=f; resc=true; } } \
    SBAR(); \
    GAPB(o[0]=__builtin_amdgcn_mfma_f32_32x32x16_bf16(PAF(0),VFR(0),o[0],0,0,0), C0,0); \
    GAPB(o[1]=__builtin_amdgcn_mfma_f32_32x32x16_bf16(PAF(0),VFR(4),o[1],0,0,0), C0,4); \
    KRD(GL,0); GAPB(o[0]=__builtin_amdgcn_mfma_f32_32x32x16_bf16(PAF(1),VFR(1),o[0],0,0,0), C0,8); \
    KRD(GL,1); GAPB(o[1]=__builtin_amdgcn_mfma_f32_32x32x16_bf16(PAF(1),VFR(5),o[1],0,0,0), C0,12); \
    KRD(GL,2); GAPB(o[0]=__builtin_amdgcn_mfma_f32_32x32x16_bf16(PAF(2),VFR(2),o[0],0,0,0), C1,0); \
    KRD(GL,3); GAPB(o[1]=__builtin_amdgcn_mfma_f32_32x32x16_bf16(PAF(2),VFR(6),o[1],0,0,0), C1,4); \
    GAPB(o[0]=__builtin_amdgcn_mfma_f32_32x32x16_bf16(PAF(3),VFR(3),o[0],0,0,0), C1,8); \
    GAPB(o[1]=__builtin_amdgcn_mfma_f32_32x32x16_bf16(PAF(3),VFR(7),o[1],0,0,0), C1,12); \
    }while(0)
  int t=1;
  #undef CMASK
  #define CMASK(P0,P1,t) do{}while(0)
  for(;t+5<NT;t+=2){
    STEP(pB0,pB1,pA0,pA1,t,true,true,true);     WAIT_BAR(2); RESC(); ROT();
    STEP(pA0,pA1,pB0,pB1,t+1,true,true,true);   WAIT_BAR(2); RESC(); ROT();
  }
  #undef CMASK
  #define CMASK(P0,P1,t) do{}while(0)
  #define ENDW(tt) do{ if((tt)+3<NT){WAIT_BAR(2);} else if((tt)+2<NT){WAIT_BAR(1);} else {WAIT_BAR(0);} }while(0)
  for(;t+1<NT;t+=2){
    STEP(pB0,pB1,pA0,pA1,t,(t+3<NT),(t+1<NT),(t+1<NT));       ENDW(t);   RESC(); ROT();
    STEP(pA0,pA1,pB0,pB1,t+1,(t+4<NT),(t+2<NT),(t+2<NT));     ENDW(t+1); RESC(); ROT();
  }
  STEP(pB0,pB1,pA0,pA1,NT-1,false,false,false); RESC();
  { float sacc=pB0[0]+pB0[1]; _Pragma("unroll") for(int r=2;r<16;++r)sacc+=pB0[r]; _Pragma("unroll") for(int r=0;r<16;++r)sacc+=pB1[r]; l_reg+=sacc;
    pw0=(u32x4){PKW(pB0,0),PKW(pB0,2),PKW(pB0,4),PKW(pB0,6)};pw1=(u32x4){PKW(pB0,8),PKW(pB0,10),PKW(pB0,12),PKW(pB0,14)};pw2=(u32x4){PKW(pB1,0),PKW(pB1,2),PKW(pB1,4),PKW(pB1,6)};pw3=(u32x4){PKW(pB1,8),PKW(pB1,10),PKW(pB1,12),PKW(pB1,14)};
    SBAR(); pv(o,vb0+sl_cur,PAF(0),PAF(1),PAF(2),PAF(3)); }
  #undef PKW
  #undef PAF
  #undef VFR
  #undef PIN
  #undef MX3
  #undef GAPA
  #undef GAPB
  #undef EX
  #undef VRD
  #undef KRD
  #undef STEP
  #undef ENDW
  {auto rr=__builtin_amdgcn_permlane32_swap(__float_as_uint(l_reg),__float_as_uint(l_reg),false,false);l_reg=__uint_as_float(rr[0])+__uint_as_float(rr[1]);}
  if(hi==0)wsf[32+r32]=l_reg;asm volatile("s_waitcnt lgkmcnt(0)":::"memory");
  float rli[16];
  #pragma unroll
  for(int r=0;r<16;++r)rli[r]=__builtin_amdgcn_rcpf(wsf[32+crow(r,hi)]);
  bf16*Ow=Ou+(long)(wid*QBLK)*OP;
  { bf16*stg=(bf16*)(shm+LDS_OST)+wid*2048;
    #pragma unroll
    for(int r=0;r<16;++r){const int orow=crow(r,hi);
      #pragma unroll
      for(int d0=0;d0<2;++d0)stg[orow*64+d0*32+r32]=__float2bfloat16(o[d0][r]*rli[r]);}
    asm volatile("s_waitcnt lgkmcnt(0)":::"memory");
    #pragma unroll
    for(int i=0;i<4;++i){const int row=i*8+(lane>>3),ch=lane&7; const u32x4 v=*(const u32x4*)(stg+row*64+ch*8); ATTN_STORE16(Ow+(long)row*OP+ch*8,v);} }
  asm volatile("s_waitcnt lgkmcnt(0)\n\ts_barrier":::"memory");
  #undef DMA_K
  #undef DMA_V
  #undef CMASK
  #undef START
  #undef RESC
  #undef ROT
}
constexpr int ATTN_LDS_BYTES=LDS_BYTES;
#undef SBAR
#undef WAIT_BAR
}

__device__ __forceinline__ void ph_attn_dft(const Params& P, int bid, int nblk, unsigned char* smem, int with_ctx) {
    PG8_LAS unsigned char* lds = (PG8_LAS unsigned char*)smem; bf16_t* MIXb = (bf16_t*)(P.ws + OFF_MIX);
    const bool bal = (nblk == 256);
    { pg8::Gemm g{(const bf16_t*)(P.ws + OFF_ADFT), (const bf16_t*)(P.ws + OFF_ZTL), 4096, 4096}; pg8::DftSched S{nblk, bid, 0}; pg8::EpiRe8 E{MIXb, 0}; pg8::gemm_phase(lds, g, S, E); }
    if (with_ctx) { pg8::Gemm g{(const bf16_t*)(P.ws + OFF_ADFTC), (const bf16_t*)(P.ws + OFF_ZTC), 512, 512}; pg8::DftSched S{nblk, bal ? (bid >= 128 ? bid - 128 : 1 << 20) : bid, 1}; pg8::EpiRe8 E{MIXb, 1}; pg8::gemm_phase(lds, g, S, E); }
    __syncthreads();
    const attn_body::bf16* QR = (const attn_body::bf16*)(P.ws + OFF_QR); const attn_body::bf16* KA = (const attn_body::bf16*)(P.ws + OFF_KALL); const attn_body::bf16* VA = (const attn_body::bf16*)(P.ws + OFF_VALL);
    attn_body::bf16* MIX = (attn_body::bf16*)(P.ws + OFF_MIX);
    int start, cnt, stride, shortU;
    if (bal) { if (bid < 128) { start = 3 * ((bid & 7) * 16 + (bid >> 3)); cnt = 3; stride = 1; shortU = -1; }
               else { const int vj = (bid & 7) * 16 + ((bid - 128) >> 3); start = 384 + 5 * vj; cnt = 5; stride = 1; shortU = with_ctx ? 1024 + vj : -1; } }
    else { const int vcu = (nblk % 8 == 0) ? (bid % 8) * (nblk / 8) + bid / 8 : bid; const int nU = with_ctx ? 1152 : 1024; start = vcu; stride = nblk; cnt = vcu < nU ? (nU - 1 - vcu) / nblk + 1 : 0; shortU = -1; }
    for (int k = 0; k <= cnt; ++k) {
        const int U = k < cnt ? start + k * stride : shortU; if (U < 0) break;
        int b, h, qrow, krow, NTl;
        if (U < 1024) { b = U >> 6; h = (U >> 3) & 7; qrow = b * SEQ + (U & 7) * 256; krow = b * KV; NTl = KV / 64; }
        else { const int j = U - 1024; b = j >> 3; h = j & 7; qrow = NL + b * CTX; krow = b * KV + SEQ; NTl = CTX / 64; }
        attn_body::attn_unit<8>(QR + (size_t)qrow * 512 + h * 64, KA + (size_t)krow * 128 + (h >> 2) * 64, VA + (size_t)krow * 128 + (h >> 2) * 64, MIX + (size_t)qrow * D + 512 + h * 64, NTl, (char*)smem);
    }
}

#define XB_TMO      128
#define XB_XCNT(j)  (256  + 64 * (j))
#define XB_XSUB(j)  (1280 + 64 * (j))
#define XB_XGEN(j)  (2304 + 64 * (j))
#define XB_TOP      3328
#define XB_TOPGEN   3392
#define XCD_BAR_WORDS 3456
#define XB_SPIN_CAP (1u << 18)
#define LAS __attribute__((address_space(3)))

__device__ __forceinline__ unsigned xb_ld(unsigned* p)              { return __hip_atomic_load(p, __ATOMIC_RELAXED, __HIP_MEMORY_SCOPE_AGENT); }
__device__ __forceinline__ unsigned xb_add(unsigned* p, unsigned v) { return __hip_atomic_fetch_add(p, v, __ATOMIC_RELAXED, __HIP_MEMORY_SCOPE_AGENT); }
__device__ __forceinline__ unsigned xb_xcc_id() { return (unsigned)__builtin_amdgcn_s_getreg((3 << 11) | 20) & 0xFu; }
#define XB_SPIN(cond, bar) do { unsigned _sp = 0; while (cond) { __builtin_amdgcn_s_sleep(1); \
    if ((++_sp & 255u) == 0u) { if (xb_ld(&(bar)[XB_TMO])) break; if (_sp > XB_SPIN_CAP) { atomicAdd(&(bar)[XB_TMO], 1u); break; } } } } while (0)

struct XcdBarrier {
    unsigned* bar; unsigned x;
    volatile LAS unsigned* st;
};
__device__ __forceinline__ XcdBarrier xcd_barrier_post(unsigned* bar, volatile LAS unsigned* st) {
    XcdBarrier b; b.bar = bar; b.x = xb_xcc_id(); b.st = st;
    if (threadIdx.x == 0) (void)xb_add(&bar[XB_XCNT(b.x)], 1u);
    return b;
}
__device__ __forceinline__ void xcd_barrier_complete(unsigned* bar, unsigned x, unsigned& nloc, unsigned& nx) {
    const unsigned G = gridDim.x * gridDim.y * gridDim.z;
    unsigned sum, cnt, mine, sp = 0u;
    for (;;) {
        sum = 0u; cnt = 0u; mine = 0u;
#pragma unroll
        for (unsigned j = 0; j < 16; ++j) { const unsigned c = xb_ld(&bar[XB_XCNT(j)]); sum += c; cnt += (c > 0u) ? 1u : 0u; mine = (j == x) ? c : mine; }
        if (sum == G) break;
        __builtin_amdgcn_s_sleep(1);
        if ((++sp & 255u) == 0u) { if (xb_ld(&bar[XB_TMO])) break; if (sp > XB_SPIN_CAP) { atomicAdd(&bar[XB_TMO], 1u); break; } }
    }
    nloc = mine > 0u ? mine : 1u; nx = cnt > 0u ? cnt : 1u;
}
__device__ __forceinline__ void xcd_barrier(const XcdBarrier& b) {
    asm volatile("s_waitcnt vmcnt(0)" ::: "memory");
    __syncthreads();
    if (threadIdx.x == 0) {
        unsigned* bar = b.bar; const unsigned bx = xb_xcc_id();
        __builtin_amdgcn_s_waitcnt(0);
        unsigned nloc = b.st[0], nx = b.st[1];
        if (nloc == 0u) { xcd_barrier_complete(bar, bx, nloc, nx); b.st[0] = nloc; b.st[1] = nx; }
        const unsigned old = xb_add(&bar[XB_XSUB(bx)], 1u);
        const unsigned gen = old / nloc;
        if (old + 1u == (gen + 1u) * nloc) {
            __builtin_amdgcn_fence(__ATOMIC_RELEASE, "agent");
            asm volatile("s_waitcnt vmcnt(0)" ::: "memory");
            const unsigned og = xb_add(&bar[XB_TOP], 1u);
            const unsigned tg = og / nx;
            if (og + 1u == (tg + 1u) * nx) xb_add(&bar[XB_TOPGEN], 1u);
            else XB_SPIN(xb_ld(&bar[XB_TOPGEN]) == tg, bar);
            __builtin_amdgcn_fence(__ATOMIC_ACQUIRE, "agent");
            xb_add(&bar[XB_XGEN(bx)], 1u);
            asm volatile("s_waitcnt vmcnt(0)" ::: "memory");
        } else {
            XB_SPIN(xb_ld(&bar[XB_XGEN(bx)]) == gen, bar);
            __builtin_amdgcn_fence(__ATOMIC_ACQUIRE, "agent");
            asm volatile("s_waitcnt vmcnt(0)" ::: "memory");
        }
    }
    __syncthreads();
}

constexpr int LDS_BYTES = 147456;
constexpr int MISC_OFF = 131072 + 320;

__global__ void __launch_bounds__(512, 2) mega_fwd(Params P) {
    extern __shared__ __attribute__((aligned(16))) unsigned char smem[];
    const int bid = blockIdx.x, nblk = gridDim.x;
    for (int u = threadIdx.x; u < (LDS_BYTES - 131072) / 4; u += 512) ((LAS unsigned*)((LAS unsigned char*)smem + 131072))[u] = 0u;
    __syncthreads();
    for (int u = threadIdx.x; u < 1024; u += 512) ((LAS unsigned char*)smem)[SIGLUT_OFF + u] = (unsigned char)__builtin_rintf(255.0f * sigmoidf_((float)(u - 512) * (1.0f / 64.0f)));
    __syncthreads();
    XcdBarrier bar = xcd_barrier_post((unsigned*)(P.ws + OFF_CTL), (volatile LAS unsigned*)((LAS unsigned char*)smem + MISC_OFF) + 8);
    float* ldsf = (float*)smem;
#define GASQ __attribute__((address_space(1)))
#define LND(m) Q.m = (decltype(Q.m))((const char*)Q.m + z_)
#ifndef DUPM
#define DUPM 0
#endif
#define DUP(bit, call) do { call; if (DUPM & (1 << (bit))) { call; } } while (0)
#define PH(call) do { Params Q = P; long z_ = 0; asm volatile("" : "+s"(z_)); LND(ws); LND(out); LND(x); LND(c); LND(ctx); LND(c_ctx); LND(ada_w); LND(ada_b); LND(norm_mix); LND(w_in); LND(fourier_w); LND(pool_w); LND(pool_scale); LND(pool_proj); \
        LND(q_norm); LND(k_norm); LND(attn_proj); LND(w_out); LND(norm_ffn); LND(peer_wq); LND(peer_keys); LND(peer_u); LND(peer_v); call; } while (0)
    for (int rep = 0; rep < ((DUPM & (1 << 11)) ? 2 : 1); ++rep) {
    PH(ph_mod(Q, bid, nblk, ldsf)); PH(ph_tables(Q, bid, nblk)); PH(ph_wtrans(Q, bid, nblk, ldsf)); PH(ph_wft(Q, bid, nblk, ldsf)); PH(ph_wg8(Q, bid, nblk, ldsf)); PH(ph_wpool(Q, bid, nblk, ldsf)); PH(ph_wst(Q, bid, nblk, 0, 1)); PH(ph_peer_cvt(Q, bid, nblk, 0, 1));
    }
    xcd_barrier(bar);
#pragma unroll 1
    for (int l = 0; l < DEPTH; ++l) {
        const int ntok = (l == DEPTH - 1) ? NL : NT;
        DUP(0, PH(ph_norm(Q, l, 0, NT, bid, nblk, l == 0)));      xcd_barrier(bar);
        DUP(1, PH(ph_gemm1_pg(Q, l, bid, nblk, smem)));        xcd_barrier(bar);
        {
            const bool withz = l < DEPTH - 1, split = withz && nblk > 64;
            const int zc = split ? bid : bid, zG = split ? (1 << 20) : nblk;
            if (withz && (split ? bid < 32 : true)) { PH(ph_gemm1_ctxz(Q, l, zc, zG, smem)); }
            if (!split || bid >= 32) { PH(ph_l3(Q, l, split ? bid - 32 : bid, split ? nblk - 32 : nblk)); }
        }
        xcd_barrier(bar);
        DUP(3, PH(ph_attn_dft(Q, bid, nblk, smem, l < DEPTH - 1)));      xcd_barrier(bar);
        DUP(4, PH(ph_merge_pg(Q, l, ntok, bid, nblk, smem)));
        if (l < DEPTH - 1) {
            if (nblk == 256) { if (bid >= 64) { PH(ph_peer_cvt(Q, bid - 64, 192, l + 1, l + 2, 0, 1)); } }
            else { PH(ph_peer_cvt(Q, bid, nblk, l + 1, l + 2)); PH(ph_wst(Q, bid, nblk, l + 1, l + 2)); }
        }
        xcd_barrier(bar);
        PH(ph_out_pg(Q, l, ntok, bid, nblk, smem));
        if (l < DEPTH - 1 && nblk == 256 && bid >= 64) { PH(ph_wst(Q, bid - 64, 192, l + 1, l + 2)); }
        xcd_barrier(bar);
        DUP(5, PH(ph_norm(Q, l, 1, ntok, bid, nblk)));      xcd_barrier(bar);
        DUP(6, PH(ph_score_pg(Q, l, ntok, bid, nblk, smem)));        xcd_barrier(bar);
        DUP(7, PH(ph_topk(Q, ntok, bid, nblk, smem)));
        if (l < DEPTH - 1 && nblk == 256 && bid >= 64) { PH(ph_peer_cvt(Q, bid - 64, 192, l + 1, l + 2, 1, 2)); }
        xcd_barrier(bar);
        DUP(8, PH(ph_peer_u(Q, l, ntok, bid, nblk)));    xcd_barrier(bar);
        DUP(9, PH(ph_peer_a(Q, ntok, bid, nblk)));       xcd_barrier(bar);
        PH(ph_peer_v(Q, l, ntok, bid, nblk)); if (DUPM & (1 << 10)) { PH(ph_peer_v(Q, l, ntok, bid, nblk, true)); }   xcd_barrier(bar);
    }
#undef PH
#undef DUP
#undef LND
#undef GASQ
}

extern "C" void kernel_launch(void* const* d_in, const int* in_sizes, int n_in, void* d_out, int out_size, void* d_ws, size_t ws_size, hipStream_t stream) {
    static int grid = 0;
    if (grid == 0) {
        if (n_in != 21 || ws_size < WS_END) { grid = -1; return; }
        int dev = 0, cus = 0, per_cu = 0;
        if (hipGetDevice(&dev) != hipSuccess || hipDeviceGetAttribute(&cus, hipDeviceAttributeMultiprocessorCount, dev) != hipSuccess) { grid = -1; return; }
        if (hipFuncSetAttribute((const void*)mega_fwd, hipFuncAttributeMaxDynamicSharedMemorySize, LDS_BYTES) != hipSuccess) { grid = -1; return; }
        if (hipOccupancyMaxActiveBlocksPerMultiprocessor(&per_cu, (const void*)mega_fwd, 512, LDS_BYTES) != hipSuccess || per_cu < 1) { (void)hipGetLastError(); }
        grid = (cus / 8) * 8;
    }
    if (grid < 0) return;
    (void)hipMemsetAsync((char*)d_ws + OFF_CTL, 0, 65536, stream);
    Params P{};
    const float** f = (const float**)&P;
    for (int i = 0; i < 21; ++i) f[i] = (const float*)d_in[i];
    P.out = (float*)d_out; P.ws = (unsigned char*)d_ws;
    hipLaunchKernelGGL(mega_fwd, dim3(grid), dim3(512), LDS_BYTES, stream, P);
}
```

```cpp
#include <hip/hip_runtime.h>
#include <stdint.h>
#include <hip/hip_bf16.h>
#include <cmath>

typedef unsigned short bf16_t;
typedef short bf16x8 __attribute__((ext_vector_type(8)));
typedef float f32x4 __attribute__((ext_vector_type(4)));
typedef float f32x16 __attribute__((ext_vector_type(16)));
typedef unsigned u32x4 __attribute__((ext_vector_type(4)));
typedef unsigned u32x2 __attribute__((ext_vector_type(2)));
typedef float f32x2_t __attribute__((ext_vector_type(2)));
typedef __bf16 bf16x2_t __attribute__((ext_vector_type(2)));
typedef int i32x8 __attribute__((ext_vector_type(8)));
typedef int i32x4_ __attribute__((ext_vector_type(4)));
constexpr int SIGLUT_OFF = 131072 + 1024;
constexpr float G8_SCALE = 64.0f;

constexpr int D = 1024, NB = 16, SEQ = 2048, DEPTH = 4, CTX = 256;
constexpr int NL = NB * SEQ, NC = NB * CTX, NT = NL + NC;
constexpr int INC = 4352;
constexpr int KV = SEQ + CTX;
constexpr int NEXP = 16384;
constexpr float C2 = 0.125f * 1.4426950408889634f;
constexpr float EPS = 1e-6f;

constexpr size_t MiB = 1u << 20;
constexpr size_t OFF_CTL = 0;
constexpr size_t OFF_MOD = 1 * MiB;
constexpr size_t OFF_SC = 3 * MiB + 512 * 1024;
constexpr size_t OFF_ROPE = 3 * MiB;
constexpr size_t OFF_XC = 4 * MiB;
constexpr size_t OFF_HB = 20 * MiB;
constexpr size_t OFF_MIX = 92 * MiB;
constexpr size_t OFF_KALL = 164 * MiB;
constexpr size_t OFF_VALL = 173 * MiB;
constexpr size_t OFF_EID = 182 * MiB;
constexpr size_t OFF_GW = 200 * MiB;
constexpr size_t OFF_GT = 218 * MiB;
constexpr size_t OFF_QR = 434 * MiB;
constexpr size_t OFF_ZTL = 470 * MiB;
constexpr size_t OFF_ZTC = 502 * MiB;
constexpr size_t OFF_PP = 506 * MiB;
constexpr size_t OFF_ST = 218 * MiB;
constexpr size_t OFF_W1T = 524 * MiB;
constexpr size_t OFF_WFT = 556 * MiB;
constexpr size_t OFF_WMT = 560 * MiB;
constexpr size_t OFF_WOT = 568 * MiB;
constexpr size_t OFF_WST = 576 * MiB;
constexpr size_t OFF_ADFT = 592 * MiB;
constexpr size_t OFF_ADFTC = 608 * MiB;
constexpr size_t OFF_PU = 609 * MiB;
constexpr size_t OFF_PV = 737 * MiB;
constexpr size_t OFF_WG8 = 866 * MiB;
constexpr size_t OFF_HB8 = 880 * MiB;
constexpr size_t WS_END = 916 * MiB;

struct Params {
    const float *x, *c, *ctx, *c_ctx, *ada_w, *ada_b, *norm_mix, *w_in, *fourier_w, *pool_w, *pool_scale, *pool_proj, *q_norm, *k_norm,
        *attn_proj, *w_out, *norm_ffn, *peer_wq, *peer_keys, *peer_u, *peer_v;
    float* out;
    unsigned char* ws;
};

__device__ __forceinline__ unsigned pk_bf16(float lo, float hi) { f32x2_t v = {lo, hi}; bf16x2_t b = __builtin_convertvector(v, bf16x2_t); return __builtin_bit_cast(unsigned, b); }
__device__ __forceinline__ float bf_lo(unsigned u) { return __uint_as_float(u << 16); }
__device__ __forceinline__ float bf_hi(unsigned u) { return __uint_as_float(u & 0xffff0000u); }
__device__ __forceinline__ float sigmoidf_(float x) { return __builtin_amdgcn_rcpf(1.0f + __expf(-x)); }
__device__ __forceinline__ float gelu_tanh(float x) { const float y = 0.7978845608028654f * (x + 0.044715f * x * x * x); const float t = 1.0f - 2.0f * __builtin_amdgcn_rcpf(1.0f + __expf(2.0f * y)); return 0.5f * x * (1.0f + t); }
template <int CTRL> __device__ __forceinline__ float dpp_f(float v) { return __builtin_bit_cast(float, __builtin_amdgcn_update_dpp(0, __builtin_bit_cast(int, v), CTRL, 0xF, 0xF, true)); }
#define DPP_F(v, ctrl) dpp_f<(ctrl)>(v)
__device__ __forceinline__ float xsum16(float v) { const unsigned u = __builtin_bit_cast(unsigned, v); auto r = __builtin_amdgcn_permlane16_swap(u, u, false, false); return __builtin_bit_cast(float, (unsigned)r[0]) + __builtin_bit_cast(float, (unsigned)r[1]); }
__device__ __forceinline__ float xsum32(float v) { const unsigned u = __builtin_bit_cast(unsigned, v); auto r = __builtin_amdgcn_permlane32_swap(u, u, false, false); return __builtin_bit_cast(float, (unsigned)r[0]) + __builtin_bit_cast(float, (unsigned)r[1]); }
__device__ __forceinline__ float sum8(float v) { v += DPP_F(v, 0xB1); v += DPP_F(v, 0x4E); v += DPP_F(v, 0x141); return v; }
__device__ __forceinline__ float wave_sum(float v) { v = sum8(v); v += DPP_F(v, 0x140); v = xsum16(v); return xsum32(v); }
__device__ __forceinline__ int tidx() { int t = threadIdx.x; asm volatile("" : "+v"(t)); return t; }
__device__ __forceinline__ float dot2bf(unsigned a, unsigned b, float acc) { return __builtin_amdgcn_fdot2_f32_bf16(__builtin_bit_cast(bf16x2_t, a), __builtin_bit_cast(bf16x2_t, b), acc, false); }
__device__ __forceinline__ float dot8(u32x4 a, u32x4 b, float acc) {
    const unsigned a0 = a.x, a1 = a.y, a2 = a.z, a3 = a.w, b0 = b.x, b1 = b.y, b2 = b.z, b3 = b.w;
    acc = dot2bf(a0, b0, acc); acc = dot2bf(a1, b1, acc); acc = dot2bf(a2, b2, acc); acc = dot2bf(a3, b3, acc);
    return acc;
}
__device__ __forceinline__ float* xrow_ptr(const Params& P, int row) { return row < NL ? P.out + (size_t)row * D : (float*)(P.ws + OFF_XC) + (size_t)(row - NL) * D; }
__device__ __forceinline__ int mod_r(int row) { return row < NL ? (row >> 11) : 16; }
__device__ __forceinline__ const float* mod_ptr(const Params& P, int l, int r, int j) { return (const float*)(P.ws + OFF_MOD) + ((size_t)(l * 17 + r) * 6 + j) * D; }
__device__ __forceinline__ int kv_row(int row) { return row < NL ? (row >> 11) * KV + (row & 2047) : ((row - NL) >> 8) * KV + SEQ + ((row - NL) & 255); }

__device__ __forceinline__ void ph_tables(const Params& P, int bid, int nblk) {
    const int TID = tidx();
    float* rc = (float*)(P.ws + OFF_ROPE); float* rs = rc + SEQ * 32;
    for (int i = bid * 512 + TID; i < SEQ * 32; i += nblk * 512) {
        const int t = i >> 5, f = i & 31; const float pos = (float)(f < 16 ? (t >> 6) : (t & 63));
        const float inv = powf(10000.0f, -(float)(f & 15) / 16.0f); const float ang = pos * inv;
        float s, c; sincosf(ang, &s, &c); rc[i] = c; rs[i] = s;
    }
    bf16_t* A = (bf16_t*)(P.ws + OFF_ADFT);
    for (size_t i = (size_t)bid * 512 + TID; i < (size_t)2048 * 2048; i += (size_t)nblk * 512) {
        const int kp = (int)(i >> 11), t = (int)(i & 2047); const int m = (kp * t) & 2047;
        float s, c; sincospif((float)m * (1.0f / 1024.0f), &s, &c);
        A[(size_t)kp * 4096 + t] = (bf16_t)(pk_bf16(c, 0.f) & 0xffff); A[(size_t)kp * 4096 + 2048 + t] = (bf16_t)(pk_bf16(-s, 0.f) & 0xffff);
    }
    bf16_t* Ac = (bf16_t*)(P.ws + OFF_ADFTC);
    for (int i = bid * 512 + TID; i < 256 * 256; i += nblk * 512) {
        const int kp = i >> 8, t = i & 255; const int m = (kp * t) & 255;
        float s, c; sincospif((float)m * (1.0f / 128.0f), &s, &c);
        Ac[kp * 512 + t] = (bf16_t)(pk_bf16(c, 0.f) & 0xffff); Ac[kp * 512 + 256 + t] = (bf16_t)(pk_bf16(-s, 0.f) & 0xffff);
    }
}
__device__ __forceinline__ void ph_mod(const Params& P, int bid, int nblk, float* lds) {
    const int TID = tidx();
    const int tid = TID, c4 = tid & 7, ks = tid >> 3, lane = tid & 63, wid = tid >> 6;
    float* mod = (float*)(P.ws + OFF_MOD);
    float* lsc = lds;
    float* red = lds + 17 * D;
    __syncthreads();
    for (int i = tid; i < 17 * D; i += 512) { const float v = i < 16 * D ? P.c[i] : P.c_ctx[i - 16 * D]; lsc[i] = v * sigmoidf_(v); }
    __syncthreads();
    for (int u = bid; u < DEPTH * 192; u += nblk) {
        const int l = u / 192;
        f32x4 acc[17];
#pragma unroll
        for (int r = 0; r < 17; ++r) acc[r] = (f32x4){0.f, 0.f, 0.f, 0.f};
        const float* w = P.ada_w + ((size_t)l * D + ks * 16) * 6144 + (u % 192) * 32 + c4 * 4;
        f32x4 wv[16];
#pragma unroll
        for (int q = 0; q < 16; ++q) wv[q] = *(const f32x4*)(w + (size_t)q * 6144);
#pragma unroll
        for (int q4 = 0; q4 < 4; ++q4)
#pragma unroll
            for (int r = 0; r < 17; ++r) { const f32x4 cc = *(const f32x4*)(lsc + r * D + ks * 16 + 4 * q4);
                acc[r] += cc.x * wv[4 * q4] + cc.y * wv[4 * q4 + 1] + cc.z * wv[4 * q4 + 2] + cc.w * wv[4 * q4 + 3]; }
#pragma unroll
        for (int r = 0; r < 17; ++r)
#pragma unroll
            for (int e = 0; e < 4; ++e) { float v = acc[r][e]; v += dpp_f<0x128>(v);
                auto sw = __builtin_amdgcn_permlane16_swap(__builtin_bit_cast(unsigned, v), __builtin_bit_cast(unsigned, v), false, false);
                acc[r][e] = __builtin_bit_cast(float, (unsigned)sw[0]) + __builtin_bit_cast(float, (unsigned)sw[1]); }
        __syncthreads();
        if ((lane & 24) == 0) { const int g = wid * 2 + (lane >> 5);
#pragma unroll
            for (int r = 0; r < 17; ++r) *(f32x4*)(red + (g * 17 + r) * 32 + c4 * 4) = acc[r]; }
        __syncthreads();
        for (int i = tid; i < 17 * 32; i += 512) { const int r = i >> 5, c = i & 31; float sum = 0.f;
#pragma unroll
            for (int q = 0; q < 16; ++q) sum += red[(q * 17 + r) * 32 + c];
            const int jj = (u % 192) * 32 + c; mod[(size_t)(l * 17 + r) * 6144 + jj] = sum + P.ada_b[l * 6144 + jj]; }
    }
}
__device__ __forceinline__ void tr_cvt_tile_w(const float* src, int ldn, bf16_t* dst, int ldk, int N, int tile, float* lw, int lane) {
    const int tn = N / 64; const int k0 = (tile / tn) * 32, n0 = (tile % tn) * 64;
    float v[32];
#pragma unroll
    for (int kk = 0; kk < 32; ++kk) v[kk] = src[(size_t)(k0 + kk) * ldn + n0 + lane];
#pragma unroll
    for (int kk = 0; kk < 32; ++kk) lw[kk * 65 + lane] = v[kk];
    asm volatile("s_waitcnt lgkmcnt(0)" ::: "memory");
#pragma unroll
    for (int it = 0; it < 4; ++it) { const int row = it * 16 + (lane >> 2), ch = (lane & 3) * 8; u32x4 o;
        o.x = pk_bf16(lw[(ch + 0) * 65 + row], lw[(ch + 1) * 65 + row]); o.y = pk_bf16(lw[(ch + 2) * 65 + row], lw[(ch + 3) * 65 + row]);
        o.z = pk_bf16(lw[(ch + 4) * 65 + row], lw[(ch + 5) * 65 + row]); o.w = pk_bf16(lw[(ch + 6) * 65 + row], lw[(ch + 7) * 65 + row]);
        *(u32x4*)(dst + (size_t)(n0 + row) * ldk + k0 + ch) = o; }
    asm volatile("s_waitcnt lgkmcnt(0)" ::: "memory");
}
__device__ __forceinline__ void ph_wtrans(const Params& P, int bid, int nblk, float* lds) {
    const int TID = tidx(); const int wid = __builtin_amdgcn_readfirstlane(TID >> 6), lane = TID & 63;
    float* lw = lds + wid * (32 * 65);
    __syncthreads();
    for (int u = bid * 8 + wid; u < DEPTH * 2944; u += nblk * 8) {
        const int l = u / 2944; int t = u % 2944;
        if (t < 2048) tr_cvt_tile_w(P.w_in + (size_t)l * D * INC + 256, INC, (bf16_t*)(P.ws + OFF_W1T) + (size_t)l * 4096 * D, D, 4096, t, lw, lane);
        else if (t < 2560) tr_cvt_tile_w(P.w_out + (size_t)l * D * D, D, (bf16_t*)(P.ws + OFF_WOT) + (size_t)l * D * D, D, D, t - 2048, lw, lane);
        else if (t < 2688) tr_cvt_tile_w(P.fourier_w + (size_t)l * 256 * D, D, (bf16_t*)(P.ws + OFF_WMT) + (size_t)l * D * D, D, D, t - 2560, lw, lane);
        else tr_cvt_tile_w(P.attn_proj + (size_t)l * 512 * D, D, (bf16_t*)(P.ws + OFF_WMT) + (size_t)l * D * D + 512, D, D, t - 2688, lw, lane);
    }
    __syncthreads();
}
__device__ __forceinline__ void ph_wft(const Params& P, int bid, int nblk, float* lds) {
    const int TID = tidx();
    const int tid = TID, lane = TID & 63, r = lane & 31, hi = lane >> 5; const int wid = __builtin_amdgcn_readfirstlane(TID >> 6);
    __syncthreads();
    if (tid < 64) { float s, c; sincospif((float)tid * (1.0f / 32.0f), &s, &c); lds[tid] = c; lds[64 + tid] = s; }
    __syncthreads();
    bf16_t* W = (bf16_t*)(P.ws + OFF_WFT);
    for (int u = bid * 8 + wid; u < DEPTH * 512; u += nblk * 8) {
        const int kt = u & 31, jt = (u >> 5) & 1, part = (u >> 6) & 1, g = (u >> 7) & 3, l = u >> 9;
        const float* tab = lds + part * 64; const int j = jt * 32 + r;
        const float* bp = P.w_in + ((size_t)l * D + kt * 32 + r) * INC + g * 64;
        f32x4 bv[16];
#pragma unroll
        for (int q = 0; q < 16; ++q) bv[q] = *(const f32x4*)(bp + 4 * q);
        f32x16 acc;
#pragma unroll
        for (int q = 0; q < 16; ++q) acc[q] = 0.f;
#pragma unroll
        for (int s2 = 0; s2 < 32; ++s2) { const float a = tab[((2 * s2 + hi) * j) & 63]; const f32x4 b4 = bv[s2 >> 1];
            const float bb = (s2 & 1) ? (hi ? b4.w : b4.z) : (hi ? b4.y : b4.x);
            acc = __builtin_amdgcn_mfma_f32_32x32x2f32(a, bb, acc, 0, 0, 0); }
#pragma unroll
        for (int q = 0; q < 16; ++q) { const int jj = jt * 32 + 8 * (q >> 2) + 4 * hi + (q & 3);
            W[((size_t)l * 512 + part * 256 + g * 64 + jj) * D + kt * 32 + r] = (bf16_t)(pk_bf16(acc[q], 0.f) & 0xffff); }
    }
    __syncthreads();
}
__device__ __forceinline__ unsigned pk_fp8x4(float a, float b, float c, float d) { int w = __builtin_amdgcn_cvt_pk_fp8_f32(a, b, 0, false); w = __builtin_amdgcn_cvt_pk_fp8_f32(c, d, w, true); return (unsigned)w; }
__device__ __forceinline__ void ph_wg8(const Params& P, int bid, int nblk, float* lds) {
    const int TID = tidx(); const int wid = __builtin_amdgcn_readfirstlane(TID >> 6), lane = TID & 63;
    float* lw = lds + wid * (32 * 65);
    __syncthreads();
    for (int u = bid * 8 + wid; u < DEPTH * 1536; u += nblk * 8) {
        const int l = u / 1536, t = u % 1536; const int k0 = (t / 48) * 32, n0 = (t % 48) * 64;
        const float* src = P.w_in + (size_t)l * D * INC + 1280; unsigned char* dst = P.ws + OFF_WG8 + (size_t)l * 3072 * D;
        float v[32];
#pragma unroll
        for (int kk = 0; kk < 32; ++kk) v[kk] = src[(size_t)(k0 + kk) * INC + n0 + lane];
#pragma unroll
        for (int kk = 0; kk < 32; ++kk) lw[kk * 65 + lane] = v[kk] * G8_SCALE;
        asm volatile("s_waitcnt lgkmcnt(0)" ::: "memory");
#pragma unroll
        for (int it = 0; it < 2; ++it) { const int row = it * 32 + (lane >> 1), ch = (lane & 1) * 16; u32x4 o;
            o.x = pk_fp8x4(lw[(ch + 0) * 65 + row], lw[(ch + 1) * 65 + row], lw[(ch + 2) * 65 + row], lw[(ch + 3) * 65 + row]);
            o.y = pk_fp8x4(lw[(ch + 4) * 65 + row], lw[(ch + 5) * 65 + row], lw[(ch + 6) * 65 + row], lw[(ch + 7) * 65 + row]);
            o.z = pk_fp8x4(lw[(ch + 8) * 65 + row], lw[(ch + 9) * 65 + row], lw[(ch + 10) * 65 + row], lw[(ch + 11) * 65 + row]);
            o.w = pk_fp8x4(lw[(ch + 12) * 65 + row], lw[(ch + 13) * 65 + row], lw[(ch + 14) * 65 + row], lw[(ch + 15) * 65 + row]);
            *(u32x4*)(dst + (size_t)(n0 + row) * D + k0 + ch) = o; }
        asm volatile("s_waitcnt lgkmcnt(0)" ::: "memory");
    }
    __syncthreads();
}
__device__ __forceinline__ void ph_wpool(const Params& P, int bid, int nblk, float* lds) {
    const int TID = tidx();
    bf16_t* W = (bf16_t*)(P.ws + OFF_WMT);
    for (int u = bid; u < DEPTH * 4 * 16; u += nblk) {
        const int nc = u & 15, g = (u >> 4) & 3, l = u >> 6; const int n = nc * 64 + (TID & 63), c0 = (TID >> 6) * 8;
        __syncthreads();
        for (int i = TID; i < 64 * 64; i += 512) lds[i] = P.pool_w[(size_t)(l * 4 + g) * 4096 + i];
        __syncthreads();
        float pr[64];
#pragma unroll
        for (int e = 0; e < 64; ++e) pr[e] = P.pool_proj[((size_t)l * 256 + g * 64 + e) * D + n] * P.pool_scale[l * 256 + g * 64 + e];
        float a[8];
#pragma unroll
        for (int c = 0; c < 8; ++c) { a[c] = 0.f;
#pragma unroll
            for (int e = 0; e < 64; ++e) a[c] += lds[(c0 + c) * 64 + e] * pr[e]; }
        u32x4 o; o.x = pk_bf16(a[0], a[1]); o.y = pk_bf16(a[2], a[3]); o.z = pk_bf16(a[4], a[5]); o.w = pk_bf16(a[6], a[7]);
        *(u32x4*)(W + ((size_t)l * D + n) * D + 256 + g * 64 + c0) = o;
    }
}
__device__ __forceinline__ void ph_wst(const Params& P, int bid, int nblk, int l0, int l1) {
    const int TID = tidx();
    bf16_t* W = (bf16_t*)(P.ws + OFF_WST);
    const int wid = __builtin_amdgcn_readfirstlane(TID >> 6), lane = TID & 63, r = lane & 31, hi = lane >> 5;
    for (int u = l0 * 2048 + bid * 8 + wid; u < l1 * 2048; u += nblk * 8) {
        const int kt = u & 31, jt = (u >> 5) & 3, hp = (u >> 7) & 15, l = u >> 11;
        const float* ap = P.peer_keys + ((size_t)(l * 16 + hp) * 128 + jt * 32 + r) * 128;
        const float* bp = P.peer_wq + ((size_t)l * D + kt * 32 + r) * 2048 + hp * 128;
        f32x16 acc;
#pragma unroll
        for (int q = 0; q < 16; ++q) acc[q] = 0.f;
#pragma unroll 1
        for (int q0 = 0; q0 < 32; q0 += 8) { f32x4 av[8], bv[8];
#pragma unroll
            for (int q = 0; q < 8; ++q) { av[q] = *(const f32x4*)(ap + 4 * (q0 + q)); bv[q] = *(const f32x4*)(bp + 4 * (q0 + q)); }
#pragma unroll
            for (int q = 0; q < 8; ++q) {
                acc = __builtin_amdgcn_mfma_f32_32x32x2f32(hi ? av[q].y : av[q].x, hi ? bv[q].y : bv[q].x, acc, 0, 0, 0);
                acc = __builtin_amdgcn_mfma_f32_32x32x2f32(hi ? av[q].w : av[q].z, hi ? bv[q].w : bv[q].z, acc, 0, 0, 0); } }
#pragma unroll
        for (int q = 0; q < 16; ++q) { const int j = jt * 32 + 8 * (q >> 2) + 4 * hi + (q & 3);
            W[((size_t)l * 2048 + hp * 128 + j) * D + kt * 32 + r] = (bf16_t)(pk_bf16(acc[q], 0.f) & 0xffff); }
    }
}
constexpr float U_SCALE = 64.0f, V_SCALE = 8.0f;
__device__ __forceinline__ void ph_peer_cvt(const Params& P, int bid, int nblk, int l0, int l1, int w0 = 0, int w1 = 2) {
    const int TID = tidx();
    const size_t per = (size_t)NEXP * D / 16, nbeg = (size_t)l0 * per, n16 = (size_t)l1 * per;
    for (int w = w0; w < w1; ++w) {
        const f32x4* s = (const f32x4*)(w ? P.peer_v : P.peer_u); unsigned char* d = P.ws + (w ? OFF_PV : OFF_PU); const float sc = w ? V_SCALE : U_SCALE;
        for (size_t i = nbeg + (size_t)bid * 512 + TID; i < n16; i += (size_t)nblk * 512) {
            const f32x4 a = __builtin_nontemporal_load(s + 4 * i), b = __builtin_nontemporal_load(s + 4 * i + 1), c = __builtin_nontemporal_load(s + 4 * i + 2), e4 = __builtin_nontemporal_load(s + 4 * i + 3);
            u32x4 o; o.x = pk_fp8x4(a.x * sc, a.y * sc, a.z * sc, a.w * sc); o.y = pk_fp8x4(b.x * sc, b.y * sc, b.z * sc, b.w * sc); o.z = pk_fp8x4(c.x * sc, c.y * sc, c.z * sc, c.w * sc); o.w = pk_fp8x4(e4.x * sc, e4.y * sc, e4.z * sc, e4.w * sc);
            const size_t row = i >> 6; const int c16 = (int)(i & 63);
            const size_t l = row >> 14, e = row & (NEXP - 1);
            *(u32x4*)(d + (((l * 8 + (c16 >> 3)) * NEXP + e) * 128 + (c16 & 7) * 16)) = o; }
    }
}

__device__ __forceinline__ void ph_norm(const Params& P, int l, int which, int nrows, int bid, int nblk, const bool from_input = false) {
    const int TID = tidx();
    const int wid = __builtin_amdgcn_readfirstlane(TID >> 6), lane = TID & 63;
    const float* gain = (which ? P.norm_ffn : P.norm_mix) + l * D;
    bf16_t* HB = (bf16_t*)(P.ws + OFF_HB);
    f32x4 gg[4];
#pragma unroll
    for (int i = 0; i < 4; ++i) gg[i] = *(const f32x4*)(gain + i * 256 + lane * 4);
    const int stride = nblk * 8;
    for (int row0 = bid * 8 + wid; row0 < nrows; row0 += 2 * stride) {
        f32x4 v[2][4], sa[2][4], sb[2][4];
#pragma unroll
        for (int h = 0; h < 2; ++h) { const int row = min(row0 + h * stride, nrows - 1);
            const float* xr = from_input ? (row < NL ? P.x + (size_t)row * D : P.ctx + (size_t)(row - NL) * D) : xrow_ptr(P, row); const int r = mod_r(row);
            const float* sh = mod_ptr(P, l, r, which ? 3 : 0); const float* sc = mod_ptr(P, l, r, which ? 4 : 1);
#pragma unroll
            for (int i = 0; i < 4; ++i) { v[h][i] = *(const f32x4*)(xr + i * 256 + lane * 4); sa[h][i] = *(const f32x4*)(sc + i * 256 + lane * 4); sb[h][i] = *(const f32x4*)(sh + i * 256 + lane * 4); } }
        asm volatile("" : "+v"(v[0][0]), "+v"(v[0][1]), "+v"(v[0][2]), "+v"(v[0][3]), "+v"(v[1][0]), "+v"(v[1][1]), "+v"(v[1][2]), "+v"(v[1][3]));
#pragma unroll
        for (int h = 0; h < 2; ++h) { const int row = row0 + h * stride;
            float ss = 0.f;
#pragma unroll
            for (int i = 0; i < 4; ++i) ss += v[h][i].x * v[h][i].x + v[h][i].y * v[h][i].y + v[h][i].z * v[h][i].z + v[h][i].w * v[h][i].w;
            ss = wave_sum(ss); const float rstd = rsqrtf(ss * (1.0f / D) + EPS);
            if (row < nrows) {
#pragma unroll
                for (int i = 0; i < 4; ++i) { const int c = i * 256 + lane * 4; const f32x4 g = gg[i], a = sa[h][i], b = sb[h][i];
                    const float o0 = v[h][i].x * rstd * g.x * (1.f + a.x) + b.x, o1 = v[h][i].y * rstd * g.y * (1.f + a.y) + b.y, o2 = v[h][i].z * rstd * g.z * (1.f + a.z) + b.z, o3 = v[h][i].w * rstd * g.w * (1.f + a.w) + b.w;
                    u32x2 o; o.x = pk_bf16(o0, o1); o.y = pk_bf16(o2, o3); *(u32x2*)(HB + (size_t)row * D + c) = o;
                    if (!which) *(unsigned*)(P.ws + OFF_HB8 + (size_t)row * D + c) = pk_fp8x4(o0, o1, o2, o3); }
            }
        }
    }
}

__device__ __forceinline__ void ph_l3(const Params& P, int l, int bid, int nblk) {
    const int TID = tidx();
    const float* rc = (const float*)(P.ws + OFF_ROPE); const float* rs = rc + SEQ * 32;
    {
        const int sub = TID & 7; const bool hi_half = (sub & 2) != 0;
        const f32x4 gq0 = *(const f32x4*)(P.q_norm + l * 64 + sub * 8), gq1 = *(const f32x4*)(P.q_norm + l * 64 + sub * 8 + 4), gk0 = *(const f32x4*)(P.k_norm + l * 64 + sub * 8), gk1 = *(const f32x4*)(P.k_norm + l * 64 + sub * 8 + 4);
        const int stride = nblk * 64, NI = NT * 10;
        for (int i0 = (bid * 512 + TID) >> 3; i0 < NI; i0 += 4 * stride) {
            u32x4 vv[4]; f32x4 rc0[4], rc1[4], rs0[4], rs1[4]; bf16_t* pp[4];
#pragma unroll
            for (int b4 = 0; b4 < 4; ++b4) { const int i = min(i0 + b4 * stride, NI - 1); const int row = i / 10, slot = i - row * 10; const bool isq = slot < 8;
                pp[b4] = (isq ? (bf16_t*)(P.ws + OFF_QR) + (size_t)row * 512 + slot * 64 : (bf16_t*)(P.ws + OFF_KALL) + (size_t)kv_row(row) * 128 + (slot - 8) * 64) + sub * 8;
                vv[b4] = *(const u32x4*)pp[b4];
                const int tix = (row & 2047) * 32 + (sub >> 2) * 16 + (sub & 1) * 8;
                rc0[b4] = *(const f32x4*)(rc + tix); rc1[b4] = *(const f32x4*)(rc + tix + 4); rs0[b4] = *(const f32x4*)(rs + tix); rs1[b4] = *(const f32x4*)(rs + tix + 4); }
            asm volatile("" : "+v"(vv[0]), "+v"(vv[1]), "+v"(vv[2]), "+v"(vv[3]));
#pragma unroll
            for (int b4 = 0; b4 < 4; ++b4) { const int i = i0 + b4 * stride; const int ic = min(i, NI - 1); const int row = ic / 10, slot = ic - row * 10; const bool isq = slot < 8;
                const unsigned v0 = vv[b4].x, v1 = vv[b4].y, v2 = vv[b4].z, v3 = vv[b4].w;
                float x[8] = {bf_lo(v0), bf_hi(v0), bf_lo(v1), bf_hi(v1), bf_lo(v2), bf_hi(v2), bf_lo(v3), bf_hi(v3)};
                float ss = 0.f;
#pragma unroll
                for (int d = 0; d < 8; ++d) ss += x[d] * x[d];
                ss = sum8(ss);
                const float rstd = rsqrtf(ss * (1.0f / 64.0f) + EPS) * (isq ? C2 : 1.0f);
                const f32x4 g0 = isq ? gq0 : gk0, g1 = isq ? gq1 : gk1;
                x[0] *= rstd * g0.x; x[1] *= rstd * g0.y; x[2] *= rstd * g0.z; x[3] *= rstd * g0.w; x[4] *= rstd * g1.x; x[5] *= rstd * g1.y; x[6] *= rstd * g1.z; x[7] *= rstd * g1.w;
                {
                    const f32x4 c0 = rc0[b4], c1 = rc1[b4], s0 = rs0[b4], s1 = rs1[b4]; const bool lat = row < NL;
                    const float cc[8] = {c0.x, c0.y, c0.z, c0.w, c1.x, c1.y, c1.z, c1.w}, sn[8] = {s0.x, s0.y, s0.z, s0.w, s1.x, s1.y, s1.z, s1.w};
#pragma unroll
                    for (int d = 0; d < 8; ++d) { const float other = DPP_F(x[d], 0x4E);
                        const float r = hi_half ? (x[d] * cc[d] + other * sn[d]) : (x[d] * cc[d] - other * sn[d]); x[d] = lat ? r : x[d]; }
                }
                u32x4 o; o.x = pk_bf16(x[0], x[1]); o.y = pk_bf16(x[2], x[3]); o.z = pk_bf16(x[4], x[5]); o.w = pk_bf16(x[6], x[7]);
                if (i < NI) *(u32x4*)pp[b4] = o;
            }
        }
    }
    const bf16_t* PP = (const bf16_t*)(P.ws + OFF_PP); bf16_t* MIX = (bf16_t*)(P.ws + OFF_MIX);
    for (int i = bid * 512 + TID; i < NT * 32; i += nblk * 512) {
        const int row = i >> 5, ch = (i & 31) * 8, g = ch >> 6, win = 2 << g;
        int base, t, L; if (row < NL) { base = row & ~2047; t = row & 2047; L = SEQ; } else { base = NL + ((row - NL) & ~255); t = (row - NL) & 255; L = CTX; }
        const int lo = max(t - win / 2, 0), hi = min(t + win - win / 2, L);
        float s[8];
#pragma unroll
        for (int q = 0; q < 8; ++q) s[q] = 0.f;
        u32x4 wv[16];
#pragma unroll
        for (int k = 0; k < 16; ++k) wv[k] = *(const u32x4*)(PP + (size_t)(base + min(lo + k, hi - 1)) * 256 + ch);
#pragma unroll
        for (int k = 0; k < 16; ++k) { const float w = lo + k < hi ? 1.0f : 0.0f; const unsigned a0 = wv[k].x, a1 = wv[k].y, a2 = wv[k].z, a3 = wv[k].w;
            s[0] += w * bf_lo(a0); s[1] += w * bf_hi(a0); s[2] += w * bf_lo(a1); s[3] += w * bf_hi(a1); s[4] += w * bf_lo(a2); s[5] += w * bf_hi(a2); s[6] += w * bf_lo(a3); s[7] += w * bf_hi(a3); }
        const float inv = 1.0f / (float)(hi - lo); const u32x4 me = *(const u32x4*)(PP + (size_t)row * 256 + ch);
        u32x4 o; o.x = pk_bf16(s[0] * inv - bf_lo(me.x), s[1] * inv - bf_hi(me.x)); o.y = pk_bf16(s[2] * inv - bf_lo(me.y), s[3] * inv - bf_hi(me.y));
        o.z = pk_bf16(s[4] * inv - bf_lo(me.z), s[5] * inv - bf_hi(me.z)); o.w = pk_bf16(s[6] * inv - bf_lo(me.w), s[7] * inv - bf_hi(me.w));
        *(u32x4*)(MIX + (size_t)row * D + 256 + ch) = o;
    }
}

__device__ __forceinline__ int fkey(float v) { const int b = __float_as_int(v); return b ^ ((b >> 31) & 0x7fffffff); }
__device__ __forceinline__ float kval(int k) { return __int_as_float(k ^ ((k >> 31) & 0x7fffffff)); }
__device__ __forceinline__ float kval16(int k) { const int s = k >> 16; return __int_as_float((s ^ ((s >> 31) & 0x7fff)) << 16); }
#define CE_DESC(a, b) do { const int hi_ = max(a, b), lo_ = min(a, b); a = hi_; b = lo_; } while (0)
__device__ __forceinline__ void bitonic_merge16(int (&a)[16]) {
#pragma unroll
    for (int j = 8; j > 0; j >>= 1)
#pragma unroll
        for (int i = 0; i < 16; ++i) { const int l = i ^ j; if (l > i) CE_DESC(a[i], a[l]); }
}
__device__ __forceinline__ void bitonic_sort16(int (&a)[16]) {
#pragma unroll
    for (int k = 2; k <= 16; k <<= 1)
#pragma unroll
        for (int j = k >> 1; j > 0; j >>= 1)
#pragma unroll
            for (int i = 0; i < 16; ++i) { const int l = i ^ j; if (l > i) { if ((i & k) == 0 || k == 16) CE_DESC(a[i], a[l]); else CE_DESC(a[l], a[i]); } }
}
__device__ __forceinline__ void top16_merge(int (&run)[16], int (&c)[16]) {
    bitonic_sort16(c);
#pragma unroll
    for (int i = 0; i < 16; ++i) run[i] = max(run[i], c[15 - i]);
    bitonic_merge16(run);
}
__device__ __forceinline__ void ph_topk(const Params& P, int ntok, int bid, int nblk, unsigned char* lds) {
    const int TID = tidx();
    const int wid = __builtin_amdgcn_readfirstlane(TID >> 6), lane = TID & 63;
    const bf16_t* ST = (const bf16_t*)(P.ws + OFF_ST); unsigned* EID = (unsigned*)(P.ws + OFF_EID); float* GW = (float*)(P.ws + OFF_GW);
    unsigned char* myl = lds + TID * 36;
    for (int u = bid * 8 + wid; u < (ntok / 64) * 8; u += nblk * 8) {
        const int h = u & 7, tok = (u >> 3) * 64 + lane;
        int l1[16], l2[16];
        const bf16_t* s1 = ST + (size_t)(h * 256) * NT + tok; const bf16_t* s2 = s1 + (size_t)128 * NT;
        unsigned fa[16], fb[16];
#pragma unroll
        for (int q = 0; q < 16; ++q) { fa[q] = s1[(size_t)q * NT]; fb[q] = s2[(size_t)q * NT]; }
#pragma unroll 1
        for (int j0 = 0; j0 < 128; j0 += 16) {
            int a[16], b[16];
#pragma unroll
            for (int q = 0; q < 16; ++q) { a[q] = (int)((fa[q] << 16) | (unsigned)(127 - (j0 + q))); b[q] = (int)((fb[q] << 16) | (unsigned)(127 - (j0 + q))); }
            const int jn = j0 + 16 < 128 ? j0 + 16 : j0;
#pragma unroll
            for (int q = 0; q < 16; ++q) { fa[q] = s1[(size_t)(jn + q) * NT]; fb[q] = s2[(size_t)(jn + q) * NT]; }
            if (j0 == 0) { bitonic_sort16(a); bitonic_sort16(b);
#pragma unroll
                for (int i = 0; i < 16; ++i) { l1[i] = a[i]; l2[i] = b[i]; } }
            else { top16_merge(l1, a); top16_merge(l2, b); }
        }
        float v1[16], v2[16];
#pragma unroll
        for (int i = 0; i < 16; ++i) { v1[i] = kval16(l1[i]); v2[i] = kval16(l2[i]); myl[i] = (unsigned char)(127 - (l1[i] & 127)); myl[16 + i] = (unsigned char)(127 - (l2[i] & 127)); }
        int cd[64];
        { int n = 0;
#pragma unroll
          for (int i = 0; i < 16; ++i)
#pragma unroll
              for (int j = 0; j < 16; ++j) if ((i + 1) * (j + 1) <= 16) { cd[n] = (fkey(v1[i] + v2[j]) & ~255) | (255 - (i * 16 + j)); ++n; }
#pragma unroll
          for (int q = 50; q < 64; ++q) cd[q] = INT_MIN; }
        int l3[16], c[16];
#pragma unroll
        for (int q = 0; q < 16; ++q) l3[q] = cd[q];
#pragma unroll
        for (int q = 0; q < 8; ++q) c[q] = cd[16 + q];
        c[8] = INT_MIN; c[9] = INT_MIN; c[10] = INT_MIN; c[11] = cd[28]; c[12] = cd[27]; c[13] = cd[26]; c[14] = cd[25]; c[15] = cd[24];
        bitonic_merge16(c);
#pragma unroll
        for (int i = 0; i < 16; ++i) l3[i] = max(l3[i], c[15 - i]);
        bitonic_merge16(l3);
#pragma unroll
        for (int q = 0; q < 13; ++q) c[q] = cd[29 + q];
        c[13] = INT_MIN; c[14] = INT_MIN; c[15] = INT_MIN;
        top16_merge(l3, c);
#pragma unroll
        for (int i = 0; i < 8; ++i) l3[8 + i] = max(l3[8 + i], cd[49 - i]);
        bitonic_merge16(l3);
        float t[16]; float sum = 0.f; const float t0 = kval((l3[0] & ~255) | 128);
#pragma unroll
        for (int k = 0; k < 16; ++k) { t[k] = __expf(kval((l3[k] & ~255) | 128) - t0); sum += t[k]; }
        const float inv = 1.0f / sum;
        int e[16];
#pragma unroll
        for (int k = 0; k < 16; ++k) { const int pos = 255 - (l3[k] & 255); e[k] = (int)myl[pos >> 4] * 128 + (int)myl[16 + (pos & 15)]; t[k] *= inv; }
#pragma unroll
        for (int k = 0; k < 16; k += 4) *(f32x4*)(GW + (size_t)tok * 128 + h * 16 + k) = (f32x4){t[k], t[k + 1], t[k + 2], t[k + 3]};
#pragma unroll
        for (int k = 0; k < 16; k += 8) *(u32x4*)(EID + (size_t)tok * 64 + h * 8 + (k >> 1)) = (u32x4){(unsigned)e[k] | ((unsigned)e[k + 1] << 16), (unsigned)e[k + 2] | ((unsigned)e[k + 3] << 16), (unsigned)e[k + 4] | ((unsigned)e[k + 5] << 16), (unsigned)e[k + 6] | ((unsigned)e[k + 7] << 16)};
    }
}

constexpr size_t OFF_PB = OFF_ST;
constexpr size_t OFF_CV = OFF_ST + 144 * MiB;
__device__ __forceinline__ int id16(const u32x4& a, const u32x4& b, int it) {
    const unsigned w = it < 8 ? (it < 4 ? (it < 2 ? a.x : a.y) : (it < 6 ? a.z : a.w)) : (it < 12 ? (it < 10 ? b.x : b.y) : (it < 14 ? b.z : b.w));
    return (it & 1) ? (int)(w >> 16) : (int)(w & 0xffffu);
}
__device__ __forceinline__ void unpk_fp8x16p(const u32x4& w, f32x2_t (&f)[8]) {
    const unsigned d0 = w.x, d1 = w.y, d2 = w.z, d3 = w.w;
    f[0] = __builtin_amdgcn_cvt_pk_f32_fp8((int)d0, false); f[1] = __builtin_amdgcn_cvt_pk_f32_fp8((int)d0, true); f[2] = __builtin_amdgcn_cvt_pk_f32_fp8((int)d1, false); f[3] = __builtin_amdgcn_cvt_pk_f32_fp8((int)d1, true);
    f[4] = __builtin_amdgcn_cvt_pk_f32_fp8((int)d2, false); f[5] = __builtin_amdgcn_cvt_pk_f32_fp8((int)d2, true); f[6] = __builtin_amdgcn_cvt_pk_f32_fp8((int)d3, false); f[7] = __builtin_amdgcn_cvt_pk_f32_fp8((int)d3, true);
}
__device__ __forceinline__ void unpk_fp8x16(const u32x4& w, float (&f)[16]) {
    const unsigned d0 = w.x, d1 = w.y, d2 = w.z, d3 = w.w;
    f32x2_t t;
    t = __builtin_amdgcn_cvt_pk_f32_fp8((int)d0, false); f[0] = t.x; f[1] = t.y; t = __builtin_amdgcn_cvt_pk_f32_fp8((int)d0, true); f[2] = t.x; f[3] = t.y;
    t = __builtin_amdgcn_cvt_pk_f32_fp8((int)d1, false); f[4] = t.x; f[5] = t.y; t = __builtin_amdgcn_cvt_pk_f32_fp8((int)d1, true); f[6] = t.x; f[7] = t.y;
    t = __builtin_amdgcn_cvt_pk_f32_fp8((int)d2, false); f[8] = t.x; f[9] = t.y; t = __builtin_amdgcn_cvt_pk_f32_fp8((int)d2, true); f[10] = t.x; f[11] = t.y;
    t = __builtin_amdgcn_cvt_pk_f32_fp8((int)d3, false); f[12] = t.x; f[13] = t.y; t = __builtin_amdgcn_cvt_pk_f32_fp8((int)d3, true); f[14] = t.x; f[15] = t.y;
}
__device__ __forceinline__ unsigned rowoff16(const u32x4 (&id)[2], int it, unsigned lo16, unsigned c128) {
    const u32x4 v4 = id[it >> 3]; const int e = (it >> 1) & 3; const unsigned w = e == 0 ? v4.x : e == 1 ? v4.y : e == 2 ? v4.z : v4.w; unsigned r;
    if (it & 1) asm("v_mad_u32_u16 %0, %1, %2, %3 op_sel:[1,0,0,0]" : "=v"(r) : "v"(w), "v"(c128), "v"(lo16));
    else        asm("v_mad_u32_u16 %0, %1, %2, %3" : "=v"(r) : "v"(w), "v"(c128), "v"(lo16));
    return r;
}
__device__ __forceinline__ void ph_peer_u(const Params& P, int l, int ntok, int bid, int nblk) {
    const int TID = tidx(); const int wid = __builtin_amdgcn_readfirstlane(TID >> 6), lane = TID & 63, c8 = lane & 7, q = lane >> 3;
    const int grp = bid & 7, nw = (nblk >> 3) * 8, w0 = (bid >> 3) * 8 + wid;
    if (w0 >= ntok) return;
    const int tl = w0 + ((ntok - 1 - w0) / nw) * nw;
    const bf16_t* HB = (const bf16_t*)(P.ws + OFF_HB) + grp * 128 + c8 * 16; const unsigned* EID = (const unsigned*)(P.ws + OFF_EID) + q * 8; unsigned c128 = 128u; asm volatile("" : "+v"(c128));
    float* PB = (float*)(P.ws + OFF_PB) + (size_t)grp * NT * 128 + lane;
    const unsigned char* Tu = P.ws + OFF_PU + ((size_t)(l * 8 + grp) * NEXP) * 128;
    const unsigned lo16 = (unsigned)c8 * 16u;
    u32x4 buf[16], idN[2], idNN[2], xaC, xbC, xaN, xbN, xaNN, xbNN;
#define PU_LOADI(T, ID, XA, XB) do { const int T_ = min((T), tl); _Pragma("unroll") for (int i_ = 0; i_ < 2; ++i_) ID[i_] = *(const u32x4*)(EID + (size_t)T_ * 64 + i_ * 4); XA = *(const u32x4*)(HB + (size_t)T_ * D); XB = *(const u32x4*)(HB + (size_t)T_ * D + 8); } while (0)
    { u32x4 id0[2]; PU_LOADI(w0, id0, xaC, xbC);
#pragma unroll
      for (int it = 0; it < 16; ++it) buf[it] = *(const u32x4*)(Tu + rowoff16(id0, it, lo16, c128)); }
    PU_LOADI(w0 + nw, idN, xaN, xbN);
    for (int t0 = w0; t0 < ntok; t0 += nw) {
        PU_LOADI(t0 + 2 * nw, idNN, xaNN, xbNN);
        const unsigned x0 = xaC.x, x1 = xaC.y, x2 = xaC.z, x3 = xaC.w, x4 = xbC.x, x5 = xbC.y, x6 = xbC.z, x7 = xbC.w;
        const f32x2_t xv[8] = {{bf_lo(x0), bf_hi(x0)}, {bf_lo(x1), bf_hi(x1)}, {bf_lo(x2), bf_hi(x2)}, {bf_lo(x3), bf_hi(x3)}, {bf_lo(x4), bf_hi(x4)}, {bf_lo(x5), bf_hi(x5)}, {bf_lo(x6), bf_hi(x6)}, {bf_lo(x7), bf_hi(x7)}};
        float r0 = 0.f, r1 = 0.f;
#pragma unroll
        for (int it = 0; it < 16; ++it) { f32x2_t uf[8]; unpk_fp8x16p(buf[it], uf);
            buf[it] = *(const u32x4*)(Tu + rowoff16(idN, it, lo16, c128));
            f32x2_t d = uf[0] * xv[0];
#pragma unroll
            for (int i = 1; i < 8; ++i) d = __builtin_elementwise_fma(uf[i], xv[i], d);
            const float p = sum8(d.x + d.y); if (c8 == (it & 7)) { if (it < 8) r0 = p; else r1 = p; } }
        float* pb = PB + (size_t)t0 * 128; pb[0] = r0; pb[64] = r1;
        xaC = xaN; xbC = xbN; xaN = xaNN; xbN = xbNN;
#pragma unroll
        for (int i = 0; i < 2; ++i) idN[i] = idNN[i];
    }
#undef PU_LOADI
}
__device__ __forceinline__ void ph_peer_a(const Params& P, int ntok, int bid, int nblk) {
    const int TID = tidx(); const int wid = __builtin_amdgcn_readfirstlane(TID >> 6), lane = TID & 63;
    const float* PB = (const float*)(P.ws + OFF_PB); const float* GW = (const float*)(P.ws + OFF_GW); float* CV = (float*)(P.ws + OFF_CV);
    constexpr int TB = 4;
    const int stride = nblk * 8;
    for (int t0 = bid * 8 + wid; t0 < ntok; t0 += TB * stride) {
        float pb[TB][2][8], gw[TB][2];
#pragma unroll
        for (int h = 0; h < TB; ++h) { const int t = min(t0 + h * stride, ntok - 1);
#pragma unroll
            for (int k = 0; k < 2; ++k) {
#pragma unroll
                for (int j = 0; j < 8; ++j) pb[h][k][j] = PB[((size_t)j * NT + t) * 128 + k * 64 + lane];
                gw[h][k] = GW[(size_t)t * 128 + (lane >> 3) * 16 + k * 8 + (lane & 7)]; } }
        asm volatile("" : "+v"(gw[0][0]), "+v"(gw[1][0]), "+v"(gw[2][0]), "+v"(gw[3][0]), "+v"(gw[0][1]), "+v"(gw[1][1]), "+v"(gw[2][1]), "+v"(gw[3][1]));
#pragma unroll
        for (int h = 0; h < TB; ++h) { const int t = t0 + h * stride;
            if (t < ntok) {
#pragma unroll
                for (int k = 0; k < 2; ++k) { float a = 0.f;
#pragma unroll
                    for (int j = 0; j < 8; ++j) a += pb[h][k][j];
                    const int p = (lane >> 3) * 16 + k * 8 + (lane & 7);
                    ((bf16_t*)CV)[(size_t)t * 128 + p] = (bf16_t)(pk_bf16(gw[h][k] * gelu_tanh(a * (1.0f / U_SCALE)) * (1.0f / V_SCALE), 0.f) & 0xffff); } } }
    }
}
__device__ __forceinline__ float red16(float a, float b) { auto r = __builtin_amdgcn_permlane16_swap(__builtin_bit_cast(unsigned, a), __builtin_bit_cast(unsigned, b), false, false); return __builtin_bit_cast(float, (unsigned)r[0]) + __builtin_bit_cast(float, (unsigned)r[1]); }
__device__ __forceinline__ float red32(float a, float b) { auto r = __builtin_amdgcn_permlane32_swap(__builtin_bit_cast(unsigned, a), __builtin_bit_cast(unsigned, b), false, false); return __builtin_bit_cast(float, (unsigned)r[0]) + __builtin_bit_cast(float, (unsigned)r[1]); }
__device__ __forceinline__ void ph_peer_v(const Params& P, int l, int ntok, int bid, int nblk, const bool dry = false) {
    const int TID = tidx(); const int wid = __builtin_amdgcn_readfirstlane(TID >> 6), lane = TID & 63, c8 = lane & 7, q = lane >> 3;
    const int grp = bid & 7, nw = (nblk >> 3) * 8, w0 = (bid >> 3) * 8 + wid;
    if (w0 >= ntok) return;
    const int tl = w0 + ((ntok - 1 - w0) / nw) * nw;
    unsigned c128 = 128u; asm volatile("" : "+v"(c128)); const unsigned* EID = (const unsigned*)(P.ws + OFF_EID) + q * 8; const unsigned* CV = (const unsigned*)(P.ws + OFF_CV) + q * 8;
    const unsigned char* Tv = P.ws + OFF_PV + ((size_t)(l * 8 + grp) * NEXP) * 128;
    const unsigned lo16 = (unsigned)c8 * 16u;
    const int xcol = grp * 128 + c8 * 16 + 4 * (lane >> 4);
    const bool writer = (lane & 8) == 0;
    u32x4 buf[16], idN[2], idNN[2]; f32x2_t cvC[8], cvN[8];
#define PV_LOADI(T, ID) do { const int T_ = min((T), tl); _Pragma("unroll") for (int i_ = 0; i_ < 2; ++i_) ID[i_] = *(const u32x4*)(EID + (size_t)T_ * 64 + i_ * 4); } while (0)
#define PV_LOADC(T, CVX) do { const int T_ = min((T), tl); _Pragma("unroll") for (int i_ = 0; i_ < 2; ++i_) { const u32x4 c4_ = *(const u32x4*)(CV + (size_t)T_ * 64 + i_ * 4); const unsigned w0_ = c4_.x, w1_ = c4_.y, w2_ = c4_.z, w3_ = c4_.w; CVX[4 * i_] = (f32x2_t){bf_lo(w0_), bf_hi(w0_)}; CVX[4 * i_ + 1] = (f32x2_t){bf_lo(w1_), bf_hi(w1_)}; CVX[4 * i_ + 2] = (f32x2_t){bf_lo(w2_), bf_hi(w2_)}; CVX[4 * i_ + 3] = (f32x2_t){bf_lo(w3_), bf_hi(w3_)}; } } while (0)
    { u32x4 id0[2]; PV_LOADI(w0, id0); PV_LOADC(w0, cvC);
#pragma unroll
      for (int it = 0; it < 16; ++it) buf[it] = *(const u32x4*)(Tv + rowoff16(id0, it, lo16, c128)); }
    PV_LOADI(w0 + nw, idN);
    f32x4 gpre = {0.f, 0.f, 0.f, 0.f}; int rcur = -1;
    for (int t0 = w0; t0 < ntok; t0 += nw) {
        PV_LOADI(t0 + 2 * nw, idNN); PV_LOADC(t0 + nw, cvN);
        float* xp = xrow_ptr(P, t0) + xcol; const float* m5 = mod_ptr(P, l, mod_r(t0), 5) + xcol;
        f32x4 xpre;
        if (!dry && writer) { xpre = *(const f32x4*)xp; const int rr_ = mod_r(t0); if (rr_ != rcur) { gpre = *(const f32x4*)m5; rcur = rr_; } }
        f32x2_t o2[8];
#pragma unroll
        for (int i = 0; i < 8; ++i) o2[i] = (f32x2_t){0.f, 0.f};
#pragma unroll
        for (int it = 0; it < 16; ++it) { f32x2_t vf[8]; unpk_fp8x16p(buf[it], vf);
            buf[it] = *(const u32x4*)(Tv + rowoff16(idN, it, lo16, c128));
#pragma unroll
            for (int i = 0; i < 8; ++i) { if (it & 1) asm("v_pk_fma_f32 %0, %1, %2, %0 op_sel:[0,1,0] op_sel_hi:[1,1,1]" : "+v"(o2[i]) : "v"(vf[i]), "v"(cvC[it >> 1]));
                                          else        asm("v_pk_fma_f32 %0, %1, %2, %0 op_sel_hi:[1,0,1]" : "+v"(o2[i]) : "v"(vf[i]), "v"(cvC[it >> 1])); } }
        float w[16];
#pragma unroll
        for (int i = 0; i < 8; ++i) { const float ox = o2[i].x, oy = o2[i].y; w[2 * i] = ox + DPP_F(ox, 0x128); w[2 * i + 1] = oy + DPP_F(oy, 0x128); }
        float z[4];
#pragma unroll
        for (int j = 0; j < 4; ++j) z[j] = red32(red16(w[j], w[4 + j]), red16(w[8 + j], w[12 + j]));
        if (dry) {
#pragma unroll
            for (int j = 0; j < 4; ++j) asm volatile("" :: "v"(z[j]));
        } else if (writer) {
            f32x4 x = xpre; x.x += gpre.x * z[0]; x.y += gpre.y * z[1]; x.z += gpre.z * z[2]; x.w += gpre.w * z[3]; *(f32x4*)xp = x;
        }
#pragma unroll
        for (int i = 0; i < 8; ++i) cvC[i] = cvN[i];
#pragma unroll
        for (int i = 0; i < 2; ++i) idN[i] = idNN[i];
    }
#undef PV_LOADI
#undef PV_LOADC
}

namespace pg8 {
#define PG8_LAS __attribute__((address_space(3)))
constexpr int BM = 256, BK = 64, HALF = 128, HTB = HALF * BK * 2, STAGE_BYTES = 8 * HTB, NXCD = 8, WGM = 4;
__host__ __device__ __forceinline__ int lds_byte(int r, int c) { const int ch = (c >> 3) ^ ((r >> 1) & 7); return r * 128 + ch * 16 + (c & 7) * 2; }
__host__ __device__ __forceinline__ void stage_rc(int b, int& R, int& C) { R = b >> 7; C = ((((b >> 4) & 7) ^ ((R >> 1) & 7)) << 3) + ((b & 15) >> 1); }
__host__ __device__ __forceinline__ int perm32(int rho) { const int n = rho >> 4, i = rho & 15; return 8 * (i >> 2) + 4 * n + (i & 3); }
struct Unit { int pm, pn, nt, kofs, tag; };
struct Gemm { const bf16_t* A; const bf16_t* Bt; int lda, ldb; };
struct TileOrder {
    int nM, nN, nwg, G, c;
    __device__ __forceinline__ void init(int nM_, int nN_, int G_, int c_) { nM = nM_; nN = nN_; nwg = nM * nN; G = G_; c = c_; }
    __device__ __forceinline__ bool tile(int i, int& pm, int& pn) const {
        const long L = (long)i * G + c; if (L >= nwg) return false;
        int wgid = (int)L; { const int q = nwg / NXCD, r = nwg % NXCD, xcd = wgid % NXCD, off = wgid / NXCD; wgid = (xcd < r ? xcd * (q + 1) : r * (q + 1) + (xcd - r) * q) + off; }
        const int nig = WGM * nN, gid = wgid / nig, fm = gid * WGM, gsz = (nM - fm) < WGM ? (nM - fm) : WGM;
        pm = fm + ((wgid % nig) % gsz); pn = (wgid % nig) / gsz; return true;
    }
};
struct PlainSched { TileOrder T; int nt;
    __device__ __forceinline__ bool next(int i, Unit& u) const { if (!T.tile(i, u.pm, u.pn)) return false; u.nt = nt; u.kofs = 0; u.tag = 0; return true; } };
struct CtxZSched { int c, G, nt;
    __device__ __forceinline__ bool next(int i, Unit& u) const { const int L = i * G + c; if (L >= 32) return false; u.pm = L & 1; u.pn = 128 + (L >> 1); u.nt = nt; u.kofs = 0; u.tag = 0; return true; } };
struct MergeSched { TileOrder T;
    __device__ __forceinline__ bool next(int i, Unit& u) const { const int ti = i / 3, br = i - 3 * ti; if (!T.tile(ti, u.pm, u.pn)) return false;
        u.tag = br; u.nt = br == 2 ? 8 : 4; u.kofs = br == 0 ? 0 : br == 1 ? 512 : 1024; return true; } };

template <class Epi, class Sched, bool FP8 = false>
__device__ __forceinline__ void gemm_phase(PG8_LAS unsigned char* lds, const Gemm g, const Sched& S, const Epi& E) {
    const int TID = tidx();
    const int tid = TID, wid = __builtin_amdgcn_readfirstlane(tid >> 6), lane = tid & 63, wr = wid >> 2, wc = wid & 3, fr = lane & 15, fq = lane >> 4;
    unsigned voffA[2], voffB[2];
#pragma unroll
    for (int i = 0; i < 2; ++i) { int R, C; stage_rc(tid * 16 + i * 8192, R, C); const int Rb = Epi::PERM ? ((R & ~31) + perm32(R & 31)) : R;
        voffA[i] = (unsigned)(R * g.lda + C) * 2u; voffB[i] = (unsigned)(Rb * g.ldb + C) * 2u; }
    const size_t kstep = (size_t)(BK * 2);
    const size_t hstepA = (size_t)HALF * g.lda * 2, hstepB = (size_t)HALF * g.ldb * 2;
    const size_t tstepA = 2 * hstepA, tstepB = 2 * hstepB;
    const unsigned ldsw = (unsigned)wid * 1024u;
    const int aoffk[2] = {lds_byte(wr * 64 + fr, fq * 8), lds_byte(wr * 64 + fr, fq * 8 + 32)}, boffk[2] = {lds_byte(wc * 32 + fr, fq * 8), lds_byte(wc * 32 + fr, fq * 8 + 32)};
#define PG8_SA(b, h) (((b) * 2 + (h)) * HTB)
#define PG8_SB(b, h) ((4 + (b) * 2 + (h)) * HTB)
#define PG8_STAGE(bufoff, gbase, voff) do { _Pragma("unroll") for (int _i = 0; _i < 2; ++_i) \
        __builtin_amdgcn_global_load_lds((const unsigned*)((const char*)(gbase) + (voff)[_i]), (PG8_LAS unsigned*)(lds + (bufoff) + ldsw + _i * 8192), 16, 0, 0); } while (0)
#define PG8_LDA(dst, b, h) do { _Pragma("unroll") for (int m = 0; m < 4; ++m) { if constexpr (FP8) { const i32x4_ lo_ = *(const PG8_LAS i32x4_*)(lds + PG8_SA(b, h) + aoffk[0] + m * 2048), hi_ = *(const PG8_LAS i32x4_*)(lds + PG8_SA(b, h) + aoffk[1] + m * 2048); dst##8[m] = __builtin_shufflevector(lo_, hi_, 0, 1, 2, 3, 4, 5, 6, 7); } \
        else { _Pragma("unroll") for (int k = 0; k < 2; ++k) dst[m][k] = *(const PG8_LAS bf16x8*)(lds + PG8_SA(b, h) + aoffk[k] + m * 2048); } } } while (0)
#define PG8_LDB(dst, b, h) do { _Pragma("unroll") for (int n = 0; n < 2; ++n) { if constexpr (FP8) { const i32x4_ lo_ = *(const PG8_LAS i32x4_*)(lds + PG8_SB(b, h) + boffk[0] + n * 2048), hi_ = *(const PG8_LAS i32x4_*)(lds + PG8_SB(b, h) + boffk[1] + n * 2048); dst##8[n] = __builtin_shufflevector(lo_, hi_, 0, 1, 2, 3, 4, 5, 6, 7); } \
        else { _Pragma("unroll") for (int k = 0; k < 2; ++k) dst[n][k] = *(const PG8_LAS bf16x8*)(lds + PG8_SB(b, h) + boffk[k] + n * 2048); } } } while (0)
#define PG8_MMA(ai, bj, At, Bt) do { __builtin_amdgcn_s_setprio(1); _Pragma("unroll") for (int m = 0; m < 4; ++m) _Pragma("unroll") for (int n = 0; n < 2; ++n) { \
        if constexpr (FP8) asm volatile("v_mfma_scale_f32_16x16x128_f8f6f4 %0, %1, %2, %0, %3, %3 op_sel_hi:[0,0,0]" : "+v"(acc[ai][bj][m][n]) : "v"(Bt##8[n]), "v"(At##8[m]), "v"(scale1));   \
        else { _Pragma("unroll") for (int k = 0; k < 2; ++k) acc[ai][bj][m][n] = __builtin_amdgcn_mfma_f32_16x16x32_bf16(Bt[n][k], At[m][k], acc[ai][bj][m][n], 0, 0, 0); } } \
        __builtin_amdgcn_s_setprio(0); } while (0)
#define PG8_WAIT_V(n) asm volatile("s_waitcnt vmcnt(" #n ")" ::: "memory")
#define PG8_WAIT_L(n) asm volatile("s_waitcnt lgkmcnt(" #n ")" ::: "memory")
#define PG8_BAR __builtin_amdgcn_s_barrier()
#define PG8_SCHED __builtin_amdgcn_sched_barrier(0)
    Unit cur, nxt; int ui = 0;
    if (!S.next(0, cur)) return;
    int scale1 = 0x7F7F7F7F; asm volatile("" : "+v"(scale1));
    f32x4 acc[2][2][4][2];
#pragma unroll
    for (int a = 0; a < 2; ++a)
#pragma unroll
        for (int b = 0; b < 2; ++b)
#pragma unroll
            for (int m = 0; m < 4; ++m)
#pragma unroll
                for (int n = 0; n < 2; ++n) acc[a][b][m][n] = (f32x4){0.f, 0.f, 0.f, 0.f};
    bf16x8 At[4][2], B0[2][2], B1[2][2];
    i32x8 At8[4], B08[2], B18[2];
    const char* cA = (const char*)g.A + (size_t)cur.pm * tstepA + cur.kofs; const char* cB = (const char*)g.Bt + (size_t)cur.pn * tstepB + cur.kofs;
    PG8_STAGE(PG8_SB(0, 0), cB, voffB); PG8_STAGE(PG8_SB(0, 1), cB + hstepB, voffB); PG8_STAGE(PG8_SA(0, 0), cA, voffA); PG8_STAGE(PG8_SA(0, 1), cA + hstepA, voffA);
    if (wr == 1) PG8_BAR;
    PG8_WAIT_V(2); PG8_BAR;
    PG8_STAGE(PG8_SB(1, 0), cB + kstep, voffB); PG8_STAGE(PG8_SA(1, 0), cA + kstep, voffA); PG8_STAGE(PG8_SB(1, 1), cB + hstepB + kstep, voffB);
    PG8_WAIT_V(6); PG8_BAR;
    for (;;) {
        const bool has_next = S.next(ui + 1, nxt);
        const char* nA = has_next ? (const char*)g.A + (size_t)nxt.pm * tstepA + nxt.kofs : cA; const char* nB = has_next ? (const char*)g.Bt + (size_t)nxt.pn * tstepB + nxt.kofs : cB;
        const int nt = cur.nt;
        for (int t = 0; t < nt; t += 2) {
            const bool last = (t == nt - 2);
            const char* a1 = cA + (size_t)(t + 1) * kstep;
            const char* a2 = last ? nA : cA + (size_t)(t + 2) * kstep; const char* b2 = last ? nB : cB + (size_t)(t + 2) * kstep;
            const char* a3 = a2 + kstep; const char* b3 = b2 + kstep;
            PG8_LDB(B0, 0, 0); PG8_LDB(B1, 0, 1); PG8_SCHED; PG8_LDA(At, 0, 0); PG8_STAGE(PG8_SA(1, 1), a1 + hstepA, voffA);
            PG8_WAIT_V(8); PG8_WAIT_L(0); PG8_BAR; PG8_MMA(0, 0, At, B0); PG8_MMA(0, 1, At, B1); PG8_BAR; PG8_SCHED;
            PG8_LDA(At, 0, 1); PG8_STAGE(PG8_SB(0, 0), b2, voffB); PG8_STAGE(PG8_SB(0, 1), b2 + hstepB, voffB); PG8_STAGE(PG8_SA(0, 0), a2, voffA);
            PG8_WAIT_V(8); PG8_WAIT_L(0); PG8_BAR; PG8_MMA(1, 0, At, B0); PG8_MMA(1, 1, At, B1); PG8_BAR; PG8_SCHED;
            PG8_LDB(B0, 1, 0); PG8_LDB(B1, 1, 1); PG8_SCHED; PG8_LDA(At, 1, 0); PG8_STAGE(PG8_SA(0, 1), a2 + hstepA, voffA);
            PG8_WAIT_V(8); PG8_WAIT_L(0); PG8_BAR; PG8_MMA(0, 0, At, B0); PG8_MMA(0, 1, At, B1); PG8_BAR; PG8_SCHED;
            PG8_LDA(At, 1, 1); PG8_STAGE(PG8_SB(1, 0), b3, voffB); PG8_STAGE(PG8_SB(1, 1), b3 + hstepB, voffB); PG8_STAGE(PG8_SA(1, 0), a3, voffA);
            PG8_WAIT_V(8); PG8_WAIT_L(0); PG8_BAR; PG8_MMA(1, 0, At, B0); PG8_MMA(1, 1, At, B1); PG8_BAR; PG8_SCHED;
        }
        if (wr == 0) PG8_BAR;
        if constexpr (FP8) asm volatile("s_nop 15\n\ts_nop 15" ::: "memory");
        E(acc, cur, wr, wc, fr, fq);
        if (!has_next) break;
        if (!E.keeps(cur)) {
#pragma unroll
        for (int a = 0; a < 2; ++a)
#pragma unroll
            for (int b = 0; b < 2; ++b)
#pragma unroll
                for (int m = 0; m < 4; ++m)
#pragma unroll
                    for (int n = 0; n < 2; ++n) acc[a][b][m][n] = (f32x4){0.f, 0.f, 0.f, 0.f};
        }
        cur = nxt; cA = nA; cB = nB; ++ui;
        if (wr == 1) PG8_BAR;
    }
    PG8_WAIT_V(0);
    PG8_BAR;
#undef PG8_SA
#undef PG8_SB
#undef PG8_STAGE
#undef PG8_LDA
#undef PG8_LDB
#undef PG8_MMA
#undef PG8_WAIT_V
#undef PG8_WAIT_L
#undef PG8_BAR
#undef PG8_SCHED
}
__device__ __forceinline__ u32x4 pack8(f32x4 v0, f32x4 v1) { u32x4 w; w.x = pk_bf16(v0[0], v0[1]); w.y = pk_bf16(v0[2], v0[3]); w.z = pk_bf16(v1[0], v1[1]); w.w = pk_bf16(v1[2], v1[3]); return w; }
__device__ __forceinline__ u32x2 pack8u(f32x4 a, f32x4 b) {
    u32x2 w;
    w.x = (unsigned)__builtin_rintf(a[0] * 255.f) | ((unsigned)__builtin_rintf(a[1] * 255.f) << 8) | ((unsigned)__builtin_rintf(a[2] * 255.f) << 16) | ((unsigned)__builtin_rintf(a[3] * 255.f) << 24);
    w.y = (unsigned)__builtin_rintf(b[0] * 255.f) | ((unsigned)__builtin_rintf(b[1] * 255.f) << 8) | ((unsigned)__builtin_rintf(b[2] * 255.f) << 16) | ((unsigned)__builtin_rintf(b[3] * 255.f) << 24);
    return w;
}
__device__ __forceinline__ void unpk8u(u32x2 w, float (&f)[8]) {
    const unsigned x = w.x, y = w.y; const float k = 1.0f / 255.0f;
    f[0] = (float)(x & 255u) * k; f[1] = (float)((x >> 8) & 255u) * k; f[2] = (float)((x >> 16) & 255u) * k; f[3] = (float)(x >> 24) * k;
    f[4] = (float)(y & 255u) * k; f[5] = (float)((y >> 8) & 255u) * k; f[6] = (float)((y >> 16) & 255u) * k; f[7] = (float)(y >> 24) * k;
}
__device__ __forceinline__ f32x4 sig4(f32x4 v) { return (f32x4){sigmoidf_(v[0]), sigmoidf_(v[1]), sigmoidf_(v[2]), sigmoidf_(v[3])}; }
struct EpiG1 {
    static constexpr bool PERM = true; __device__ __forceinline__ bool keeps(const Unit&) const { return false; } unsigned char* ws;
    __device__ __forceinline__ void operator()(const f32x4 (&acc)[2][2][4][2], const Unit& u, int wr, int wc, int fr, int fq) const {
        const int rl = wr * 64 + fr, cl = wc * 32 + 8 * fq; const int row0 = u.pm * BM + rl;
        const int kvb = (u.pm < 128 ? (u.pm >> 3) * KV + (u.pm & 7) * 256 : (u.pm - 128) * KV + SEQ) + rl;
#pragma unroll
        for (int ai = 0; ai < 2; ++ai)
#pragma unroll
            for (int m = 0; m < 4; ++m) { const int ro = ai * HALF + m * 16;
#pragma unroll
                for (int bj = 0; bj < 2; ++bj) { const f32x4 v0 = acc[ai][bj][m][0], v1 = acc[ai][bj][m][1];
                    if (u.pn == 0) *(u32x4*)((bf16_t*)(ws + OFF_PP) + (size_t)(row0 + ro) * 256 + bj * HALF + cl) = pack8(v0, v1);
                    else if (u.pn < 3) *(u32x4*)((bf16_t*)(ws + OFF_QR) + (size_t)(row0 + ro) * 512 + (u.pn - 1) * 256 + bj * HALF + cl) = pack8(v0, v1);
                    else if (u.pn == 3) *(u32x4*)((bf16_t*)(ws + (bj ? OFF_VALL : OFF_KALL)) + (size_t)(kvb + ro) * 128 + cl) = pack8(v0, v1);
                    else *(u32x2*)(ws + OFF_GT + (size_t)(row0 + ro) * 3072 + (u.pn - 4) * 256 + bj * HALF + cl) = pack8u(sig4(v0), sig4(v1)); } }
    }
};
struct EpiG8 {
    static constexpr bool PERM = true; __device__ __forceinline__ bool keeps(const Unit&) const { return false; } unsigned char* ws; const PG8_LAS unsigned char* lut;
    __device__ __forceinline__ unsigned g4(const f32x4 v) const {
        const unsigned i0 = min((unsigned)(v[0] + 512.5f), 1023u), i1 = min((unsigned)(v[1] + 512.5f), 1023u), i2 = min((unsigned)(v[2] + 512.5f), 1023u), i3 = min((unsigned)(v[3] + 512.5f), 1023u);
        return (unsigned)lut[i0] | ((unsigned)lut[i1] << 8) | ((unsigned)lut[i2] << 16) | ((unsigned)lut[i3] << 24);
    }
    __device__ __forceinline__ void operator()(const f32x4 (&acc)[2][2][4][2], const Unit& u, int wr, int wc, int fr, int fq) const {
        const int row0 = u.pm * BM + wr * 64 + fr, cl = wc * 32 + 8 * (fq & ~1); const int odd = fq & 1;
#pragma unroll
        for (int ai = 0; ai < 2; ++ai)
#pragma unroll
            for (int bj = 0; bj < 2; ++bj)
#pragma unroll
                for (int mp = 0; mp < 2; ++mp) {
                    const unsigned a0 = g4(acc[ai][bj][2 * mp][0]), a1 = g4(acc[ai][bj][2 * mp][1]), b0 = g4(acc[ai][bj][2 * mp + 1][0]), b1 = g4(acc[ai][bj][2 * mp + 1][1]);
                    auto s0 = __builtin_amdgcn_permlane16_swap(a0, b0, false, false); auto s1 = __builtin_amdgcn_permlane16_swap(a1, b1, false, false);
                    u32x4 o; o.x = (unsigned)s0[0]; o.y = (unsigned)s1[0]; o.z = (unsigned)s0[1]; o.w = (unsigned)s1[1];
                    *(u32x4*)(ws + OFF_GT + (size_t)(row0 + ai * HALF + (2 * mp + odd) * 16) * 3072 + u.pn * 256 + bj * HALF + cl) = o; }
    }
};
struct EpiGZ {
    static constexpr bool PERM = true; __device__ __forceinline__ bool keeps(const Unit&) const { return false; } unsigned char* ws;
    __device__ __forceinline__ void operator()(const f32x4 (&acc)[2][2][4][2], const Unit& u, int wr, int wc, int fr, int fq) const {
        const int ch0 = wr * 64 + fr, tl = wc * 32 + 8 * fq;
        bf16_t* base; int pitch;
        if (u.pn < 128) { base = (bf16_t*)(ws + OFF_ZTL) + (size_t)((u.pn >> 3) * 256) * 4096 + u.pm * 2048 + (u.pn & 7) * 256; pitch = 4096; }
        else { base = (bf16_t*)(ws + OFF_ZTC) + (size_t)((u.pn - 128) * 256) * 512 + u.pm * 256; pitch = 512; }
#pragma unroll
        for (int ai = 0; ai < 2; ++ai)
#pragma unroll
            for (int m = 0; m < 4; ++m) { const int ch = ch0 + ai * HALF + m * 16;
#pragma unroll
                for (int bj = 0; bj < 2; ++bj) *(u32x4*)(base + (size_t)ch * pitch + bj * HALF + tl) = pack8(acc[ai][bj][m][0], acc[ai][bj][m][1]); }
    }
};
struct EpiRe8 {
    static constexpr bool PERM = true; __device__ __forceinline__ bool keeps(const Unit&) const { return false; } bf16_t* mix; int ctx;
    __device__ __forceinline__ void operator()(const f32x4 (&acc)[2][2][4][2], const Unit& u, int wr, int wc, int fr, int fq) const {
        const int rb = (ctx ? NL + u.tag * CTX : u.tag * SEQ + (u.pm & 7) * 256) + wr * 64 + fr, cl = wc * 32 + 8 * fq;
        const float sc = ctx ? 1.0f / 128.0f : 0.0027621358640099515f;
#pragma unroll
        for (int ai = 0; ai < 2; ++ai)
#pragma unroll
            for (int m = 0; m < 4; ++m)
#pragma unroll
                for (int bj = 0; bj < 2; ++bj) *(u32x4*)(mix + (size_t)(rb + ai * HALF + m * 16) * D + bj * HALF + cl) = pack8(acc[ai][bj][m][0] * sc, acc[ai][bj][m][1] * sc);
    }
};
struct EpiMg {
    static constexpr bool PERM = true; unsigned char* ws;
    __device__ __forceinline__ bool keeps(const Unit& u) const { return u.tag != 2; }
    __device__ __forceinline__ void operator()(f32x4 (&acc)[2][2][4][2], const Unit& u, int wr, int wc, int fr, int fq) const {
        const int row0 = u.pm * BM + wr * 64 + fr, col0 = u.pn * BM + wc * 32 + 8 * fq;
        const unsigned char* gt = ws + OFF_GT + u.tag * 1024; bf16_t* U = (bf16_t*)(ws + OFF_HB);
        const unsigned go = (unsigned)row0 * 3072u + (unsigned)col0, dofs = u.tag != 2 ? 1024u : 0u; const bool ratio = u.tag != 2;
#pragma unroll
        for (int g = 0; g < 4; ++g) {
            u32x2 gn[2][2], gd[2][2];
#pragma unroll
            for (int mm = 0; mm < 2; ++mm)
#pragma unroll
                for (int bj = 0; bj < 2; ++bj) { const unsigned o = go + (unsigned)((g >> 1) * HALF + ((g & 1) * 2 + mm) * 16) * 3072u + (unsigned)(bj * HALF);
                    gn[mm][bj] = *(const u32x2*)(gt + o); gd[mm][bj] = *(const u32x2*)(gt + (o + dofs)); }
#pragma unroll
            for (int mm = 0; mm < 2; ++mm)
#pragma unroll
                for (int bj = 0; bj < 2; ++bj) { const int ai = g >> 1, m = (g & 1) * 2 + mm; float f[8], d[8];
                    u32x2 dd = gd[mm][bj]; dd.x = ratio ? dd.x : 0xFFFFFFFFu; dd.y = ratio ? dd.y : 0xFFFFFFFFu;
                    unpk8u(gn[mm][bj], f); unpk8u(dd, d);
#pragma unroll
                    for (int i = 0; i < 8; ++i) f[i] = fmaxf(f[i], 1e-20f) * __builtin_amdgcn_rcpf(fmaxf(d[i], 1e-20f));
                    f32x4 v0 = acc[ai][bj][m][0], v1 = acc[ai][bj][m][1];
                    v0[0] *= f[0]; v0[1] *= f[1]; v0[2] *= f[2]; v0[3] *= f[3]; v1[0] *= f[4]; v1[1] *= f[5]; v1[2] *= f[6]; v1[3] *= f[7];
                    acc[ai][bj][m][0] = v0; acc[ai][bj][m][1] = v1; }
        }
        if (u.tag == 2) {
#pragma unroll
            for (int ai = 0; ai < 2; ++ai)
#pragma unroll
                for (int m = 0; m < 4; ++m)
#pragma unroll
                    for (int bj = 0; bj < 2; ++bj) *(u32x4*)(U + (size_t)(row0 + ai * HALF + m * 16) * D + col0 + bj * HALF) = pack8(acc[ai][bj][m][0], acc[ai][bj][m][1]);
        }
    }
};
struct EpiO {
    static constexpr bool PERM = false; __device__ __forceinline__ bool keeps(const Unit&) const { return false; } float* out; unsigned char* ws; int l; const float* xin; const float* cin;
    __device__ __forceinline__ void operator()(const f32x4 (&acc)[2][2][4][2], const Unit& u, int wr, int wc, int fr, int fq) const {
        const int rl = wr * 64 + fr, col0 = u.pn * BM + wc * 32 + 4 * fq;
        float* xb = (u.pm < 128 ? out + (size_t)u.pm * BM * D : (float*)(ws + OFF_XC) + (size_t)(u.pm - 128) * BM * D) + (size_t)rl * D + col0;
        const float* xr = (u.pm < 128 ? xin + (size_t)u.pm * BM * D : cin + (size_t)(u.pm - 128) * BM * D) + (size_t)rl * D + col0;
        const float* m2 = (const float*)(ws + OFF_MOD) + ((size_t)(l * 17 + (u.pm < 128 ? (u.pm >> 3) : 16)) * 6 + 2) * D + col0;
        f32x4 gv[2][2];
#pragma unroll
        for (int bj = 0; bj < 2; ++bj)
#pragma unroll
            for (int n = 0; n < 2; ++n) gv[bj][n] = *(const f32x4*)(m2 + bj * HALF + n * 16);
        f32x4 xv[2][2][2][2];
#define EO_LOAD(G, BUF) do { _Pragma("unroll") for (int mm = 0; mm < 2; ++mm) { const int ai_ = (G) >> 1, m_ = ((G) & 1) * 2 + mm; const size_t ro_ = (size_t)(ai_ * HALF + m_ * 16) * D; \
            _Pragma("unroll") for (int bj = 0; bj < 2; ++bj) _Pragma("unroll") for (int n = 0; n < 2; ++n) xv[BUF][mm][bj][n] = *(const f32x4*)(xr + ro_ + bj * HALF + n * 16); } } while (0)
        EO_LOAD(0, 0);
#pragma unroll
        for (int g = 0; g < 4; ++g) { const int cb = g & 1;
            if (g < 3) EO_LOAD(g + 1, cb ^ 1);
            asm volatile("" : "+v"(xv[cb][0][0][0]), "+v"(xv[cb][0][0][1]), "+v"(xv[cb][0][1][0]), "+v"(xv[cb][0][1][1]), "+v"(xv[cb][1][0][0]), "+v"(xv[cb][1][0][1]), "+v"(xv[cb][1][1][0]), "+v"(xv[cb][1][1][1]));
#pragma unroll
            for (int mm = 0; mm < 2; ++mm) { const int ai = g >> 1, m = (g & 1) * 2 + mm; const size_t ro = (size_t)(ai * HALF + m * 16) * D;
#pragma unroll
                for (int bj = 0; bj < 2; ++bj)
#pragma unroll
                    for (int n = 0; n < 2; ++n) *(f32x4*)(xb + ro + bj * HALF + n * 16) = xv[cb][mm][bj][n] + gv[bj][n] * acc[ai][bj][m][n]; }
        }
#undef EO_LOAD
    }
};
struct EpiS {
    static constexpr bool PERM = true; __device__ __forceinline__ bool keeps(const Unit&) const { return false; } bf16_t* st;
    __device__ __forceinline__ void operator()(const f32x4 (&acc)[2][2][4][2], const Unit& u, int wr, int wc, int fr, int fq) const {
        bf16_t* base = st + (size_t)(u.pm * BM + wr * 64 + fr) * NT + u.pn * BM + wc * 32 + 8 * fq;
#pragma unroll
        for (int ai = 0; ai < 2; ++ai)
#pragma unroll
            for (int m = 0; m < 4; ++m)
#pragma unroll
                for (int bj = 0; bj < 2; ++bj) { u32x4 p = pack8(acc[ai][bj][m][0], acc[ai][bj][m][1]);
                    p.x ^= ((p.x >> 15) & 0x00010001u) * 0x7fffu; p.y ^= ((p.y >> 15) & 0x00010001u) * 0x7fffu; p.z ^= ((p.z >> 15) & 0x00010001u) * 0x7fffu; p.w ^= ((p.w >> 15) & 0x00010001u) * 0x7fffu;
                    *(u32x4*)(base + (size_t)(ai * HALF + m * 16) * NT + bj * HALF) = p; }
    }
};
struct DftSched { int G, c, ctx;
    __device__ __forceinline__ bool next(int i, Unit& u) const { const int L = i * G + c; const int n = ctx ? NB : NB * 8; if (L >= n) return false;
        if (ctx) { u.pm = 0; u.pn = L; u.tag = L; u.nt = 8; } else { u.pm = L & 7; u.pn = L >> 3; u.tag = L >> 3; u.nt = 64; }
        u.kofs = 0; return true; } };
}


__device__ __forceinline__ void ph_gemm1_pg(const Params& P, int l, int bid, int nblk, unsigned char* smem) {
    PG8_LAS unsigned char* lds = (PG8_LAS unsigned char*)smem; const bf16_t* HB = (const bf16_t*)(P.ws + OFF_HB);
    { pg8::Gemm g{(const bf16_t*)(P.ws + OFF_HB8), (const bf16_t*)(P.ws + OFF_WG8 + (size_t)l * 3072 * D), D / 2, D / 2}; pg8::PlainSched S; S.T.init(NT / 256, 12, nblk, bid); S.nt = 8; pg8::EpiG8 E{P.ws, (const PG8_LAS unsigned char*)(lds + SIGLUT_OFF)};
      pg8::gemm_phase<pg8::EpiG8, pg8::PlainSched, true>(lds, g, S, E); }
    { pg8::Gemm g{HB, (const bf16_t*)(P.ws + OFF_W1T) + (size_t)l * 4096 * D, D, D}; pg8::PlainSched S; S.T.init(NT / 256, 4, nblk, nblk == 256 ? (bid + 64) & 255 : bid); S.nt = 16; pg8::EpiG1 E{P.ws}; pg8::gemm_phase(lds, g, S, E); }
    { pg8::Gemm g{(const bf16_t*)(P.ws + OFF_WFT) + (size_t)l * 512 * D, HB, D, D}; pg8::PlainSched S; S.T.init(2, NL / 256, nblk, bid); S.nt = 16; pg8::EpiGZ E{P.ws}; pg8::gemm_phase(lds, g, S, E); }
}
__device__ __forceinline__ void ph_gemm1_ctxz(const Params& P, int l, int c, int G, unsigned char* smem) {
    PG8_LAS unsigned char* lds = (PG8_LAS unsigned char*)smem;
    pg8::Gemm g{(const bf16_t*)(P.ws + OFF_WFT) + (size_t)l * 512 * D, (const bf16_t*)(P.ws + OFF_HB), D, D}; pg8::CtxZSched S{c, G, 16}; pg8::EpiGZ E{P.ws}; pg8::gemm_phase(lds, g, S, E);
}
__device__ __forceinline__ void ph_merge_pg(const Params& P, int l, int ntok, int bid, int nblk, unsigned char* smem) {
    PG8_LAS unsigned char* lds = (PG8_LAS unsigned char*)smem;
    pg8::Gemm g{(const bf16_t*)(P.ws + OFF_MIX), (const bf16_t*)(P.ws + OFF_WMT) + (size_t)l * D * D, D, D}; pg8::MergeSched S; S.T.init(ntok / 256, 4, nblk, bid); pg8::EpiMg E{P.ws}; pg8::gemm_phase(lds, g, S, E);
}
__device__ __forceinline__ void ph_out_pg(const Params& P, int l, int ntok, int bid, int nblk, unsigned char* smem) {
    PG8_LAS unsigned char* lds = (PG8_LAS unsigned char*)smem;
    pg8::Gemm g{(const bf16_t*)(P.ws + OFF_HB), (const bf16_t*)(P.ws + OFF_WOT) + (size_t)l * D * D, D, D}; pg8::PlainSched S; S.T.init(ntok / 256, 4, nblk, bid); S.nt = 16; pg8::EpiO E{P.out, P.ws, l, l == 0 ? P.x : (const float*)P.out, l == 0 ? P.ctx : (const float*)(P.ws + OFF_XC)}; pg8::gemm_phase(lds, g, S, E);
}
__device__ __forceinline__ void ph_score_pg(const Params& P, int l, int ntok, int bid, int nblk, unsigned char* smem) {
    PG8_LAS unsigned char* lds = (PG8_LAS unsigned char*)smem;
    pg8::Gemm g{(const bf16_t*)(P.ws + OFF_WST) + (size_t)l * 2048 * D, (const bf16_t*)(P.ws + OFF_HB), D, D}; pg8::PlainSched S; S.T.init(8, ntok / 256, nblk, bid); S.nt = 16; pg8::EpiS E{(bf16_t*)(P.ws + OFF_ST)}; pg8::gemm_phase(lds, g, S, E);
}


namespace attn_body {
using bf16=__hip_bfloat16;
using bf16x8=__attribute__((ext_vector_type(8)))short;
using s16x4=__attribute__((ext_vector_type(4)))short;
using f32x16=__attribute__((ext_vector_type(16)))float;
using u32x4=__attribute__((ext_vector_type(4)))unsigned;
constexpr int D=64,QP=512,KP=128,OP=1024;
constexpr int NW=8,QBLK=32,QB=QBLK*NW,KVBLK=64;
__device__ __forceinline__ int crow(int r,int hi){return (r&3)+8*(r>>2)+4*hi;}
#define SBAR() __builtin_amdgcn_sched_barrier(0)
constexpr int NSLOT=3, SLOTB=8192;
constexpr int LDS_K=0, LDS_V=NSLOT*SLOTB, LDS_WS=2*NSLOT*SLOTB, LDS_OST=LDS_WS+NW*64*4, LDS_BYTES=LDS_OST+NW*4096;
constexpr float C2=0.125f*1.4426950408889634f;
__device__ __forceinline__ void glds16(const void*gsrc,unsigned lds_dst){unsigned keep;
  asm volatile("s_mov_b32 %0, m0\n\ts_mov_b32 m0, %2\n\ts_nop 0\n\tglobal_load_lds_dwordx4 %1, off\n\ts_mov_b32 m0, %0":"=&s"(keep):"v"(gsrc),"s"(lds_dst):"memory");}
__device__ __forceinline__ float max3f(float a,float b,float c){float r;asm("v_max3_f32 %0, %1, %2, %3":"=v"(r):"v"(a),"v"(b),"v"(c));return r;}
__device__ __forceinline__ float max2f(float a,float b){float r;asm("v_max_f32_e32 %0, %1, %2":"=v"(r):"v"(a),"v"(b));return r;}
__device__ __forceinline__ float fadd_s(float a,float b){float r;asm("v_add_f32_e32 %0, %1, %2":"=v"(r):"v"(a),"v"(b));return r;}
__device__ __forceinline__ float fsub_s(float a,float b){float r;asm("v_sub_f32_e32 %0, %1, %2":"=v"(r):"v"(a),"v"(b));return r;}
typedef float f32x2_t __attribute__((ext_vector_type(2))); typedef __bf16 bf16x2_t __attribute__((ext_vector_type(2)));
__device__ __forceinline__ unsigned cvtpk_s(float lo,float hi){f32x2_t v={lo,hi};bf16x2_t b=__builtin_convertvector(v,bf16x2_t);return __builtin_bit_cast(unsigned,b);}
#define WAIT_BAR(N) asm volatile("s_waitcnt vmcnt(" #N ") lgkmcnt(0)\n\ts_barrier":::"memory")

__device__ __forceinline__ void qkt(f32x16&p0,f32x16&p1,const char*Kslot,const bf16x8*qr,const f32x16&negm,int r32,int hi){
  const char*kb=Kslot+hi*1024+r32*16;
  #pragma unroll
  for(int d0=0;d0<4;++d0){
    const bf16x8 b0=*reinterpret_cast<const bf16x8*>(kb+d0*2048);
    const bf16x8 b1=*reinterpret_cast<const bf16x8*>(kb+d0*2048+512);
    if(d0==0){p0=__builtin_amdgcn_mfma_f32_32x32x16_bf16(b0,qr[0],negm,0,0,0);p1=__builtin_amdgcn_mfma_f32_32x32x16_bf16(b1,qr[0],negm,0,0,0);}
    else{p0=__builtin_amdgcn_mfma_f32_32x32x16_bf16(b0,qr[d0],p0,0,0,0);p1=__builtin_amdgcn_mfma_f32_32x32x16_bf16(b1,qr[d0],p1,0,0,0);}}
}
typedef __attribute__((address_space(3))) const char* lds_cptr;
typedef short v4i16_t __attribute__((ext_vector_type(4)));
__device__ __forceinline__ void kload8(bf16x8*kf,lds_cptr kp){
  kf[0]=*(const __attribute__((address_space(3))) bf16x8*)(kp);      kf[1]=*(const __attribute__((address_space(3))) bf16x8*)(kp+512);
  kf[2]=*(const __attribute__((address_space(3))) bf16x8*)(kp+2048); kf[3]=*(const __attribute__((address_space(3))) bf16x8*)(kp+2560);
  kf[4]=*(const __attribute__((address_space(3))) bf16x8*)(kp+4096); kf[5]=*(const __attribute__((address_space(3))) bf16x8*)(kp+4608);
  kf[6]=*(const __attribute__((address_space(3))) bf16x8*)(kp+6144); kf[7]=*(const __attribute__((address_space(3))) bf16x8*)(kp+6656);
}
__device__ __forceinline__ void kload2(bf16x8*kf,lds_cptr kp,int j){ kf[2*j]=*(const __attribute__((address_space(3))) bf16x8*)(kp+j*2048); kf[2*j+1]=*(const __attribute__((address_space(3))) bf16x8*)(kp+j*2048+512); }
__device__ __forceinline__ s16x4 vtr(lds_cptr p){ return __builtin_bit_cast(s16x4,__builtin_amdgcn_ds_read_tr16_b64_v4i16((__attribute__((address_space(3))) v4i16_t*)p)); }
__device__ __forceinline__ float rowmax(const f32x16&p0,const f32x16&p1){
  float a=max3f(p0[0],p0[1],p1[0]),b=max3f(p0[2],p0[3],p1[1]);a=max3f(a,p1[2],p1[3]);
  #pragma unroll
  for(int r=4;r<16;r+=4){a=max3f(a,p0[r],p0[r+1]);b=max3f(b,p0[r+2],p0[r+3]);a=max3f(a,p1[r],p1[r+1]);b=max3f(b,p1[r+2],p1[r+3]);}
  const float m=max2f(a,b);
  auto rr=__builtin_amdgcn_permlane32_swap(__float_as_uint(m),__float_as_uint(m),false,false);
  return max2f(__uint_as_float(rr[0]),__uint_as_float(rr[1]));
}
__device__ __forceinline__ void pv(f32x16*o,int vb,bf16x8 pa0,bf16x8 pa1,bf16x8 pa2,bf16x8 pa3){
  #pragma unroll
  for(int d0=0;d0<2;++d0){s16x4 lo[4],hi[4];
    #pragma unroll
    for(int ks=0;ks<4;++ks){
      asm volatile("ds_read_b64_tr_b16 %0,%1 offset:%c2":"=&v"(lo[ks]):"v"(vb),"i"(d0*4096+ks*1024):"memory");
      asm volatile("ds_read_b64_tr_b16 %0,%1 offset:%c2":"=&v"(hi[ks]):"v"(vb),"i"(d0*4096+ks*1024+512):"memory");}
    asm volatile("s_waitcnt lgkmcnt(0)":::"memory");SBAR();
    #define PK(k) (bf16x8){lo[k][0],lo[k][1],lo[k][2],lo[k][3],hi[k][0],hi[k][1],hi[k][2],hi[k][3]}
    o[d0]=__builtin_amdgcn_mfma_f32_32x32x16_bf16(pa0,PK(0),o[d0],0,0,0);
    o[d0]=__builtin_amdgcn_mfma_f32_32x32x16_bf16(pa1,PK(1),o[d0],0,0,0);
    o[d0]=__builtin_amdgcn_mfma_f32_32x32x16_bf16(pa2,PK(2),o[d0],0,0,0);
    o[d0]=__builtin_amdgcn_mfma_f32_32x32x16_bf16(pa3,PK(3),o[d0],0,0,0);
    #undef PK
  }
}

#ifndef ATTN_STORE16
#define ATTN_STORE16(p,v) (*(u32x4*)(p)=(v))
#endif
template<int THRL> __device__ __forceinline__ void attn_unit(const bf16*Qu,const bf16*__restrict__ Kh,const bf16*__restrict__ Vh,bf16*Ou,const int NT,char*shm){
  const int tid=tidx(),lane=tid&63,r32=lane&31,hi=lane>>5; const int wid=__builtin_amdgcn_readfirstlane(tid>>6);
  const bf16*Qw=Qu+(long)(wid*QBLK)*QP;
  const unsigned lds0=(unsigned)(uintptr_t)shm;
  float*wsf=(float*)(shm+LDS_WS)+wid*64;
  const bf16*ksrc=Kh+(long)lane*KP+wid*8;
  const bf16*vsrc=Vh+(long)(16*(wid&3)+(lane>>2))*KP+(wid>>2)*32+(lane&3)*8;
  const unsigned kdst=lds0+LDS_K+wid*1024, vdst=lds0+LDS_V+wid*1024;
  #define DMA_K(t,slot) glds16(ksrc+(long)(t)*KVBLK*KP,(unsigned)__builtin_amdgcn_readfirstlane(kdst+(slot)))
  #define DMA_V(t,slot) glds16(vsrc+(long)(t)*KVBLK*KP,(unsigned)__builtin_amdgcn_readfirstlane(vdst+(slot)))
  const int vb0=(int)(lds0+LDS_V)+((lane>>4)&1)*32+(lane&3)*8+(4*hi+((lane&15)>>2))*64;
  const char*Kbase=shm+LDS_K; bf16x8 kf[8];
  const lds_cptr shm3=(lds_cptr)shm; const lds_cptr kp0=shm3+LDS_K+hi*1024+r32*16; const lds_cptr vp0=shm3+LDS_V+((lane>>4)&1)*32+(lane&3)*8+(4*hi+((lane&15)>>2))*64;
  DMA_K(0,0);DMA_V(0,0);DMA_K(1,SLOTB);
  bf16x8 qr[4];
  #pragma unroll
  for(int d0=0;d0<4;++d0)qr[d0]=*reinterpret_cast<const bf16x8*>(&Qw[(long)r32*QP+d0*16+hi*8]);
  float mhat=0.f,l_reg=0.f;f32x16 o[2];o[0]=f32x16{};o[1]=f32x16{};f32x16 negm=f32x16{};asm volatile("":"+v"(negm));
  #define CMASK(P0,P1,t) do{}while(0)
  bool resc=false;
  #define START(P0,P1) do{ const float rm=rowmax(P0,P1); resc=false; \
    { const float dl=rm; mhat=fadd_s(mhat,dl); \
      _Pragma("unroll") for(int r=0;r<16;++r){P0[r]=fsub_s(P0[r],dl);P1[r]=fsub_s(P1[r],dl);} \
      _Pragma("unroll") for(int r=0;r<16;++r)negm[r]=-mhat; asm volatile("":"+v"(negm)); } \
    _Pragma("unroll") for(int r=0;r<16;++r)P0[r]=__builtin_amdgcn_exp2f(P0[r]); }while(0)
  #define RESC() do{ if(resc){ asm volatile("s_waitcnt lgkmcnt(0)":::"memory"); \
      _Pragma("unroll") for(int d_=0;d_<2;++d_) _Pragma("unroll") for(int r=0;r<16;++r)o[d_][r]*=wsf[crow(r,hi)]; } }while(0)
  f32x16 pA0,pA1,pB0,pB1;
  int sl_prev=0,sl_cur=0,sl_next=SLOTB;
  #define ROT() do{sl_prev=sl_cur;sl_cur=sl_next;sl_next=(sl_next==(NSLOT-1)*SLOTB)?0:sl_next+SLOTB;}while(0)
  DMA_K(2,2*SLOTB);
  WAIT_BAR(3);
  qkt(pA0,pA1,Kbase,qr,negm,r32,hi);asm volatile("s_nop 15\n\ts_nop 7":"+v"(pA0),"+v"(pA1));CMASK(pA0,pA1,0);
  START(pA0,pA1);
  _Pragma("unroll") for(int r=0;r<16;++r)pA1[r]=__builtin_amdgcn_exp2f(pA1[r]);
  WAIT_BAR(0);
  DMA_K(3,0);DMA_V(1,SLOTB);
  ROT();
  kload8(kf,kp0+sl_cur);
  WAIT_BAR(2);
  s16x4 vlo[8],vhi[8]; u32x4 pw0,pw1,pw2,pw3;
  #define PKW(P,B) cvtpk_s(P[B],P[B+1])
  #define PAF(k) __builtin_bit_cast(bf16x8,pw##k)
  #define VFR(i) (bf16x8){vlo[i][0],vlo[i][1],vlo[i][2],vlo[i][3],vhi[i][0],vhi[i][1],vhi[i][2],vhi[i][3]}
  #define PIN(x) asm volatile("":"+v"(x))
  #define MX3(a,b,c) __builtin_fmaxf(__builtin_fmaxf((a),(b)),(c))
  #define GAPA(MF,A0,A1,A2,A3,W0,W1,PW) do{ MF; sacc+=A0; sacc+=A1; sacc+=A2; sacc+=A3; PIN(sacc); W0; W1; PIN(PW); SBAR(); }while(0)
  #define EX(v) __builtin_amdgcn_exp2f(v)
  #define GAPB(MF,X,B) do{ MF; X[B]=EX(X[B]); X[B+1]=EX(X[B+1]); X[B+2]=EX(X[B+2]); X[B+3]=EX(X[B+3]); PIN(X); SBAR(); }while(0)
  #define VRD(i) do{ vlo[i]=vtr(vp_+(((i)>>2)*4096+((i)&3)*1024)); vhi[i]=vtr(vp_+(((i)>>2)*4096+((i)&3)*1024+512)); }while(0)
  #define KRD(G,j) do{ if(G){ kload2(kf,kp0+sl_next,j); SBAR(); } }while(0)
  #define STEP(C0,C1,P0,P1,t,GK,GV,GL) do{ SBAR(); \
    const lds_cptr vp_=vp0+sl_prev; \
    VRD(0); SBAR(); float sacc=(P0[0]+P0[1]); \
    GAPA(C0=__builtin_amdgcn_mfma_f32_32x32x16_bf16(kf[0],qr[0],negm,0,0,0), P0[2],P0[3],P0[4],P0[5],     pw0[0]=PKW(P0,0), pw0[1]=PKW(P0,2), pw0); \
    VRD(4); SBAR(); GAPA(C1=__builtin_amdgcn_mfma_f32_32x32x16_bf16(kf[1],qr[0],negm,0,0,0), P0[6],P0[7],P0[8],P0[9],     pw0[2]=PKW(P0,4), pw0[3]=PKW(P0,6), pw0); \
    VRD(1); SBAR(); GAPA(C0=__builtin_amdgcn_mfma_f32_32x32x16_bf16(kf[2],qr[1],C0,0,0,0),   P0[10],P0[11],P0[12],P0[13], pw1[0]=PKW(P0,8), pw1[1]=PKW(P0,10), pw1); \
    VRD(5); SBAR(); GAPA(C1=__builtin_amdgcn_mfma_f32_32x32x16_bf16(kf[3],qr[1],C1,0,0,0),   P0[14],P0[15],P1[0],P1[1],   pw1[2]=PKW(P0,12),pw1[3]=PKW(P0,14), pw1); \
    VRD(2); SBAR(); GAPA(C0=__builtin_amdgcn_mfma_f32_32x32x16_bf16(kf[4],qr[2],C0,0,0,0),   P1[2],P1[3],P1[4],P1[5],     pw2[0]=PKW(P1,0), pw2[1]=PKW(P1,2), pw2); \
    VRD(6); SBAR(); GAPA(C1=__builtin_amdgcn_mfma_f32_32x32x16_bf16(kf[5],qr[2],C1,0,0,0),   P1[6],P1[7],P1[8],P1[9],     pw2[2]=PKW(P1,4), pw2[3]=PKW(P1,6), pw2); \
    VRD(3); SBAR(); GAPA(C0=__builtin_amdgcn_mfma_f32_32x32x16_bf16(kf[6],qr[3],C0,0,0,0),   P1[10],P1[11],P1[12],P1[13], pw3[0]=PKW(P1,8), pw3[1]=PKW(P1,10), pw3); \
    VRD(7); SBAR(); GAPA(C1=__builtin_amdgcn_mfma_f32_32x32x16_bf16(kf[7],qr[3],C1,0,0,0),   P1[14],P1[15],0.f,0.f,       pw3[2]=PKW(P1,12),pw3[3]=PKW(P1,14), pw3); \
    l_reg+=sacc; \
    if(GK){DMA_K((t)+3,sl_cur);} if(GV){DMA_V((t)+1,sl_next);} \
    CMASK(C0,C1,t); \
    { float a=MX3(C0[0],C0[1],C1[0]),b=MX3(C0[2],C0[3],C1[1]); a=MX3(a,C1[2],C1[3]); \
      _Pragma("unroll") for(int r=4;r<16;r+=4){a=MX3(a,C0[r],C0[r+1]);b=MX3(b,C0[r+2],C0[r+3]);a=MX3(a,C1[r],C1[r+1]);b=MX3(b,C1[r+2],C1[r+3]);} \
      float rm=__builtin_fmaxf(a,b); { auto rr=__builtin_amdgcn_permlane32_swap(__float_as_uint(rm),__float_as_uint(rm),false,false); rm=__builtin_fmaxf(__uint_as_float(rr[0]),__uint_as_float(rr[1])); } \
      resc=false; \
      if(__builtin_expect(__any(rm>(float)THRL),0)){ const float dl=__builtin_fmaxf(rm,0.f); mhat+=dl; \
        _Pragma("unroll") for(int r=0;r<16;++r){C0[r]-=dl;C1[r]-=dl;} \
        _Pragma("unroll") for(int r=0;r<16;++r)negm[r]=-mhat; asm volatile("":"+v"(negm)); \
        const float f=__builtin_amdgcn_exp2f(-dl); l_reg*=f; if(hi==0)wsf[r32]=f; resc=true; } } \
    SBAR(); \
    GAPB(o[0]=__builtin_amdgcn_mfma_f32_32x32x16_bf16(PAF(0),VFR(0),o[0],0,0,0), C0,0); \
    GAPB(o[1]=__builtin_amdgcn_mfma_f32_32x32x16_bf16(PAF(0),VFR(4),o[1],0,0,0), C0,4); \
    KRD(GL,0); GAPB(o[0]=__builtin_amdgcn_mfma_f32_32x32x16_bf16(PAF(1),VFR(1),o[0],0,0,0), C0,8); \
    KRD(GL,1); GAPB(o[1]=__builtin_amdgcn_mfma_f32_32x32x16_bf16(PAF(1),VFR(5),o[1],0,0,0), C0,12); \
    KRD(GL,2); GAPB(o[0]=__builtin_amdgcn_mfma_f32_32x32x16_bf16(PAF(2),VFR(2),o[0],0,0,0), C1,0); \
    KRD(GL,3); GAPB(o[1]=__builtin_amdgcn_mfma_f32_32x32x16_bf16(PAF(2),VFR(6),o[1],0,0,0), C1,4); \
    GAPB(o[0]=__builtin_amdgcn_mfma_f32_32x32x16_bf16(PAF(3),VFR(3),o[0],0,0,0), C1,8); \
    GAPB(o[1]=__builtin_amdgcn_mfma_f32_32x32x16_bf16(PAF(3),VFR(7),o[1],0,0,0), C1,12); \
    }while(0)
  int t=1;
  #undef CMASK
  #define CMASK(P0,P1,t) do{}while(0)
  for(;t+5<NT;t+=2){
    STEP(pB0,pB1,pA0,pA1,t,true,true,true);     WAIT_BAR(2); RESC(); ROT();
    STEP(pA0,pA1,pB0,pB1,t+1,true,true,true);   WAIT_BAR(2); RESC(); ROT();
  }
  #undef CMASK
  #define CMASK(P0,P1,t) do{}while(0)
  #define ENDW(tt) do{ if((tt)+3<NT){WAIT_BAR(2);} else if((tt)+2<NT){WAIT_BAR(1);} else {WAIT_BAR(0);} }while(0)
  for(;t+1<NT;t+=2){
    STEP(pB0,pB1,pA0,pA1,t,(t+3<NT),(t+1<NT),(t+1<NT));       ENDW(t);   RESC(); ROT();
    STEP(pA0,pA1,pB0,pB1,t+1,(t+4<NT),(t+2<NT),(t+2<NT));     ENDW(t+1); RESC(); ROT();
  }
  STEP(pB0,pB1,pA0,pA1,NT-1,false,false,false); RESC();
  { float sacc=pB0[0]+pB0[1]; _Pragma("unroll") for(int r=2;r<16;++r)sacc+=pB0[r]; _Pragma("unroll") for(int r=0;r<16;++r)sacc+=pB1[r]; l_reg+=sacc;
    pw0=(u32x4){PKW(pB0,0),PKW(pB0,2),PKW(pB0,4),PKW(pB0,6)};pw1=(u32x4){PKW(pB0,8),PKW(pB0,10),PKW(pB0,12),PKW(pB0,14)};pw2=(u32x4){PKW(pB1,0),PKW(pB1,2),PKW(pB1,4),PKW(pB1,6)};pw3=(u32x4){PKW(pB1,8),PKW(pB1,10),PKW(pB1,12),PKW(pB1,14)};
    SBAR(); pv(o,vb0+sl_cur,PAF(0),PAF(1),PAF(2),PAF(3)); }
  #undef PKW
  #undef PAF
  #undef VFR
  #undef PIN
  #undef MX3
  #undef GAPA
  #undef GAPB
  #undef EX
  #undef VRD
  #undef KRD
  #undef STEP
  #undef ENDW
  {auto rr=__builtin_amdgcn_permlane32_swap(__float_as_uint(l_reg),__float_as_uint(l_reg),false,false);l_reg=__uint_as_float(rr[0])+__uint_as_float(rr[1]);}
  if(hi==0)wsf[32+r32]=l_reg;asm volatile("s_waitcnt lgkmcnt(0)":::"memory");
  float rli[16];
  #pragma unroll
  for(int r=0;r<16;++r)rli[r]=__builtin_amdgcn_rcpf(wsf[32+crow(r,hi)]);
  bf16*Ow=Ou+(long)(wid*QBLK)*OP;
  { bf16*stg=(bf16*)(shm+LDS_OST)+wid*2048;
    #pragma unroll
    for(int r=0;r<16;++r){const int orow=crow(r,hi);
      #pragma unroll
      for(int d0=0;d0<2;++d0)stg[orow*64+d0*32+r32]=__float2bfloat16(o[d0][r]*rli[r]);}
    asm volatile("s_waitcnt lgkmcnt(0)":::"memory");
    #pragma unroll
    for(int i=0;i<4;++i){const int row=i*8+(lane>>3),ch=lane&7; const u32x4 v=*(const u32x4*)(stg+row*64+ch*8); ATTN_STORE16(Ow+(long)row*OP+ch*8,v);} }
  asm volatile("s_waitcnt lgkmcnt(0)\n\ts_barrier":::"memory");
  #undef DMA_K
  #undef DMA_V
  #undef CMASK
  #undef START
  #undef RESC
  #undef ROT
}
constexpr int ATTN_LDS_BYTES=LDS_BYTES;
#undef SBAR
#undef WAIT_BAR
}

__device__ __forceinline__ void ph_attn_dft(const Params& P, int bid, int nblk, unsigned char* smem, int with_ctx) {
    PG8_LAS unsigned char* lds = (PG8_LAS unsigned char*)smem; bf16_t* MIXb = (bf16_t*)(P.ws + OFF_MIX);
    const bool bal = (nblk == 256);
    { pg8::Gemm g{(const bf16_t*)(P.ws + OFF_ADFT), (const bf16_t*)(P.ws + OFF_ZTL), 4096, 4096}; pg8::DftSched S{nblk, bid, 0}; pg8::EpiRe8 E{MIXb, 0}; pg8::gemm_phase(lds, g, S, E); }
    if (with_ctx) { pg8::Gemm g{(const bf16_t*)(P.ws + OFF_ADFTC), (const bf16_t*)(P.ws + OFF_ZTC), 512, 512}; pg8::DftSched S{nblk, bal ? (bid >= 128 ? bid - 128 : 1 << 20) : bid, 1}; pg8::EpiRe8 E{MIXb, 1}; pg8::gemm_phase(lds, g, S, E); }
    __syncthreads();
    const attn_body::bf16* QR = (const attn_body::bf16*)(P.ws + OFF_QR); const attn_body::bf16* KA = (const attn_body::bf16*)(P.ws + OFF_KALL); const attn_body::bf16* VA = (const attn_body::bf16*)(P.ws + OFF_VALL);
    attn_body::bf16* MIX = (attn_body::bf16*)(P.ws + OFF_MIX);
    int start, cnt, stride, shortU;
    if (bal) { if (bid < 128) { start = 3 * ((bid & 7) * 16 + (bid >> 3)); cnt = 3; stride = 1; shortU = -1; }
               else { const int vj = (bid & 7) * 16 + ((bid - 128) >> 3); start = 384 + 5 * vj; cnt = 5; stride = 1; shortU = with_ctx ? 1024 + vj : -1; } }
    else { const int vcu = (nblk % 8 == 0) ? (bid % 8) * (nblk / 8) + bid / 8 : bid; const int nU = with_ctx ? 1152 : 1024; start = vcu; stride = nblk; cnt = vcu < nU ? (nU - 1 - vcu) / nblk + 1 : 0; shortU = -1; }
    for (int k = 0; k <= cnt; ++k) {
        const int U = k < cnt ? start + k * stride : shortU; if (U < 0) break;
        int b, h, qrow, krow, NTl;
        if (U < 1024) { b = U >> 6; h = (U >> 3) & 7; qrow = b * SEQ + (U & 7) * 256; krow = b * KV; NTl = KV / 64; }
        else { const int j = U - 1024; b = j >> 3; h = j & 7; qrow = NL + b * CTX; krow = b * KV + SEQ; NTl = CTX / 64; }
        attn_body::attn_unit<8>(QR + (size_t)qrow * 512 + h * 64, KA + (size_t)krow * 128 + (h >> 2) * 64, VA + (size_t)krow * 128 + (h >> 2) * 64, MIX + (size_t)qrow * D + 512 + h * 64, NTl, (char*)smem);
    }
}

#define XB_TMO      128
#define XB_XCNT(j)  (256  + 64 * (j))
#define XB_XSUB(j)  (1280 + 64 * (j))
#define XB_XGEN(j)  (2304 + 64 * (j))
#define XB_TOP      3328
#define XB_TOPGEN   3392
#define XCD_BAR_WORDS 3456
#define XB_SPIN_CAP (1u << 18)
#define LAS __attribute__((address_space(3)))

__device__ __forceinline__ unsigned xb_ld(unsigned* p)              { return __hip_atomic_load(p, __ATOMIC_RELAXED, __HIP_MEMORY_SCOPE_AGENT); }
__device__ __forceinline__ unsigned xb_add(unsigned* p, unsigned v) { return __hip_atomic_fetch_add(p, v, __ATOMIC_RELAXED, __HIP_MEMORY_SCOPE_AGENT); }
__device__ __forceinline__ unsigned xb_xcc_id() { return (unsigned)__builtin_amdgcn_s_getreg((3 << 11) | 20) & 0xFu; }
#define XB_SPIN(cond, bar) do { unsigned _sp = 0; while (cond) { __builtin_amdgcn_s_sleep(1); \
    if ((++_sp & 255u) == 0u) { if (xb_ld(&(bar)[XB_TMO])) break; if (_sp > XB_SPIN_CAP) { atomicAdd(&(bar)[XB_TMO], 1u); break; } } } } while (0)

struct XcdBarrier {
    unsigned* bar; unsigned x;
    volatile LAS unsigned* st;
};
__device__ __forceinline__ XcdBarrier xcd_barrier_post(unsigned* bar, volatile LAS unsigned* st) {
    XcdBarrier b; b.bar = bar; b.x = xb_xcc_id(); b.st = st;
    if (threadIdx.x == 0) (void)xb_add(&bar[XB_XCNT(b.x)], 1u);
    return b;
}
__device__ __forceinline__ void xcd_barrier_complete(unsigned* bar, unsigned x, unsigned& nloc, unsigned& nx) {
    const unsigned G = gridDim.x * gridDim.y * gridDim.z;
    unsigned sum, cnt, mine, sp = 0u;
    for (;;) {
        sum = 0u; cnt = 0u; mine = 0u;
#pragma unroll
        for (unsigned j = 0; j < 16; ++j) { const unsigned c = xb_ld(&bar[XB_XCNT(j)]); sum += c; cnt += (c > 0u) ? 1u : 0u; mine = (j == x) ? c : mine; }
        if (sum == G) break;
        __builtin_amdgcn_s_sleep(1);
        if ((++sp & 255u) == 0u) { if (xb_ld(&bar[XB_TMO])) break; if (sp > XB_SPIN_CAP) { atomicAdd(&bar[XB_TMO], 1u); break; } }
    }
    nloc = mine > 0u ? mine : 1u; nx = cnt > 0u ? cnt : 1u;
}
__device__ __forceinline__ void xcd_barrier(const XcdBarrier& b) {
    asm volatile("s_waitcnt vmcnt(0)" ::: "memory");
    __syncthreads();
    if (threadIdx.x == 0) {
        unsigned* bar = b.bar; const unsigned bx = xb_xcc_id();
        __builtin_amdgcn_s_waitcnt(0);
        unsigned nloc = b.st[0], nx = b.st[1];
        if (nloc == 0u) { xcd_barrier_complete(bar, bx, nloc, nx); b.st[0] = nloc; b.st[1] = nx; }
        const unsigned old = xb_add(&bar[XB_XSUB(bx)], 1u);
        const unsigned gen = old / nloc;
        if (old + 1u == (gen + 1u) * nloc) {
            __builtin_amdgcn_fence(__ATOMIC_RELEASE, "agent");
            asm volatile("s_waitcnt vmcnt(0)" ::: "memory");
            const unsigned og = xb_add(&bar[XB_TOP], 1u);
            const unsigned tg = og / nx;
            if (og + 1u == (tg + 1u) * nx) xb_add(&bar[XB_TOPGEN], 1u);
            else XB_SPIN(xb_ld(&bar[XB_TOPGEN]) == tg, bar);
            __builtin_amdgcn_fence(__ATOMIC_ACQUIRE, "agent");
            xb_add(&bar[XB_XGEN(bx)], 1u);
            asm volatile("s_waitcnt vmcnt(0)" ::: "memory");
        } else {
            XB_SPIN(xb_ld(&bar[XB_XGEN(bx)]) == gen, bar);
            __builtin_amdgcn_fence(__ATOMIC_ACQUIRE, "agent");
            asm volatile("s_waitcnt vmcnt(0)" ::: "memory");
        }
    }
    __syncthreads();
}

constexpr int LDS_BYTES = 147456;
constexpr int MISC_OFF = 131072 + 320;

__global__ void __launch_bounds__(512, 2) mega_fwd(Params P) {
    extern __shared__ __attribute__((aligned(16))) unsigned char smem[];
    const int bid = blockIdx.x, nblk = gridDim.x;
    for (int u = threadIdx.x; u < (LDS_BYTES - 131072) / 4; u += 512) ((LAS unsigned*)((LAS unsigned char*)smem + 131072))[u] = 0u;
    __syncthreads();
    for (int u = threadIdx.x; u < 1024; u += 512) ((LAS unsigned char*)smem)[SIGLUT_OFF + u] = (unsigned char)__builtin_rintf(255.0f * sigmoidf_((float)(u - 512) * (1.0f / 64.0f)));
    __syncthreads();
    XcdBarrier bar = xcd_barrier_post((unsigned*)(P.ws + OFF_CTL), (volatile LAS unsigned*)((LAS unsigned char*)smem + MISC_OFF) + 8);
    float* ldsf = (float*)smem;
#define GASQ __attribute__((address_space(1)))
#define LND(m) Q.m = (decltype(Q.m))((const char*)Q.m + z_)
#ifndef DUPM
#define DUPM 0
#endif
#define DUP(bit, call) do { call; if (DUPM & (1 << (bit))) { call; } } while (0)
#define PH(call) do { Params Q = P; long z_ = 0; asm volatile("" : "+s"(z_)); LND(ws); LND(out); LND(x); LND(c); LND(ctx); LND(c_ctx); LND(ada_w); LND(ada_b); LND(norm_mix); LND(w_in); LND(fourier_w); LND(pool_w); LND(pool_scale); LND(pool_proj); \
        LND(q_norm); LND(k_norm); LND(attn_proj); LND(w_out); LND(norm_ffn); LND(peer_wq); LND(peer_keys); LND(peer_u); LND(peer_v); call; } while (0)
    for (int rep = 0; rep < ((DUPM & (1 << 11)) ? 2 : 1); ++rep) {
    PH(ph_mod(Q, bid, nblk, ldsf)); PH(ph_tables(Q, bid, nblk)); PH(ph_wtrans(Q, bid, nblk, ldsf)); PH(ph_wft(Q, bid, nblk, ldsf)); PH(ph_wg8(Q, bid, nblk, ldsf)); PH(ph_wpool(Q, bid, nblk, ldsf)); PH(ph_wst(Q, bid, nblk, 0, 1)); PH(ph_peer_cvt(Q, bid, nblk, 0, 1));
    }
    xcd_barrier(bar);
#pragma unroll 1
    for (int l = 0; l < DEPTH; ++l) {
        const int ntok = (l == DEPTH - 1) ? NL : NT;
        DUP(0, PH(ph_norm(Q, l, 0, NT, bid, nblk, l == 0)));      xcd_barrier(bar);
        DUP(1, PH(ph_gemm1_pg(Q, l, bid, nblk, smem)));        xcd_barrier(bar);
        {
            const bool withz = l < DEPTH - 1, split = withz && nblk > 64;
            const int zc = split ? bid : bid, zG = split ? (1 << 20) : nblk;
            if (withz && (split ? bid < 32 : true)) { PH(ph_gemm1_ctxz(Q, l, zc, zG, smem)); }
            if (!split || bid >= 32) { PH(ph_l3(Q, l, split ? bid - 32 : bid, split ? nblk - 32 : nblk)); }
        }
        xcd_barrier(bar);
        DUP(3, PH(ph_attn_dft(Q, bid, nblk, smem, l < DEPTH - 1)));      xcd_barrier(bar);
        DUP(4, PH(ph_merge_pg(Q, l, ntok, bid, nblk, smem)));
        if (l < DEPTH - 1) {
            if (nblk == 256) { if (bid >= 64) { PH(ph_peer_cvt(Q, bid - 64, 192, l + 1, l + 2, 0, 1)); } }
            else { PH(ph_peer_cvt(Q, bid, nblk, l + 1, l + 2)); PH(ph_wst(Q, bid, nblk, l + 1, l + 2)); }
        }
        xcd_barrier(bar);
        PH(ph_out_pg(Q, l, ntok, bid, nblk, smem));
        if (l < DEPTH - 1 && nblk == 256 && bid >= 64) { PH(ph_wst(Q, bid - 64, 192, l + 1, l + 2)); }
        xcd_barrier(bar);
        DUP(5, PH(ph_norm(Q, l, 1, ntok, bid, nblk)));      xcd_barrier(bar);
        DUP(6, PH(ph_score_pg(Q, l, ntok, bid, nblk, smem)));        xcd_barrier(bar);
        DUP(7, PH(ph_topk(Q, ntok, bid, nblk, smem)));
        if (l < DEPTH - 1 && nblk == 256 && bid >= 64) { PH(ph_peer_cvt(Q, bid - 64, 192, l + 1, l + 2, 1, 2)); }
        xcd_barrier(bar);
        DUP(8, PH(ph_peer_u(Q, l, ntok, bid, nblk)));    xcd_barrier(bar);
        DUP(9, PH(ph_peer_a(Q, ntok, bid, nblk)));       xcd_barrier(bar);
        PH(ph_peer_v(Q, l, ntok, bid, nblk)); if (DUPM & (1 << 10)) { PH(ph_peer_v(Q, l, ntok, bid, nblk, true)); }   xcd_barrier(bar);
    }
#undef PH
#undef DUP
#undef LND
#undef GASQ
}

extern "C" void kernel_launch(void* const* d_in, const int* in_sizes, int n_in, void* d_out, int out_size, void* d_ws, size_t ws_size, hipStream_t stream) {
    static int grid = 0;
    if (grid == 0) {
        if (n_in != 21 || ws_size < WS_END) { grid = -1; return; }
        int dev = 0, cus = 0, per_cu = 0;
        if (hipGetDevice(&dev) != hipSuccess || hipDeviceGetAttribute(&cus, hipDeviceAttributeMultiprocessorCount, dev) != hipSuccess) { grid = -1; return; }
        if (hipFuncSetAttribute((const void*)mega_fwd, hipFuncAttributeMaxDynamicSharedMemorySize, LDS_BYTES) != hipSuccess) { grid = -1; return; }
        if (hipOccupancyMaxActiveBlocksPerMultiprocessor(&per_cu, (const void*)mega_fwd, 512, LDS_BYTES) != hipSuccess || per_cu < 1) { (void)hipGetLastError(); }
        grid = (cus / 8) * 8;
    }
    if (grid < 0) return;
    (void)hipMemsetAsync((char*)d_ws + OFF_CTL, 0, 65536, stream);
    Params P{};
    const float** f = (const float**)&P;
    for (int i = 0; i < 21; ++i) f[i] = (const float*)d_in[i];
    P.out = (float*)d_out; P.ws = (unsigned char*)d_ws;
    hipLaunchKernelGGL(mega_fwd, dim3(grid), dim3(512), LDS_BYTES, stream, P);
}
```
